# Optimizing an MI355X kernel written in HIP

```python
import math
import jax, jax.numpy as jnp
from jax import lax
import numpy as np

D_MODEL = 1024
BATCH = 2
SEQ = 8192
DEPTH = 2

N_META = 16
Q_BLOCK = 128
EPS = 1e-6

MLA_HEADS = 8
MLA_Q_RANK = 256
MLA_KV_RANK = 128
MLA_NOPE = 64
MLA_ROPE = 32
MLA_V = 64
ROPE_BASE = 10000.0
MLA_WIDTH = MLA_HEADS * MLA_V

DIFF_HEADS = 4
DIFF_HD = 64
DIFF_V = 2 * DIFF_HD
DIFF_WIDTH = DIFF_HEADS * DIFF_V
DIFF_QK = DIFF_HEADS * 2 * DIFF_HD

D_FF = 4 * D_MODEL

IN_SPLITS = (MLA_Q_RANK, MLA_KV_RANK, MLA_ROPE, DIFF_QK, DIFF_QK, DIFF_WIDTH, D_MODEL, D_MODEL)
D_IN = sum(IN_SPLITS)
SPLIT_IDX = tuple(sum(IN_SPLITS[:i + 1]) for i in range(len(IN_SPLITS) - 1))

kernel_name = "hybrid_mla_diffattn_gated_sqrelu"


def rmsnorm(x, g):
    xf = x.astype(jnp.float32)
    y = xf * lax.rsqrt(jnp.mean(xf * xf, axis=-1, keepdims=True) + EPS)
    return (y * g.astype(jnp.float32)).astype(x.dtype)


def rope_tables(L):
    inv = 1.0 / (ROPE_BASE ** (jnp.arange(0, MLA_ROPE, 2, dtype=jnp.float32) / MLA_ROPE))
    ang = jnp.arange(L, dtype=jnp.float32)[:, None] * inv[None, :]
    return jnp.cos(ang), jnp.sin(ang)


def apply_rope(x, cos, sin):
    x1, x2 = jnp.split(x.astype(jnp.float32), 2, axis=-1)
    return jnp.concatenate([x1 * cos - x2 * sin, x1 * sin + x2 * cos], axis=-1).astype(x.dtype)


def alibi_slopes():
    i = jnp.arange(1, DIFF_HEADS + 1, dtype=jnp.float32)
    return 2.0 ** (-8.0 * i / DIFF_HEADS)


def sweep_queries(attend, qs):
    L = qs[0].shape[1]
    n_real = L - N_META
    n_blk = n_real // Q_BLOCK
    meta_out = attend(tuple(q[:, :N_META] for q in qs), jnp.arange(N_META))

    def to_blocks(q):
        r = q[:, N_META:].reshape((q.shape[0], n_blk, Q_BLOCK) + q.shape[2:])
        return jnp.moveaxis(r, 1, 0)

    pos = (N_META + jnp.arange(n_real)).reshape(n_blk, Q_BLOCK)
    blk_out = lax.map(lambda a: attend(a[0], a[1]), (tuple(to_blocks(q) for q in qs), pos))
    real_out = jnp.moveaxis(blk_out, 0, 1)
    real_out = real_out.reshape((real_out.shape[0], n_real) + real_out.shape[3:])
    return jnp.concatenate([meta_out, real_out], axis=1)


def mla_attention(q_nope, q_rope, k_nope, k_rope, v):
    k_pos = jnp.arange(k_nope.shape[1])
    scale = (MLA_NOPE + MLA_ROPE) ** -0.5

    def attend(qb, q_pos):
        qn, qr = qb
        s = jnp.einsum('bqhd,bkhd->bhqk', qn, k_nope) + jnp.einsum('bqhr,bkr->bhqk', qr, k_rope)
        s = s.astype(jnp.float32) * scale
        s = jnp.where(k_pos[None, :] <= q_pos[:, None], s, -jnp.inf)
        p = jax.nn.softmax(s, axis=-1).astype(v.dtype)
        return jnp.einsum('bhqk,bkhd->bqhd', p, v)

    return sweep_queries(attend, (q_nope, q_rope))


def diff_attention(q, k, v, lam, slopes):
    k_pos = jnp.arange(k.shape[1])
    scale = DIFF_HD ** -0.5

    def attend(qb, q_pos):
        (qq,) = qb
        s = jnp.einsum('bqhjd,bkhjd->bhjqk', qq, k).astype(jnp.float32) * scale
        dist = (q_pos[:, None] - k_pos[None, :]).astype(jnp.float32)
        s = s - slopes[None, :, None, None, None] * dist
        s = jnp.where(dist >= 0, s, -jnp.inf)
        p = jax.nn.softmax(s, axis=-1)
        a = (p[:, :, 0] - lam * p[:, :, 1]).astype(v.dtype)
        return jnp.einsum('bhqk,bkhe->bqhe', a, v)

    return sweep_queries(attend, (q,))


def setup_inputs(seed: int = 0) -> dict:
    key = jax.random.key(seed)
    ks = jax.random.split(key, 24)

    def dense(k, shape):
        return jax.random.normal(k, shape, jnp.float32) * (shape[-2] ** -0.5)

    def gain(k, shape):
        return 1.0 + 0.05 * jax.random.normal(k, shape, jnp.float32)

    return {
        "x": jax.random.normal(ks[0], (BATCH, SEQ, D_MODEL), jnp.float32),
        "meta_tokens": jax.random.normal(ks[1], (N_META, D_MODEL), jnp.float32),
        "attn_norm": gain(ks[2], (DEPTH, D_MODEL)),
        "w_in": dense(ks[3], (DEPTH, D_MODEL, D_IN)),
        "b_gate": 0.1 * jax.random.normal(ks[4], (DEPTH, 2, D_MODEL), jnp.float32),
        "mla_q_norm": gain(ks[5], (DEPTH, MLA_Q_RANK)),
        "w_q_up": dense(ks[6], (DEPTH, MLA_Q_RANK, MLA_HEADS * (MLA_NOPE + MLA_ROPE))),
        "mla_kv_norm": gain(ks[7], (DEPTH, MLA_KV_RANK)),
        "w_kv_up": dense(ks[8], (DEPTH, MLA_KV_RANK, MLA_HEADS * (MLA_NOPE + MLA_V))),
        "lambda_q1": 0.1 * jax.random.normal(ks[9], (DEPTH, DIFF_HD), jnp.float32),
        "lambda_k1": 0.1 * jax.random.normal(ks[10], (DEPTH, DIFF_HD), jnp.float32),
        "lambda_q2": 0.1 * jax.random.normal(ks[11], (DEPTH, DIFF_HD), jnp.float32),
        "lambda_k2": 0.1 * jax.random.normal(ks[12], (DEPTH, DIFF_HD), jnp.float32),
        "diff_subln": gain(ks[13], (DEPTH, DIFF_V)),
        "w_a_proj": dense(ks[14], (DEPTH, MLA_WIDTH, D_MODEL)),
        "w_b_proj": dense(ks[15], (DEPTH, DIFF_WIDTH, D_MODEL)),
        "w_o": dense(ks[16], (DEPTH, D_MODEL, D_MODEL)),
        "mlp_norm": gain(ks[17], (DEPTH, D_MODEL)),
        "w_up": dense(ks[18], (DEPTH, D_MODEL, D_FF)),
        "w_down": dense(ks[19], (DEPTH, D_FF, D_MODEL)),
        "final_norm": gain(ks[20], (D_MODEL,)),
    }


def reference(x, meta_tokens, attn_norm, w_in, b_gate, mla_q_norm, w_q_up, mla_kv_norm,
              w_kv_up, lambda_q1, lambda_k1, lambda_q2, lambda_k2, diff_subln,
              w_a_proj, w_b_proj, w_o, mlp_norm, w_up, w_down, final_norm):
    B = x.shape[0]
    meta = jnp.broadcast_to(meta_tokens[None].astype(x.dtype), (B, N_META, D_MODEL))
    x = jnp.concatenate([meta, x], axis=1)
    L = x.shape[1]
    cos, sin = rope_tables(L)
    slopes = alibi_slopes()

    for l in range(DEPTH):
        h = rmsnorm(x, attn_norm[l])
        proj = h @ w_in[l]
        q_a, kv_a, k_r, dq, dk, dv, g_a, g_b = jnp.split(proj, SPLIT_IDX, axis=-1)

        q = (rmsnorm(q_a, mla_q_norm[l]) @ w_q_up[l]).reshape(B, L, MLA_HEADS, MLA_NOPE + MLA_ROPE)
        q_nope = q[..., :MLA_NOPE]
        q_rope = apply_rope(q[..., MLA_NOPE:], cos[None, :, None], sin[None, :, None])
        kv = (rmsnorm(kv_a, mla_kv_norm[l]) @ w_kv_up[l]).reshape(B, L, MLA_HEADS, MLA_NOPE + MLA_V)
        k_nope = kv[..., :MLA_NOPE]
        v_mla = kv[..., MLA_NOPE:]
        k_rope = apply_rope(k_r, cos[None], sin[None])
        a_out = mla_attention(q_nope, q_rope, k_nope, k_rope, v_mla).reshape(B, L, MLA_WIDTH)

        lam_init = 0.8 - 0.6 * math.exp(-0.3 * l)
        lam = (jnp.exp(jnp.sum((lambda_q1[l] * lambda_k1[l]).astype(jnp.float32)))
               - jnp.exp(jnp.sum((lambda_q2[l] * lambda_k2[l]).astype(jnp.float32)))
               + lam_init)
        d_out = diff_attention(dq.reshape(B, L, DIFF_HEADS, 2, DIFF_HD),
                               dk.reshape(B, L, DIFF_HEADS, 2, DIFF_HD),
                               dv.reshape(B, L, DIFF_HEADS, DIFF_V), lam, slopes)
        d_out = (rmsnorm(d_out, diff_subln[l]) * (1.0 - lam_init)).reshape(B, L, DIFF_WIDTH)

        gate_a = jax.nn.sigmoid(g_a + b_gate[l, 0])
        gate_b = jax.nn.sigmoid(g_b + b_gate[l, 1])
        y = gate_a * (a_out @ w_a_proj[l]) + gate_b * (d_out @ w_b_proj[l])
        x = x + y @ w_o[l]

        h = rmsnorm(x, mlp_norm[l])
        x = x + jnp.square(jax.nn.relu(h @ w_up[l])) @ w_down[l]

    x = rmsnorm(x, final_norm)
    return x[:, N_META:]
```

```cpp
#include <hip/hip_runtime.h>
#include <hip/hip_cooperative_groups.h>
#include <cstdio>
#include <cstdint>
namespace cg = cooperative_groups;
__device__ __forceinline__ int lane_id() { int l; asm volatile("v_mbcnt_lo_u32_b32 %0, -1, 0\n\tv_mbcnt_hi_u32_b32 %0, -1, %0" : "=v"(l)); return l; }

namespace pg8 {
#define PG8_LAS __attribute__((address_space(3)))
typedef unsigned short bf16_t;
typedef short bf16x8 __attribute__((ext_vector_type(8)));
typedef float f32x4 __attribute__((ext_vector_type(4)));
typedef unsigned u32x4 __attribute__((ext_vector_type(4)));
constexpr int BM = 256, BK = 64, HALF = 128, HTB = HALF * BK * 2  , STAGE_BYTES = 8 * HTB, NXCD = 8, WGM = 8;

__host__ __device__ __forceinline__ int lds_byte(int r, int c) { const int st = (r >> 4) * 2 + (c >> 5), rr = r & 15, cc = c & 31, ob = rr * 64 + cc * 2; return st * 1024 + (ob ^ (((ob >> 9) & 1) << 5)); }
__host__ __device__ __forceinline__ void stage_rc(int b, int& R, int& C) { const int st = b / 1024, sb = b % 1024, swz = sb ^ (((sb >> 9) & 1) << 5); R = (st >> 1) * 16 + swz / 64; C = (st & 1) * 32 + (swz % 64) / 2; }
__host__ __device__ __forceinline__ int perm32(int rho) { const int n = rho >> 4, i = rho & 15; return 8 * (i >> 2) + 4 * n + (i & 3); }

struct Unit { int pm, pn; };
struct Gemm { const bf16_t* A; const bf16_t* Bt; int M, N, K; };

struct StaticOrder {
    int nM, nN, nwg, G, c;
    __host__ __device__ void init(int M, int N, int G_, int c_) { nM = M / BM; nN = N / BM; nwg = nM * nN; G = G_; c = c_; }
    __host__ __device__ bool next(int i, Unit& u) const {
        const long L = (long)i * G + c; if (L >= nwg) return false;
        int wgid = (int)L; { const int q = nwg / NXCD, r = nwg % NXCD, xcd = wgid % NXCD, off = wgid / NXCD; wgid = (xcd < r ? xcd * (q + 1) : r * (q + 1) + (xcd - r) * q) + off; }
        const int nig = WGM * nN, gid = wgid / nig, fm = gid * WGM, gsz = (nM - fm) < WGM ? (nM - fm) : WGM;
        u.pm = fm + ((wgid % nig) % gsz); u.pn = (wgid % nig) / gsz; return true;
    }
    __device__ __forceinline__ void a_ready(const Unit&) const {}
    __device__ __forceinline__ void done(const Unit&) const {}
};

__device__ __forceinline__ unsigned cvt_pk_bf16(float lo, float hi) { unsigned r; asm volatile("v_cvt_pk_bf16_f32 %0, %1, %2" : "=v"(r) : "v"(lo), "v"(hi)); return r; }
template <class Epi, class Sched, bool ALIGN_EPI = false, bool SP2 = false>
__device__ __forceinline__ void gemm_phase(PG8_LAS unsigned char* lds, const Gemm g, const Sched& S, const Epi& E, int g_wid) {
    int tid_o = (g_wid << 6) | lane_id(); const int tid = tid_o, wid = __builtin_amdgcn_readfirstlane(tid >> 6), lane = tid & 63, wr = wid >> 2, wc = wid & 3, fr = lane & 15, fq = lane >> 4;
    const int K = g.K, nt = K / BK;
    unsigned voffA[2], voffB[2];
#pragma unroll
    for (int i = 0; i < 2; ++i) { int R, C; stage_rc(tid * 16 + i * 8192, R, C); const int Rb = Epi::PERM ? ((R & ~31) + perm32(R & 31)) : R;
        voffA[i] = (unsigned)(R * K + C) * 2u; voffB[i] = (unsigned)(Rb * K + C) * 2u; }
    const size_t kstep = (size_t)(BK * 2);
    const size_t hstep = (size_t)HALF * K * 2;
    const size_t tstep = 2 * hstep;
    const unsigned ldsw = (unsigned)wid * 1024u;
    const int aoff = lds_byte(wr * 64 + fr, fq * 8), boff = lds_byte(wc * 32 + fr, fq * 8);
#define PG8_SA(b, h) (((b) * 2 + (h)) * HTB)
#define PG8_SB(b, h) ((4 + (b) * 2 + (h)) * HTB)
#define PG8_STAGE(bufoff, gbase, voff) do { _Pragma("unroll") for (int _i = 0; _i < 2; ++_i) \
        __builtin_amdgcn_global_load_lds((const unsigned*)((const char*)(gbase) + (voff)[_i]), (PG8_LAS unsigned*)(lds + (bufoff) + ldsw + _i * 8192), 16, 0, 0); } while (0)
#define PG8_LDA(dst, b, h) do { _Pragma("unroll") for (int m = 0; m < 4; ++m) _Pragma("unroll") for (int k = 0; k < 2; ++k) dst[m][k] = *(const PG8_LAS bf16x8*)(lds + PG8_SA(b, h) + aoff + m * 2048 + k * 1024); } while (0)
#define PG8_LDB(dst, b, h) do { _Pragma("unroll") for (int n = 0; n < 2; ++n) _Pragma("unroll") for (int k = 0; k < 2; ++k) dst[n][k] = *(const PG8_LAS bf16x8*)(lds + PG8_SB(b, h) + boff + n * 2048 + k * 1024); } while (0)
#define PG8_MMA(ai, bj, At, Bt) do { __builtin_amdgcn_s_setprio(1); _Pragma("unroll") for (int m = 0; m < 4; ++m) _Pragma("unroll") for (int n = 0; n < 2; ++n) _Pragma("unroll") for (int k = 0; k < 2; ++k) \
        acc[ai][bj][m][n] = __builtin_amdgcn_mfma_f32_16x16x32_bf16(Bt[n][k], At[m][k], acc[ai][bj][m][n], 0, 0, 0); __builtin_amdgcn_s_setprio(0); } while (0)
#define PG8_WAIT_V(n) asm volatile("s_waitcnt vmcnt(" #n ")" ::: "memory")
#define PG8_WAIT_L(n) asm volatile("s_waitcnt lgkmcnt(" #n ")" ::: "memory")
#define PG8_BAR __builtin_amdgcn_s_barrier()
#define PG8_SCHED __builtin_amdgcn_sched_barrier(0)
    Unit cur, nxt; int ui = 0;
    if (!S.next(0, cur)) return;
    f32x4 acc[2][2][4][2];
#pragma unroll
    for (int a = 0; a < 2; ++a)
#pragma unroll
        for (int b = 0; b < 2; ++b)
#pragma unroll
            for (int m = 0; m < 4; ++m)
#pragma unroll
                for (int n = 0; n < 2; ++n) acc[a][b][m][n] = (f32x4){0.f, 0.f, 0.f, 0.f};
    bf16x8 At[4][2], B0[2][2], B1[2][2];
    const char* cA = (const char*)g.A + (size_t)cur.pm * tstep; const char* cB = (const char*)g.Bt + (size_t)cur.pn * tstep;
    S.a_ready(cur);
    if constexpr (SP2) {
        PG8_STAGE(PG8_SB(0, 0), cB, voffB); PG8_STAGE(PG8_SB(0, 1), cB + hstep, voffB); PG8_STAGE(PG8_SA(0, 0), cA, voffA); PG8_STAGE(PG8_SA(0, 1), cA + hstep, voffA);
        if (wr == 1) PG8_BAR;
        PG8_WAIT_V(2); PG8_BAR;
        PG8_STAGE(PG8_SB(1, 0), cB + kstep, voffB); PG8_STAGE(PG8_SA(1, 0), cA + kstep, voffA); PG8_STAGE(PG8_SB(1, 1), cB + hstep + kstep, voffB);
        PG8_WAIT_V(6); PG8_BAR;
    } else {
        PG8_STAGE(PG8_SB(0, 0), cB, voffB); PG8_STAGE(PG8_SA(0, 0), cA, voffA); PG8_STAGE(PG8_SB(0, 1), cB + hstep, voffB); PG8_STAGE(PG8_SA(0, 1), cA + hstep, voffA);
        if (wr == 1) PG8_BAR;
        PG8_WAIT_V(4); PG8_BAR;
        PG8_STAGE(PG8_SB(1, 0), cB + kstep, voffB); PG8_STAGE(PG8_SA(1, 0), cA + kstep, voffA); PG8_STAGE(PG8_SB(1, 1), cB + hstep + kstep, voffB);
        PG8_WAIT_V(6); PG8_BAR;
    }
    for (;;) {
        const bool has_next = S.next(ui + 1, nxt);
        const char* nA = has_next ? (const char*)g.A + (size_t)nxt.pm * tstep : cA; const char* nB = has_next ? (const char*)g.Bt + (size_t)nxt.pn * tstep : cB;
        for (int t = 0; t < nt; t += 2) {
            const bool last = (t == nt - 2);
            const char* a1 = cA + (size_t)(t + 1) * kstep;
            const char* a2 = last ? nA : cA + (size_t)(t + 2) * kstep; const char* b2 = last ? nB : cB + (size_t)(t + 2) * kstep;
            const char* a3 = a2 + kstep; const char* b3 = b2 + kstep;
            if (last && has_next) S.a_ready(nxt);
            if constexpr (SP2) {
            PG8_LDB(B0, 0, 0); PG8_LDB(B1, 0, 1); PG8_SCHED; PG8_LDA(At, 0, 0); PG8_STAGE(PG8_SA(1, 1), a1 + hstep, voffA);
            PG8_WAIT_V(8); PG8_WAIT_L(0); PG8_BAR; PG8_MMA(0, 0, At, B0); PG8_MMA(0, 1, At, B1); PG8_BAR; PG8_SCHED;
            PG8_LDA(At, 0, 1); PG8_STAGE(PG8_SB(0, 0), b2, voffB); PG8_STAGE(PG8_SB(0, 1), b2 + hstep, voffB); PG8_STAGE(PG8_SA(0, 0), a2, voffA);
            PG8_WAIT_V(8); PG8_WAIT_L(0); PG8_BAR; PG8_MMA(1, 0, At, B0); PG8_MMA(1, 1, At, B1); PG8_BAR; PG8_SCHED;
            PG8_LDB(B0, 1, 0); PG8_LDB(B1, 1, 1); PG8_SCHED; PG8_LDA(At, 1, 0); PG8_STAGE(PG8_SA(0, 1), a2 + hstep, voffA);
            PG8_WAIT_V(8); PG8_WAIT_L(0); PG8_BAR; PG8_MMA(0, 0, At, B0); PG8_MMA(0, 1, At, B1); PG8_BAR; PG8_SCHED;
            PG8_LDA(At, 1, 1); PG8_STAGE(PG8_SB(1, 0), b3, voffB); PG8_STAGE(PG8_SB(1, 1), b3 + hstep, voffB); PG8_STAGE(PG8_SA(1, 0), a3, voffA);
            PG8_WAIT_V(8); PG8_WAIT_L(0); PG8_BAR; PG8_MMA(1, 0, At, B0); PG8_MMA(1, 1, At, B1); PG8_BAR; PG8_SCHED;
            } else {
            PG8_LDB(B0, 0, 0); PG8_SCHED; PG8_LDA(At, 0, 0); PG8_STAGE(PG8_SA(1, 1), a1 + hstep, voffA);
            PG8_WAIT_L(8); PG8_BAR; PG8_WAIT_L(0); PG8_MMA(0, 0, At, B0); PG8_BAR; PG8_SCHED;
            PG8_LDB(B1, 0, 1); PG8_STAGE(PG8_SB(0, 0), b2, voffB);
            PG8_BAR; PG8_WAIT_L(0); PG8_MMA(0, 1, At, B1); PG8_BAR;
            PG8_LDA(At, 0, 1); PG8_STAGE(PG8_SA(0, 0), a2, voffA);
            PG8_BAR; PG8_WAIT_L(0); PG8_MMA(1, 0, At, B0); PG8_BAR; PG8_SCHED;
            PG8_STAGE(PG8_SB(0, 1), b2 + hstep, voffB);
            PG8_WAIT_V(6); PG8_BAR; PG8_MMA(1, 1, At, B1); PG8_BAR;
            PG8_LDB(B0, 1, 0); PG8_SCHED; PG8_LDA(At, 1, 0); PG8_STAGE(PG8_SA(0, 1), a2 + hstep, voffA);
            PG8_WAIT_L(8); PG8_BAR; PG8_WAIT_L(0); PG8_MMA(0, 0, At, B0); PG8_BAR; PG8_SCHED;
            PG8_LDB(B1, 1, 1); PG8_STAGE(PG8_SB(1, 0), b3, voffB);
            PG8_BAR; PG8_WAIT_L(0); PG8_MMA(0, 1, At, B1); PG8_BAR;
            PG8_LDA(At, 1, 1); PG8_STAGE(PG8_SA(1, 0), a3, voffA);
            PG8_BAR; PG8_WAIT_L(0); PG8_MMA(1, 0, At, B0); PG8_BAR; PG8_SCHED;
            PG8_STAGE(PG8_SB(1, 1), b3 + hstep, voffB);
            PG8_WAIT_V(6); PG8_BAR; PG8_MMA(1, 1, At, B1); PG8_BAR;
            }
        }
        if constexpr (ALIGN_EPI) { if (wr == 0) PG8_BAR; }
        if constexpr (!Epi::AFTER_DRAIN) { const int le_ = lane_id(); E(acc, cur, wr, wc, le_ & 15, le_ >> 4); S.done(cur); }
        if (!has_next) break;
#pragma unroll
        for (int a = 0; a < 2; ++a)
#pragma unroll
            for (int b = 0; b < 2; ++b)
#pragma unroll
                for (int m = 0; m < 4; ++m)
#pragma unroll
                    for (int n = 0; n < 2; ++n) acc[a][b][m][n] = (f32x4){0.f, 0.f, 0.f, 0.f};
        cur = nxt; cA = nA; cB = nB; ++ui;
        if constexpr (ALIGN_EPI) { if (wr == 1) PG8_BAR; }
    }
    PG8_WAIT_V(0);
    if constexpr (!ALIGN_EPI) { if (wr == 0) PG8_BAR; }
    PG8_BAR;
    if constexpr (Epi::AFTER_DRAIN) { E.fused(acc, cur, wr, wc, fr, fq, lds, wid, lane); S.done(cur); }
#undef PG8_SA
#undef PG8_SB
#undef PG8_STAGE
#undef PG8_LDA
#undef PG8_LDB
#undef PG8_MMA
#undef PG8_WAIT_V
#undef PG8_WAIT_L
#undef PG8_BAR
#undef PG8_SCHED
}
}
using pg8::bf16_t; using pg8::bf16x8; using pg8::f32x4; using pg8::u32x4;
#define LAS __attribute__((address_space(3)))
typedef float f32x16 __attribute__((ext_vector_type(16)));
typedef float f32x2 __attribute__((ext_vector_type(2)));
typedef unsigned u32x2 __attribute__((ext_vector_type(2)));
typedef short v4i16_t __attribute__((ext_vector_type(4)));

constexpr int SEQ = 8192, MREAL = 16384, MALLOC = 16448, DM = 1024, NTHR = 512;
constexpr float EPS = 1e-6f, LOG2E = 1.4426950408889634f;
constexpr size_t R1K = (size_t)MALLOC * 1024 * 2;
constexpr size_t al64k(size_t x) { return (x + 65535) & ~(size_t)65535; }
constexpr size_t WS_CTL = 0, CTL_BYTES = 65536;
constexpr size_t WS_ROPE = CTL_BYTES;
constexpr size_t WS_SSQ = al64k(WS_ROPE + (size_t)8208 * 16 * 8);
constexpr size_t WS_SSQQ = al64k(WS_SSQ + (size_t)MALLOC * 16 * 4);
constexpr size_t WS_SSQKV = al64k(WS_SSQQ + (size_t)MALLOC * 4 * 4);
constexpr size_t WS_XMETA = al64k(WS_SSQKV + (size_t)MALLOC * 4 * 4);
constexpr size_t WS_KR = al64k(WS_XMETA + 65536);
constexpr size_t WS_W = al64k(WS_KR + (size_t)MALLOC * 32 * 2);
constexpr size_t WO_IN = 0, WO_GA = 2097152, WO_GB = 3145728, WO_Q = 4194304, WO_KV = 4390912, WO_A = 4521984, WO_B = 5046272, WO_O = 5570560, WO_UP = 6619136, WO_DN = 10813440, W_ELEMS = 15007744;
constexpr size_t WS_XB = al64k(WS_W + W_ELEMS * 2);
constexpr size_t WS_POOL = al64k(WS_XB + R1K);
constexpr size_t PO_S = 0;
constexpr size_t PO_QA = PO_S, PO_KVA = PO_S + (size_t)MALLOC * 256 * 2;
constexpr size_t PO_AO = R1K, PO_DN = R1K + R1K / 2;
constexpr size_t PO_DQ = 2 * R1K, PO_DK = 2 * R1K + R1K / 2, PO_DV = 3 * R1K, PO_Q = 3 * R1K + R1K / 2, PO_KV = 4 * R1K + R1K / 4;
constexpr size_t PO_YQ = 2 * R1K;
constexpr size_t PO_H = 0;
constexpr size_t WS_END = WS_POOL + 5 * R1K + R1K / 4;
static_assert(WS_END <= (size_t)256 * 1024 * 1024, "workspace map exceeds 256 MiB");

struct Params {
    const float* in[21]; float* out; unsigned char* ws;
};

typedef const Params __attribute__((address_space(4)))* kparams_t;
__device__ __forceinline__ kparams_t kparams() { kparams_t p = (kparams_t)__builtin_amdgcn_kernarg_segment_ptr(); asm volatile("" : "+s"(p)); return p; }
#define KPAR kparams()
__device__ __forceinline__ unsigned cvt_pk(float lo, float hi) { return pg8::cvt_pk_bf16(lo, hi); }
__device__ __forceinline__ u32x2 pk4(f32x4 v) { u32x2 r; r.x = cvt_pk(v[0], v[1]); r.y = cvt_pk(v[2], v[3]); return r; }
__device__ __forceinline__ float bf2f(unsigned short b) { return __uint_as_float((unsigned)b << 16); }
__device__ __forceinline__ f32x4 ld_bf4(const bf16_t* p) { const u32x2 w = *(const u32x2*)p; return (f32x4){__uint_as_float(w.x << 16), __uint_as_float(w.x & 0xffff0000u), __uint_as_float(w.y << 16), __uint_as_float(w.y & 0xffff0000u)}; }
__device__ __forceinline__ u32x4 pk8(f32x4 a, f32x4 b) { const u32x2 x = pk4(a), y = pk4(b); return (u32x4){x.x, x.y, y.x, y.y}; }
__device__ __forceinline__ void ld_bf8(const bf16_t* p, f32x4& a, f32x4& b) { const u32x4 w = *(const u32x4*)p;
    a = (f32x4){__uint_as_float(w.x << 16), __uint_as_float(w.x & 0xffff0000u), __uint_as_float(w.y << 16), __uint_as_float(w.y & 0xffff0000u)};
    b = (f32x4){__uint_as_float(w.z << 16), __uint_as_float(w.z & 0xffff0000u), __uint_as_float(w.w << 16), __uint_as_float(w.w & 0xffff0000u)}; }
__device__ __forceinline__ float sum4v(f32x4 a) { return (a[0] + a[1]) + (a[2] + a[3]); }
__device__ __forceinline__ float sumsq4(f32x4 a) { return (a[0] * a[0] + a[1] * a[1]) + (a[2] * a[2] + a[3] * a[3]); }
__device__ __forceinline__ float sum16p(const float* p) { const f32x4* q = (const f32x4*)p; return (sum4v(q[0]) + sum4v(q[1])) + (sum4v(q[2]) + sum4v(q[3])); }
__device__ __forceinline__ float sum4p(const float* p) { return sum4v(*(const f32x4*)p); }
__device__ __forceinline__ float shx(float v, int mask) { const int l = lane_id(); return __int_as_float(__builtin_amdgcn_ds_bpermute((l ^ mask) << 2, __float_as_int(v))); }
__device__ __forceinline__ float half_max(float v) { const auto rr = __builtin_amdgcn_permlane32_swap(__float_as_uint(v), __float_as_uint(v), false, false); return fmaxf(__uint_as_float(rr[0]), __uint_as_float(rr[1])); }
__device__ __forceinline__ float half_sum(float v) { const auto rr = __builtin_amdgcn_permlane32_swap(__float_as_uint(v), __float_as_uint(v), false, false); return __uint_as_float(rr[0]) + __uint_as_float(rr[1]); }
__device__ __forceinline__ float wave_sum(float v) {
#pragma unroll
    for (int o = 1; o < 64; o <<= 1) v += shx(v, o);
    return v;
}
__device__ __forceinline__ float fq_sum(float s) { s += shx(s, 16); s += shx(s, 32); return s; }
__device__ __forceinline__ int tok_pos(int row) { return row < MREAL ? 16 + (row & (SEQ - 1)) : row - MREAL; }
__device__ __forceinline__ float sigmoidf_(float z) { return __builtin_amdgcn_rcpf(1.0f + __builtin_amdgcn_exp2f(-LOG2E * z)); }

struct REWin {
    static constexpr bool PERM = false; static constexpr int NP = 16, FENCE = 0, KMAX = 1; const float* ssq; unsigned* kmax_word; __device__ __forceinline__ const float* nsrc() const { return ssq; } bf16_t *QA, *KVA, *KR, *DQ, *DK, *DVv; float *ssqq, *ssqkv; const f32x2* rope;
    __device__ __forceinline__ void row(int row, int pn, int wc, int fq, f32x4 (&v)[2][2], float rstd) const {
#pragma unroll
        for (int bj = 0; bj < 2; ++bj)
#pragma unroll
            for (int n = 0; n < 2; ++n) v[bj][n] = v[bj][n] * rstd;
        const int cw = 32 * wc + 4 * fq;
        if (pn == 0) {
            float s = 0.f;
#pragma unroll
            for (int bj = 0; bj < 2; ++bj)
#pragma unroll
                for (int n = 0; n < 2; ++n) { *(u32x2*)(QA + (size_t)row * 256 + 128 * bj + cw + 16 * n) = pk4(v[bj][n]); s += sumsq4(v[bj][n]); }
            s = fq_sum(s); if (fq == 0) ssqq[(size_t)row * 4 + wc] = s;
        } else if (pn == 1) {
            float s = 0.f;
#pragma unroll
            for (int n = 0; n < 2; ++n) { *(u32x2*)(KVA + (size_t)row * 128 + cw + 16 * n) = pk4(v[0][n]); s += sumsq4(v[0][n]); }
            s = fq_sum(s); if (fq == 0) ssqkv[(size_t)row * 4 + wc] = s;
            if (wc == 0) {
                const f32x2* t = rope + (size_t)tok_pos(row) * 16 + 4 * fq; f32x4 a, b;
#pragma unroll
                for (int i = 0; i < 4; ++i) { const f32x2 cs = t[i]; a[i] = v[1][0][i] * cs.x - v[1][1][i] * cs.y; b[i] = v[1][0][i] * cs.y + v[1][1][i] * cs.x; }
                *(u32x2*)(KR + (size_t)row * 32 + 4 * fq) = pk4(a); *(u32x2*)(KR + (size_t)row * 32 + 16 + 4 * fq) = pk4(b);
            }
        } else {
            bf16_t* dst = DQ + (size_t)((pn - 2) >> 1) * ((size_t)MALLOC * 512); const float sc = pn < 4 ? 0.125f * LOG2E : 1.0f; const int c0 = (pn & 1) * 256;
#pragma unroll
            for (int bj = 0; bj < 2; ++bj)
#pragma unroll
                for (int n = 0; n < 2; ++n) *(u32x2*)(dst + (size_t)row * 512 + c0 + 128 * bj + cw + 16 * n) = pk4(v[bj][n] * sc);
        }
    }
};
struct REQup {
    static constexpr bool PERM = false; static constexpr int NP = 4, FENCE = 0, KMAX = 0; const float* ssqq; bf16_t* Q; const f32x2* rope; __device__ __forceinline__ const float* nsrc() const { return ssqq; }
    __device__ __forceinline__ void row(int row, int pn, int wc, int fq, f32x4 (&v)[2][2], float rstd) const {
        const float sc = rstd * (0.10206207261596577f * LOG2E);
#pragma unroll
        for (int bj = 0; bj < 2; ++bj) {
            const int g32 = 256 * pn + 128 * bj + 32 * wc; f32x4 a = v[bj][0] * sc, b = v[bj][1] * sc;
            if ((g32 % 96) == 64) {
                const f32x2* t = rope + (size_t)tok_pos(row) * 16 + 4 * fq; f32x4 a2, b2;
#pragma unroll
                for (int i = 0; i < 4; ++i) { const f32x2 cs = t[i]; a2[i] = a[i] * cs.x - b[i] * cs.y; b2[i] = a[i] * cs.y + b[i] * cs.x; }
                a = a2; b = b2;
            }
            *(u32x2*)(Q + (size_t)row * 768 + g32 + 4 * fq) = pk4(a); *(u32x2*)(Q + (size_t)row * 768 + g32 + 16 + 4 * fq) = pk4(b);
        }
    }
};
struct REKVup {
    static constexpr bool PERM = true; static constexpr int NP = 4, FENCE = 0, KMAX = 0; const float* ssqkv; bf16_t* KV; __device__ __forceinline__ const float* nsrc() const { return ssqkv; }
    __device__ __forceinline__ void row(int row, int pn, int wc, int fq, f32x4 (&v)[2][2], float rstd) const {
        const float sc = rstd;
#pragma unroll
        for (int bj = 0; bj < 2; ++bj) *(u32x4*)(KV + (size_t)row * 1024 + 256 * pn + 128 * bj + 32 * wc + 8 * fq) = pk8(v[bj][0] * sc, v[bj][1] * sc);
    }
};
struct REStore {
    static constexpr bool PERM = true; static constexpr int NP = 0, FENCE = 0, KMAX = 0; bf16_t* O; __device__ __forceinline__ const float* nsrc() const { return nullptr; }
    __device__ __forceinline__ void row(int row, int pn, int wc, int fq, f32x4 (&v)[2][2], float rstd) const {
#pragma unroll
        for (int bj = 0; bj < 2; ++bj) *(u32x4*)(O + (size_t)row * 1024 + 256 * pn + 128 * bj + 32 * wc + 8 * fq) = pk8(v[bj][0], v[bj][1]);
    }
};
struct REGate {
    static constexpr bool PERM = true; static constexpr int NP = 16, FENCE = 1, KMAX = 0; const float* ssq; const float* bias; bf16_t* Y; const bf16_t* T; int add; __device__ __forceinline__ const float* nsrc() const { return ssq; }
    __device__ __forceinline__ void row(int row, int pn, int wc, int fq, f32x4 (&v)[2][2], float rstd) const {
#pragma unroll
        for (int bj = 0; bj < 2; ++bj) {
            const int col = 256 * pn + 128 * bj + 32 * wc + 8 * fq; const f32x4 b0 = *(const f32x4*)(bias + col), b1 = *(const f32x4*)(bias + col + 4);
            f32x4 g0, g1;
#pragma unroll
            for (int i = 0; i < 4; ++i) { g0[i] = sigmoidf_(v[bj][0][i] * rstd + b0[i]); g1[i] = sigmoidf_(v[bj][1][i] * rstd + b1[i]); }
            bf16_t* yp = Y + (size_t)row * 1024 + col; f32x4 y0, y1; ld_bf8(yp, y0, y1);
            f32x4 r0, r1; if (add) { f32x4 t0, t1; ld_bf8(T + (size_t)row * 1024 + col, t0, t1); r0 = y0 + g0 * t0; r1 = y1 + g1 * t1; } else { r0 = g0 * y0; r1 = g1 * y1; }
            *(u32x4*)yp = pk8(r0, r1);
        }
    }
};
struct REResid {
    static constexpr bool PERM = true; static constexpr int NP = 0, FENCE = 1, KMAX = 0; const float* base_main; const float* base_meta; float* out_main; float* out_meta; bf16_t* XB; float* ssq; __device__ __forceinline__ const float* nsrc() const { return nullptr; }
    __device__ __forceinline__ void row(int row, int pn, int wc, int fq, f32x4 (&v)[2][2], float rstd) const {
        const float* bp = row < MREAL ? base_main + (size_t)row * 1024 : base_meta + (size_t)(row - MREAL) * 1024;
        float* op = row < MREAL ? out_main + (size_t)row * 1024 : out_meta + (size_t)(row - MREAL) * 1024;
        float s = 0.f;
#pragma unroll
        for (int bj = 0; bj < 2; ++bj) {
            const int col = 256 * pn + 128 * bj + 32 * wc + 8 * fq;
            const f32x4 x0 = *(const f32x4*)(bp + col) + v[bj][0], x1 = *(const f32x4*)(bp + col + 4) + v[bj][1];
            *(f32x4*)(op + col) = x0; *(f32x4*)(op + col + 4) = x1; *(u32x4*)(XB + (size_t)row * 1024 + col) = pk8(x0, x1); s += sumsq4(x0) + sumsq4(x1);
        }
        s = fq_sum(s); if (fq == 0) ssq[(size_t)row * 16 + pn * 4 + wc] = s;
    }
};
struct REUp {
    static constexpr bool PERM = true; static constexpr int NP = 16, FENCE = 0, KMAX = 0; const float* ssq; bf16_t* H; __device__ __forceinline__ const float* nsrc() const { return ssq; }
    __device__ __forceinline__ void row(int row, int pn, int wc, int fq, f32x4 (&v)[2][2], float rstd) const {
#pragma unroll
        for (int bj = 0; bj < 2; ++bj) { f32x4 t0 = v[bj][0] * rstd, t1 = v[bj][1] * rstd;
#pragma unroll
            for (int i = 0; i < 4; ++i) { const float r0 = fmaxf(t0[i], 0.f), r1 = fmaxf(t1[i], 0.f); t0[i] = r0 * r0; t1[i] = r1 * r1; }
            *(u32x4*)(H + (size_t)row * 4096 + 256 * pn + 128 * bj + 32 * wc + 8 * fq) = pk8(t0, t1); }
    }
};
template <int NP> __device__ __forceinline__ float row_part(const float* p, int row, int fq) {
    if (NP == 16) return sum4v(*(const f32x4*)(p + (size_t)row * 16 + 4 * fq));
    if (NP == 4) return p[(size_t)row * 4 + fq];
    return 0.f;
}
template <int NP> __device__ __forceinline__ float row_rstd(float part) {
    if (NP == 0) return 1.0f;
    const float tot = fq_sum(part);
    return rsqrtf(tot * (NP == 16 ? (1.0f / 1024.0f) : 1.0f) + EPS);
}
template <class RE> struct EpiRows {
    static constexpr bool PERM = RE::PERM, AFTER_DRAIN = false; RE e; float inv_n;
    __device__ __forceinline__ void operator()(const f32x4 (&acc)[2][2][4][2], const pg8::Unit& u, int wr, int wc, int fr, int fq) const {
        float rs[2][4];
        if (RE::NP != 0) {
            const float* ns = e.nsrc(); float part[2][4];
#pragma unroll
            for (int ai = 0; ai < 2; ++ai)
#pragma unroll
                for (int m = 0; m < 4; ++m) part[ai][m] = row_part<RE::NP>(ns, u.pm * 256 + ai * 128 + wr * 64 + m * 16 + fr, fq);
#pragma unroll
            for (int ai = 0; ai < 2; ++ai)
#pragma unroll
                for (int m = 0; m < 4; ++m) rs[ai][m] = rsqrtf(fq_sum(part[ai][m]) * inv_n + EPS);
        }
#pragma unroll
        for (int ai = 0; ai < 2; ++ai)
#pragma unroll
            for (int m = 0; m < 4; ++m) { f32x4 v[2][2] = {{acc[ai][0][m][0], acc[ai][0][m][1]}, {acc[ai][1][m][0], acc[ai][1][m][1]}};
                e.row(u.pm * 256 + ai * 128 + wr * 64 + m * 16 + fr, u.pn, wc, fq, v, RE::NP != 0 ? rs[ai][m] : 1.0f);
                if (RE::FENCE && (m & 1)) asm volatile("" ::: "memory"); }
        if constexpr (RE::KMAX != 0) { if (u.pn == 4 || u.pn == 5) {
            float kmx = 0.f;
#pragma unroll
            for (int ai = 0; ai < 2; ++ai)
#pragma unroll
                for (int m = 0; m < 4; ++m)
#pragma unroll
                    for (int bj = 0; bj < 2; ++bj) kmx = fmaxf(kmx, fq_sum(sumsq4(acc[ai][bj][m][0]) + sumsq4(acc[ai][bj][m][1])) * rs[ai][m] * rs[ai][m]);
#pragma unroll
            for (int o = 1; o < 16; o <<= 1) kmx = fmaxf(kmx, shx(kmx, o));
            if (lane_id() == 0) atomicMax(e.kmax_word, __float_as_uint(kmx)); } }
    }
};
template <class RE> __device__ __forceinline__ void meta_gemm(LAS unsigned char* lds, const bf16_t* A, const bf16_t* Bt, int N, int K, const RE& e, float inv_n, int g_wid) {
    int tid_o = (g_wid << 6) | lane_id(); const int tid = tid_o, wid = tid >> 6, lane = tid & 63, fr = lane & 15, fq = lane >> 4;
    const bf16_t* A16 = A + (size_t)MREAL * K;
    for (int u = blockIdx.x; u < N / 64; u += gridDim.x) {
        const int pn = u >> 2, wc = u & 3;
        f32x4 acc[2][2];
#pragma unroll
        for (int bj = 0; bj < 2; ++bj)
#pragma unroll
            for (int n = 0; n < 2; ++n) acc[bj][n] = (f32x4){0.f, 0.f, 0.f, 0.f};
        const int nst = K >= 256 ? K / 256 : 1, nwv = K >= 256 ? 8 : K / 32;
#pragma unroll 4
        for (int s = 0; s < (wid < nwv ? nst : 0); ++s) {
            const int k0 = (wid * nst + s) * 32 + 8 * fq;
            const bf16x8 a = *(const bf16x8*)(A16 + (size_t)fr * K + k0);
#pragma unroll
            for (int bj = 0; bj < 2; ++bj)
#pragma unroll
                for (int n = 0; n < 2; ++n) { const bf16x8 b = *(const bf16x8*)(Bt + (size_t)(256 * pn + 128 * bj + 32 * wc + (RE::PERM ? 8 * (fr >> 2) + 4 * n + (fr & 3) : 16 * n + fr)) * K + k0);
                    acc[bj][n] = __builtin_amdgcn_mfma_f32_16x16x32_bf16(b, a, acc[bj][n], 0, 0, 0); }
        }
        LAS f32x4* red = (LAS f32x4*)lds;
#pragma unroll
        for (int bj = 0; bj < 2; ++bj)
#pragma unroll
            for (int n = 0; n < 2; ++n) red[(wid * 4 + bj * 2 + n) * 64 + lane] = acc[bj][n];
        __syncthreads();
        if (wid == 0) {
            f32x4 v[2][2];
#pragma unroll
            for (int bj = 0; bj < 2; ++bj)
#pragma unroll
                for (int n = 0; n < 2; ++n) { f32x4 s = red[(bj * 2 + n) * 64 + lane];
#pragma unroll
                    for (int w = 1; w < 8; ++w) s = s + red[(w * 4 + bj * 2 + n) * 64 + lane];
                    v[bj][n] = s; }
            float rstd = 1.0f;
            if (RE::NP != 0) rstd = rsqrtf(fq_sum(row_part<RE::NP>(e.nsrc(), MREAL + fr, fq)) * inv_n + EPS);
            e.row(MREAL + fr, pn, wc, fq, v, rstd);
            if constexpr (RE::KMAX != 0) { if (pn == 4 || pn == 5) { float kmx = 0.f;
#pragma unroll
                for (int bj = 0; bj < 2; ++bj) kmx = fmaxf(kmx, fq_sum(sumsq4(v[bj][0]) + sumsq4(v[bj][1])));
#pragma unroll
                for (int o = 1; o < 16; o <<= 1) kmx = fmaxf(kmx, shx(kmx, o));
                if (lane == 0) atomicMax(e.kmax_word, __float_as_uint(kmx)); } }
        }
        __syncthreads();
    }
}
template <class RE> __device__ __forceinline__ void gemm_all(LAS unsigned char* lds, const bf16_t* A, const bf16_t* Bt, int N, int K, const RE& e, bool do_meta, int g_wid) {
    asm volatile("" : "+s"(A), "+s"(Bt));
    if (do_meta) meta_gemm<RE>(lds, A, Bt, N, K, e, 1.0f / (float)K, g_wid);
    pg8::Gemm g{A, Bt, MREAL, N, K}; pg8::StaticOrder S; S.init(MREAL, N, (int)gridDim.x, (int)blockIdx.x);
    EpiRows<RE> E{e, 1.0f / (float)K};
    pg8::gemm_phase<EpiRows<RE>, pg8::StaticOrder, true, true>(lds, g, S, E, g_wid);
}

__device__ __forceinline__ unsigned f2bf(float f) { unsigned u = __float_as_uint(f); return (u + 0x7fffu + ((u >> 16) & 1u)) >> 16; }
__device__ __forceinline__ unsigned pk2(float lo, float hi) { return f2bf(lo) | (f2bf(hi) << 16); }
__device__ __forceinline__ void transpose_item(const float* W, int ldw, int K, int col0, int ncolblk, bf16_t* WT, int row0, const float* gain, int gmask, float gscale, LAS float* scr, int item, int lane) {
    const int kb = item / ncolblk, nb = item % ncolblk, k0 = 64 * kb, n0 = 32 * nb;
#pragma unroll
    for (int i = 0; i < 8; ++i) { const int kk = 8 * i + (lane >> 3), c4 = (lane & 7) * 4; const float g = gain ? gain[(k0 + kk) & gmask] * gscale : 1.0f;
        const f32x4 w4 = *(const f32x4*)(W + (size_t)(k0 + kk) * ldw + col0 + n0 + c4);
        LAS float* d = scr + kk * 33 + c4; d[0] = w4[0] * g; d[1] = w4[1] * g; d[2] = w4[2] * g; d[3] = w4[3] * g; }
    asm volatile("s_waitcnt lgkmcnt(0)" ::: "memory");
    const int c = lane & 7;
#pragma unroll
    for (int j = 0; j < 4; ++j) { const int n = (lane >> 3) + 8 * j; const LAS float* s = scr + (8 * c) * 33 + n;
        u32x4 o; o.x = pk2(s[0 * 33], s[1 * 33]); o.y = pk2(s[2 * 33], s[3 * 33]); o.z = pk2(s[4 * 33], s[5 * 33]); o.w = pk2(s[6 * 33], s[7 * 33]);
        *(u32x4*)(WT + (size_t)(row0 + n0 + n) * K + k0 + 8 * c) = o; }
    asm volatile("s_waitcnt lgkmcnt(0)" ::: "memory");
}
__device__ __forceinline__ void convert_weights(const Params& P, int l, LAS unsigned char* lds, int g_wid) {
    int tid_o = (g_wid << 6) | lane_id(); const int tid = tid_o, wid = tid >> 6, lane = tid & 63;
    LAS float* scr = (LAS float*)(lds + wid * 16384);
    bf16_t* W = (bf16_t*)(KPAR->ws + WS_W);
    const float* w_in = KPAR->in[3] + (size_t)l * 1024 * 4000; const float* attn_norm = KPAR->in[2] + l * 1024;
    const float* w_q = KPAR->in[6] + (size_t)l * 256 * 768; const float* qn = KPAR->in[5] + l * 256;
    const float* w_kv = KPAR->in[8] + (size_t)l * 128 * 1024; const float* kvn = KPAR->in[7] + l * 128;
    const float* w_a = KPAR->in[14] + (size_t)l * 512 * 1024; const float* w_b = KPAR->in[15] + (size_t)l * 512 * 1024; const float* subln = KPAR->in[13] + l * 128;
    const float* w_o = KPAR->in[16] + (size_t)l * 1024 * 1024; const float* mlpn = KPAR->in[17] + l * 1024;
    const float* w_up = KPAR->in[18] + (size_t)l * 1024 * 4096; const float* w_dn = KPAR->in[19] + (size_t)l * 4096 * 1024;
    const float lam_scale = 1.0f - (l == 0 ? 0.2f : 0.35550907f);
    const int gw = blockIdx.x * 8 + wid, NGW = gridDim.x * 8;
    constexpr int NITEMS = 208 + 768 + 512 + 512 + 96 + 64 + 256 + 256 + 512 + 2048 + 2048;
    for (int it = gw; it < NITEMS; it += NGW) {
        int r = it;
        if (r < 208) { transpose_item(w_in, 4000, 1024, 0, 13, W + WO_IN, 0, attn_norm, 1023, 1.f, scr, r, lane); continue; } r -= 208;
        if (r < 768) { transpose_item(w_in, 4000, 1024, 416, 48, W + WO_IN, 512, attn_norm, 1023, 1.f, scr, r, lane); continue; } r -= 768;
        if (r < 512) { transpose_item(w_in, 4000, 1024, 1952, 32, W + WO_GA, 0, attn_norm, 1023, 1.f, scr, r, lane); continue; } r -= 512;
        if (r < 512) { transpose_item(w_in, 4000, 1024, 2976, 32, W + WO_GB, 0, attn_norm, 1023, 1.f, scr, r, lane); continue; } r -= 512;
        if (r < 96) { transpose_item(w_q, 768, 256, 0, 24, W + WO_Q, 0, qn, 255, 1.f, scr, r, lane); continue; } r -= 96;
        if (r < 64) { transpose_item(w_kv, 1024, 128, 0, 32, W + WO_KV, 0, kvn, 127, 1.f, scr, r, lane); continue; } r -= 64;
        if (r < 256) { transpose_item(w_a, 1024, 512, 0, 32, W + WO_A, 0, nullptr, 0, 1.f, scr, r, lane); continue; } r -= 256;
        if (r < 256) { transpose_item(w_b, 1024, 512, 0, 32, W + WO_B, 0, subln, 127, lam_scale, scr, r, lane); continue; } r -= 256;
        if (r < 512) { transpose_item(w_o, 1024, 1024, 0, 32, W + WO_O, 0, nullptr, 0, 1.f, scr, r, lane); continue; } r -= 512;
        if (r < 2048) { transpose_item(w_up, 4096, 1024, 0, 128, W + WO_UP, 0, mlpn, 1023, 1.f, scr, r, lane); continue; } r -= 2048;
        transpose_item(w_dn, 1024, 4096, 0, 32, W + WO_DN, 0, nullptr, 0, 1.f, scr, r, lane);
    }
}
__device__ __forceinline__ void prologue_x(const Params& P, int g_wid) {
    int tid_o = (g_wid << 6) | lane_id(); const int tid = tid_o, wid = tid >> 6, lane = tid & 63;
    const int gw = blockIdx.x * 8 + wid, NGW = gridDim.x * 8;
    bf16_t* XB = (bf16_t*)(KPAR->ws + WS_XB); float* ssq = (float*)(KPAR->ws + WS_SSQ);
    for (int row = gw; row < MREAL + 16; row += NGW) {
        const float* src = row < MREAL ? KPAR->in[0] + (size_t)row * 1024 : KPAR->in[1] + (size_t)(row - MREAL) * 1024;
        float s = 0.f;
#pragma unroll
        for (int j = 0; j < 4; ++j) { const f32x4 v = ((const f32x4*)src)[64 * j + lane]; s += sumsq4(v); ((u32x2*)(XB + (size_t)row * 1024))[64 * j + lane] = pk4(v); }
        s = wave_sum(s);
        if (lane < 16) ssq[(size_t)row * 16 + lane] = lane == 0 ? s : 0.f;
    }
    { bf16_t* W = (bf16_t*)(KPAR->ws + WS_W);
      for (int i = blockIdx.x * NTHR + tid; i < 96 * 1024 / 8; i += gridDim.x * NTHR) ((u32x4*)(W + WO_IN + 416 * 1024))[i] = (u32x4){0u, 0u, 0u, 0u}; }
    f32x2* rope = (f32x2*)(KPAR->ws + WS_ROPE);
    for (int e = blockIdx.x * NTHR + tid; e < 8208 * 16; e += gridDim.x * NTHR) {
        const int pos = e >> 4, i = e & 15, i4 = i & 3, i16 = i >> 2;
        const float c4 = i4 == 0 ? 1.0f : (i4 == 1 ? 0.56234132519f : (i4 == 2 ? 0.31622776602f : 0.17782794100f));
        const float s16 = i16 == 0 ? 1.0f : (i16 == 1 ? 0.1f : (i16 == 2 ? 0.01f : 0.001f));
        const float inv = c4 * s16; const float ang = (float)pos * inv;
        const double x = (double)ang; const double nq = __builtin_rint(x * 0.63661977236758134308); const double r = __builtin_fma(-nq, 1.57079632679489661923, x);
        const double r2 = r * r;
        const double sn = r * (1.0 + r2 * (-1.0 / 6 + r2 * (1.0 / 120 + r2 * (-1.0 / 5040 + r2 * (1.0 / 362880 + r2 * (-1.0 / 39916800 + r2 * (1.0 / 6227020800.0)))))));
        const double cs = 1.0 + r2 * (-0.5 + r2 * (1.0 / 24 + r2 * (-1.0 / 720 + r2 * (1.0 / 40320 + r2 * (-1.0 / 3628800 + r2 * (1.0 / 479001600.0 + r2 * (-1.0 / 87178291200.0)))))));
        const int q = ((int)nq) & 3;
        const double c = q == 0 ? cs : (q == 1 ? -sn : (q == 2 ? -cs : sn));
        const double s = q == 0 ? sn : (q == 1 ? cs : (q == 2 ? -sn : -cs));
        rope[e] = (f32x2){(float)c, (float)s};
    }
}
constexpr int AT_KBUF = 12288, AT_VBUF = 16384, AT_K = 0, AT_V = 2 * AT_KBUF, AT_ASC = AT_V + 3 * AT_VBUF, AT_QW = AT_ASC + 1024;
__device__ __forceinline__ int crow(int r, int hi) { return (r & 3) + 8 * (r >> 2) + 4 * hi; }
#define MFMA32(a, b, c) __builtin_amdgcn_mfma_f32_32x32x16_bf16((a), (b), (c), 0, 0, 0)
template <int DQK, int DV, bool ALIBI>
__device__ __forceinline__ void attn_pass(LAS unsigned char* lds, const bf16_t* Qp, int qpitch, const bf16_t* K1, int k1pitch, const bf16_t* K2, int k2pitch,
                                          const bf16_t* Vp, int vpitch, int brow0, int NT, int qreal0, int meta, float sl2, float kmax, f32x16 (&o)[DV / 32], int g_wid) {
    constexpr int NCH = DQK / 8, NDS = DQK / 16, NDB = DV / 32, VCH = DV / 8, KP = (64 * NCH + 511) / 512, VP = (64 * VCH) / 512;
    int tid_o = (g_wid << 6) | lane_id(); const int tid = tid_o, lane = tid & 63, wid = __builtin_amdgcn_readfirstlane(tid >> 6), r32 = lane & 31, hi = lane >> 5;
    bf16x8 qf[NDS];
    { const bf16_t* qrow = Qp + (size_t)(32 * wid + r32) * qpitch + 8 * hi;
#pragma unroll
      for (int ds = 0; ds < NDS; ++ds) qf[ds] = *(const bf16x8*)(qrow + 16 * ds); }
    const bf16_t* ksrc[KP]; int kpit[KP]; unsigned kdst[KP]; bool kval[KP];
#pragma unroll
    for (int i = 0; i < KP; ++i) { const int p = tid + 512 * i; kval[i] = p < 64 * NCH; const int pp = kval[i] ? p : 0; const int key = pp / NCH, c = pp % NCH;
        if (NCH <= 8 || c < 8) { ksrc[i] = K1 + (size_t)key * k1pitch + c * 8; kpit[i] = k1pitch; } else { ksrc[i] = K2 + (size_t)key * k2pitch + (c - 8) * 8; kpit[i] = k2pitch; }
        kdst[i] = AT_K + c * 1024 + ((key ^ c) << 4); }
    const bf16_t* vsrc[VP]; unsigned vdst[VP];
#pragma unroll
    for (int i = 0; i < VP; ++i) { const int p = tid + 512 * i; const int key = p / VCH, c = p % VCH; vsrc[i] = Vp + (size_t)key * vpitch + c * 8; vdst[i] = AT_V + (c >> 2) * 4096 + key * 64 + (c & 3) * 16; }
    u32x4 kregA[KP], vregA[VP];
#define AT_ISSUE(t, KR_, VR_) do { const size_t kb_ = (size_t)((t) == 0 ? MREAL : brow0 + 64 * ((t) - 1)); \
        _Pragma("unroll") for (int i = 0; i < KP; ++i) if (kval[i]) KR_[i] = *(const u32x4*)(ksrc[i] + kb_ * kpit[i]); \
        _Pragma("unroll") for (int i = 0; i < VP; ++i) VR_[i] = *(const u32x4*)(vsrc[i] + kb_ * vpitch); } while (0)
#define AT_COMMIT(kbuf, vslot, KR_, VR_) do { \
        _Pragma("unroll") for (int i = 0; i < KP; ++i) if (kval[i]) *(LAS u32x4*)(lds + kdst[i] + (kbuf) * AT_KBUF) = KR_[i]; \
        _Pragma("unroll") for (int i = 0; i < VP; ++i) *(LAS u32x4*)(lds + vdst[i] + (vslot)) = VR_[i]; } while (0)
#define AT_BAR() asm volatile("s_waitcnt lgkmcnt(0)\n\ts_barrier" ::: "memory")
#define SB() __builtin_amdgcn_sched_barrier(0)
    unsigned kaddr[NDS];
#pragma unroll
    for (int ds = 0; ds < NDS; ++ds) { const int cx = 2 * ds + hi; kaddr[ds] = AT_K + cx * 1024 + ((r32 ^ cx) << 4); }
    const unsigned vb = AT_V + ((lane >> 4) & 1) * 32 + (lane & 3) * 8 + (4 * hi + ((lane & 15) >> 2)) * 64;
    LAS float* asc = (LAS float*)(lds + AT_ASC) + wid * 32;
    float m_ref = 0.f, l = 0.f;
    f32x16 negm;
#pragma unroll
    for (int r = 0; r < 16; ++r) negm[r] = 0.f;
#pragma unroll
    for (int db = 0; db < NDB; ++db)
#pragma unroll
        for (int r = 0; r < 16; ++r) o[db][r] = 0.f;
    const int qw0 = 32 * wid, qrow_l = qw0 + r32;
    bf16x8 pa[4];
    bool resc = false;
#define P_CINIT(t) do { \
        if (ALIBI) { const int kpos0 = (t) == 0 ? 0 : 16 + 64 * ((t) - 1), qpos0 = meta ? 0 : 16 + qreal0; const float tb = sl2x * (float)(kpos0 - qpos0 + 4 * hix) - m_ref; \
            _Pragma("unroll") for (int r = 0; r < 16; ++r) { c0[r] = tb + sl2x * (float)((r & 3) + 8 * (r >> 2)); c1[r] = c0[r] + 32.0f * sl2x; } } \
        else { c0 = negm; c1 = negm; } } while (0)
#define P_KREAD(kb) do { _Pragma("unroll") for (int ds = 0; ds < NDS; ++ds) { kf0[ds] = *(const LAS bf16x8*)(lds + kaddr[ds] + (kb) * AT_KBUF); kf1[ds] = *(const LAS bf16x8*)(lds + kaddr[ds] + (kb) * AT_KBUF + 512); } } while (0)
#define P_QK() do { __builtin_amdgcn_s_setprio(1); _Pragma("unroll") for (int ds = 0; ds < NDS; ++ds) { c0 = MFMA32(kf0[ds], qf[ds], c0); c1 = MFMA32(kf1[ds], qf[ds], c1); } __builtin_amdgcn_s_setprio(0); } while (0)
#define P_VREAD(vsp, dg) do { _Pragma("unroll") for (int d2 = 0; d2 < 2; ++d2) _Pragma("unroll") for (int ks = 0; ks < 4; ++ks) { \
            const LAS unsigned char* vp_ = lds + vb + (vsp) + ((dg) + d2) * 4096 + ks * 1024; \
            vlo[d2][ks] = __builtin_amdgcn_ds_read_tr16_b64_v4i16((LAS v4i16_t*)vp_); vhh[d2][ks] = __builtin_amdgcn_ds_read_tr16_b64_v4i16((LAS v4i16_t*)(vp_ + 512)); } } while (0)
#define P_PV(dg, ksa) do { __builtin_amdgcn_s_setprio(1); _Pragma("unroll") for (int ks = (ksa); ks < (ksa) + 2; ++ks) _Pragma("unroll") for (int d2 = 0; d2 < 2; ++d2) { \
            const bf16x8 vf_ = __builtin_shufflevector(vlo[d2][ks], vhh[d2][ks], 0, 1, 2, 3, 4, 5, 6, 7); o[(dg) + d2] = MFMA32(pa[ks], vf_, o[(dg) + d2]); } __builtin_amdgcn_s_setprio(0); } while (0)
#define P_MASKMAX(t) do { \
        int lim; if ((t) == 0) lim = meta ? (qrow_l < 15 ? qrow_l : 15) : 15; else lim = qreal0 + qrow_l - 64 * ((t) - 1); \
        if (__any(lim < 63)) { \
            _Pragma("unroll") for (int r = 0; r < 16; ++r) { const int kidx = crow(r, hix); if (kidx > lim) c0[r] = -INFINITY; if (kidx + 32 > lim) c1[r] = -INFINITY; } } \
        float mx = fmaxf(c0[0], c1[0]); \
        _Pragma("unroll") for (int r = 1; r < 16; ++r) mx = fmaxf(fmaxf(mx, c0[r]), c1[r]); \
        mx = half_max(mx); \
        if ((t) == 0 || __any(mx > 90.0f)) { \
            const float dl = (t) == 0 ? mx : fmaxf(mx, 0.f); \
            m_ref += dl; \
            _Pragma("unroll") for (int r = 0; r < 16; ++r) { c0[r] -= dl; c1[r] -= dl; negm[r] = -m_ref; } \
            if ((t) != 0) { const float alpha = __builtin_amdgcn_exp2f(-dl); l *= alpha; if (hi == 0) asc[r32] = alpha; resc = true; } \
        } } while (0)
#define P_EXP0() do { _Pragma("unroll") for (int r = 0; r < 16; ++r) c0[r] = __builtin_amdgcn_exp2f(c0[r]); } while (0)
#define P_EXP1SUM() do { float rs0 = 0.f, rs1 = 0.f; \
        _Pragma("unroll") for (int r = 0; r < 16; ++r) { c1[r] = __builtin_amdgcn_exp2f(c1[r]); rs0 += c0[r]; rs1 += c1[r]; } l += rs0 + rs1; } while (0)
#define P_PACK() do { _Pragma("unroll") for (int s = 0; s < 2; ++s) { u32x4 w0, w1; \
        _Pragma("unroll") for (int j = 0; j < 4; ++j) { w0[j] = cvt_pk(c0[8 * s + 2 * j], c0[8 * s + 2 * j + 1]); w1[j] = cvt_pk(c1[8 * s + 2 * j], c1[8 * s + 2 * j + 1]); } \
        pa[s] = __builtin_bit_cast(bf16x8, w0); pa[2 + s] = __builtin_bit_cast(bf16x8, w1); } } while (0)
#define P_RESC() do { if (resc) { resc = false; \
        _Pragma("unroll") for (int g = 0; g < 4; ++g) { const f32x4 a4 = *(const LAS f32x4*)(asc + 8 * g + 4 * hi); \
            _Pragma("unroll") for (int db = 0; db < NDB; ++db) _Pragma("unroll") for (int i = 0; i < 4; ++i) o[db][4 * g + i] *= a4[i]; } } } while (0)
#define AT_OPAQUE() float sl2x = sl2; int hix = hi; asm volatile("" : "+v"(sl2x), "+v"(hix))
    int skip = 0;
    if (ALIBI && !meta && NT > 6) {
        const bf16_t* krow = K1 + (size_t)(brow0 + qreal0 + 32 * wid + r32) * k1pitch + 8 * hi;
        float dot = 0.f, qn2 = 0.f;
#pragma unroll
        for (int ds = 0; ds < NDS; ++ds) { const bf16x8 kk = *(const bf16x8*)(krow + 16 * ds);
#pragma unroll
            for (int j = 0; j < 8; ++j) { const float qv = bf2f((unsigned short)qf[ds][j]), kv = bf2f((unsigned short)kk[j]); dot += qv * kv; qn2 += qv * qv; } }
        dot = half_sum(dot); qn2 = half_sum(qn2);
        float T = dot + sl2 * (float)(32 * wid + r32) - sqrtf(qn2) * kmax - 0.5f;
#pragma unroll
        for (int o2 = 1; o2 < 32; o2 <<= 1) T = fminf(T, shx(T, o2));
        LAS float* tm = (LAS float*)(lds + AT_ASC);
        if (lane == 0) tm[32 * wid] = T;
        AT_BAR();
        float Tmin = tm[0];
#pragma unroll
        for (int w = 1; w < 8; ++w) Tmin = fminf(Tmin, tm[32 * w]);
        const float X = ((Tmin - 48.0f) / sl2 + (float)(qreal0 + 1)) * (1.0f / 64.0f);
        int J = X > 2.0f ? (int)X - 1 : 0;
        J = J < NT - 5 ? J : NT - 5;
        skip = __builtin_amdgcn_readfirstlane(J > 0 ? J : 0);
        NT -= skip;
    }
#define TJ(t) ((t) == 0 ? 0 : (t) + skip)
    int vs_prev = 0, vs_cur = AT_VBUF, vs_next = 2 * AT_VBUF;
    AT_ISSUE(0, kregA, vregA); AT_COMMIT(0, 0, kregA, vregA);
    AT_BAR();
    {
        f32x16 c0, c1; bf16x8 kf0[NDS], kf1[NDS]; AT_OPAQUE();
        if (NT > 1) AT_ISSUE(TJ(1), kregA, vregA);
        P_CINIT(0); P_KREAD(0); SB(); P_QK(); SB(); P_MASKMAX(0); P_EXP0(); P_EXP1SUM(); P_PACK();
        if (NT > 1) AT_COMMIT(1, vs_cur, kregA, vregA);
        AT_BAR();
    }
#define WAVE_HAS(j) ((j) == 0 || 64 * ((j) - 1) <= qreal0 + qw0 + 31)
    const int NT1 = (meta || NT < 5) ? NT : NT - 3;
    for (int t = 1; t < NT1; ++t) {
        f32x16 c0, c1; bf16x8 kf0[NDS], kf1[NDS]; v4i16_t vlo[2][4], vhh[2][4]; AT_OPAQUE();
        const int kb = t & 1;
        if (t + 1 < NT) AT_ISSUE(TJ(t + 1), kregA, vregA);
        P_RESC();
        P_CINIT(TJ(t)); P_KREAD(kb); SB();
        P_QK(); SB(); P_VREAD(vs_prev, 0); SB(); P_PV(0, 0); SB();
        P_MASKMAX(TJ(t)); SB();
        P_PV(0, 2); SB(); if (NDB == 4) P_VREAD(vs_prev, 2); SB();
        P_EXP0(); SB();
        if (NDB == 4) P_PV(2, 0); SB();
        P_EXP1SUM(); SB();
        if (NDB == 4) P_PV(2, 2); SB();
        P_PACK();
        if (t + 1 < NT) AT_COMMIT(kb ^ 1, vs_next, kregA, vregA);
        AT_BAR();
        const int tmp_ = vs_prev; vs_prev = vs_cur; vs_cur = vs_next; vs_next = tmp_;
    }
    for (int t = NT1; t < NT; ++t) {
        const int kb = t & 1;
        if (t + 1 < NT) AT_ISSUE(TJ(t + 1), kregA, vregA);
        if (WAVE_HAS(TJ(t - 1))) {
            v4i16_t vlo[2][4], vhh[2][4];
            P_RESC();
            P_VREAD(vs_prev, 0); SB(); P_PV(0, 0); P_PV(0, 2); SB();
            if (NDB == 4) { P_VREAD(vs_prev, 2); SB(); P_PV(2, 0); P_PV(2, 2); SB(); }
        }
        if (WAVE_HAS(TJ(t))) {
            f32x16 c0, c1; bf16x8 kf0[NDS], kf1[NDS]; AT_OPAQUE();
            P_CINIT(TJ(t)); P_KREAD(kb); SB(); P_QK(); SB(); P_MASKMAX(TJ(t)); P_EXP0(); P_EXP1SUM(); P_PACK();
        }
        if (t + 1 < NT) AT_COMMIT(kb ^ 1, vs_next, kregA, vregA);
        AT_BAR();
        const int tmp_ = vs_prev; vs_prev = vs_cur; vs_cur = vs_next; vs_next = tmp_;
    }
    {
        if (WAVE_HAS(TJ(NT - 1))) {
            v4i16_t vlo[2][4], vhh[2][4];
            P_RESC();
            P_VREAD(vs_prev, 0); SB(); P_PV(0, 0); P_PV(0, 2); SB();
            if (NDB == 4) { P_VREAD(vs_prev, 2); SB(); P_PV(2, 0); P_PV(2, 2); SB(); }
        }
        AT_BAR();
    }
#undef WAVE_HAS
    l = half_sum(l);
    const float inv = 1.0f / l;
    if (hi == 0) asc[r32] = inv;
#pragma unroll
    for (int g = 0; g < 4; ++g) { const f32x4 a4 = *(const LAS f32x4*)(asc + 8 * g + 4 * hi);
#pragma unroll
        for (int db = 0; db < NDB; ++db)
#pragma unroll
            for (int i = 0; i < 4; ++i) o[db][4 * g + i] *= a4[i]; }
#undef AT_ISSUE
#undef AT_COMMIT
#undef AT_BAR
#undef SB
#undef P_CINIT
#undef P_KREAD
#undef P_QK
#undef P_VREAD
#undef P_PV
#undef P_MASKMAX
#undef P_EXP0
#undef P_EXP1SUM
#undef P_PACK
#undef P_RESC
#undef AT_OPAQUE
#undef TJ
}
__device__ __forceinline__ void attn_unit_mla(const Params& P, LAS unsigned char* lds, int b, int h, int qb, int meta, int g_wid) {
    const bf16_t* Q = (const bf16_t*)(KPAR->ws + WS_POOL + PO_Q); const bf16_t* KV = (const bf16_t*)(KPAR->ws + WS_POOL + PO_KV); const bf16_t* KR = (const bf16_t*)(KPAR->ws + WS_KR);
    bf16_t* AO = (bf16_t*)(KPAR->ws + WS_POOL + PO_AO);
    int tid_o = (g_wid << 6) | lane_id(); const int tid = tid_o, lane = tid & 63, wid = tid >> 6, r32 = lane & 31, hi = lane >> 5;
    const int row0 = meta ? MREAL : b * SEQ + 256 * qb, NT = meta ? 1 : 1 + 4 * (qb + 1);
    f32x16 o[2];
    attn_pass<96, 64, false>(lds, Q + (size_t)row0 * 768 + h * 96, 768, KV + h * 128, 1024, KR, 32, KV + h * 128 + 64, 1024, b * SEQ, NT, 256 * qb, meta, 0.f, 0.f, o, g_wid);
#pragma unroll
    for (int r = 0; r < 16; ++r) { const int rr = 32 * wid + crow(r, hi);
        if (!meta || rr < 16) {
#pragma unroll
            for (int db = 0; db < 2; ++db) AO[(size_t)(row0 + rr) * 512 + h * 64 + db * 32 + r32] = (bf16_t)f2bf(o[db][r]); } }
}
__device__ __forceinline__ void attn_unit_diff(const Params& P, LAS unsigned char* lds, int b, int h, int qb, int meta, int map, int l, float lam, float kmax, int g_wid) {
    const bf16_t* DQ = (const bf16_t*)(KPAR->ws + WS_POOL + PO_DQ); const bf16_t* DK = (const bf16_t*)(KPAR->ws + WS_POOL + PO_DK); const bf16_t* DVv = (const bf16_t*)(KPAR->ws + WS_POOL + PO_DV);
    const int row0 = meta ? MREAL : b * SEQ + 256 * qb, NT = meta ? 1 : 1 + 4 * (qb + 1);
    const float sl2 = LOG2E * (h == 0 ? 0.25f : (h == 1 ? 0.0625f : (h == 2 ? 0.015625f : 0.00390625f)));
    f32x16 o[4];
    attn_pass<64, 128, true>(lds, DQ + (size_t)row0 * 512 + h * 128 + 64 * map, 512, DK + h * 128 + 64 * map, 512, nullptr, 0, DVv + h * 128, 512, b * SEQ, NT, 256 * qb, meta, sl2, kmax, o, g_wid);
    const int unit = meta ? 256 + h : ((b * 4 + h) * 32 + qb);
    unsigned* cw = (unsigned*)(KPAR->ws + WS_CTL) + 8192 + l * 1024 + unit * 2;
    const int tid = (g_wid << 6) | lane_id(), lane = tid & 63, wid = tid >> 6, r32 = lane & 31, hi = lane >> 5;
    float* st4 = (float*)(KPAR->ws + WS_POOL + PO_S) + (meta ? (size_t)256 * 32768 + (size_t)h * 4096 : (size_t)unit * 32768) + (size_t)tid * 64;
    const bool parks = !meta || wid == 0;
    static_assert((size_t)256 * 131072 + 4 * 16384 <= R1K, "parking slots exceed the S region");
    if (tid == 0) *(LAS unsigned*)(lds + AT_QW + 64) = __hip_atomic_fetch_add(cw, 1u, __ATOMIC_RELAXED, __HIP_MEMORY_SCOPE_AGENT);
    __syncthreads();
    const unsigned first = *(LAS unsigned*)(lds + AT_QW + 64) == 0u;
    if (first) {
#pragma unroll
        for (int db = 0; db < 4; ++db)
#pragma unroll
            for (int g = 0; g < 4; ++g) if (parks) ((f32x4*)st4)[db * 4 + g] = (f32x4){o[db][4 * g], o[db][4 * g + 1], o[db][4 * g + 2], o[db][4 * g + 3]};
        asm volatile("s_waitcnt vmcnt(0)" ::: "memory");
        __syncthreads();
        if (tid == 0) { __builtin_amdgcn_fence(__ATOMIC_RELEASE, "agent"); asm volatile("s_waitcnt vmcnt(0)" ::: "memory");
                        __hip_atomic_store(cw + 1, 1u, __ATOMIC_RELAXED, __HIP_MEMORY_SCOPE_AGENT); }
        return;
    }
    if (tid == 0) { while (__hip_atomic_load(cw + 1, __ATOMIC_RELAXED, __HIP_MEMORY_SCOPE_AGENT) == 0u) __builtin_amdgcn_s_sleep(2);
                    __builtin_amdgcn_fence(__ATOMIC_ACQUIRE, "agent"); asm volatile("s_waitcnt vmcnt(0)" ::: "memory"); }
    __syncthreads();
    bf16_t* DN = (bf16_t*)(KPAR->ws + WS_POOL + PO_DN);
    const float ca = map == 0 ? 1.0f : -lam, cb = map == 0 ? -lam : 1.0f;
#pragma unroll
    for (int db = 0; db < 4; ++db)
#pragma unroll
        for (int g = 0; g < 4; ++g) { f32x4 s4 = (f32x4){0.f, 0.f, 0.f, 0.f}; if (parks) s4 = __builtin_nontemporal_load((const f32x4*)st4 + db * 4 + g);
#pragma unroll
            for (int i = 0; i < 4; ++i) o[db][4 * g + i] = map == 0 ? (o[db][4 * g + i] - lam * s4[i]) : (s4[i] - lam * o[db][4 * g + i]); }
    (void)ca; (void)cb;
#pragma unroll
    for (int r = 0; r < 16; ++r) {
        float ss = (o[0][r] * o[0][r] + o[1][r] * o[1][r]) + (o[2][r] * o[2][r] + o[3][r] * o[3][r]);
        ss += shx(ss, 1); ss += shx(ss, 2); ss += shx(ss, 4); ss += shx(ss, 8); ss += shx(ss, 16);
        const float rstd = rsqrtf(ss * (1.0f / 128.0f) + EPS);
        const int rr = 32 * wid + crow(r, hi);
        if (!meta || rr < 16) {
#pragma unroll
            for (int db = 0; db < 4; ++db) DN[(size_t)(row0 + rr) * 512 + h * 128 + db * 32 + r32] = (bf16_t)f2bf(o[db][r] * rstd); }
    }
}
__device__ __forceinline__ void attn_phase(const Params& P, LAS unsigned char* lds, int lc, int g_wid) {
    const int l = lc & 1;
    int tid_o = (g_wid << 6) | lane_id(); const int tid = tid_o, lane = tid & 63;
    const float s1 = wave_sum(KPAR->in[9][l * 64 + lane] * KPAR->in[10][l * 64 + lane]), s2 = wave_sum(KPAR->in[11][l * 64 + lane] * KPAR->in[12][l * 64 + lane]);
    const float lam = expf(s1) - expf(s2) + (l == 0 ? 0.2f : 0.35550907f);
    const float kmax = sqrtf(2.0f * __uint_as_float(__hip_atomic_load((unsigned*)(KPAR->ws + WS_CTL) + 3000 + 64 * l, __ATOMIC_RELAXED, __HIP_MEMORY_SCOPE_AGENT))) * 1.01f;
    const int xcc = (int)((unsigned)__builtin_amdgcn_s_getreg((3 << 11) | 20) & 7u);
    for (int qi = 0; qi < 8; ++qi) {
        const int q = (xcc + qi) & 7;
        unsigned* ctr = (unsigned*)(KPAR->ws + WS_CTL) + 64 * (lc * 8 + q);
        for (;;) {
            if (tid == 0) *(LAS unsigned*)(lds + AT_QW) = atomicAdd(ctr, 1u);
            __syncthreads();
            const int u = (int)*(LAS unsigned*)(lds + AT_QW);
            __syncthreads();
            if (u >= (l == 0 ? 130 : 128)) break;
            if (u < 128) { const int qb = 31 - (u >> 2), j = u & 3;
                if (j < 2) attn_unit_diff(P, lds, q >> 2, (qb & 1) ? 3 - (q & 3) : (q & 3), qb, 0, j, l, lam, kmax, g_wid);     else { const int s = q + 8 * (j - 2); attn_unit_mla(P, lds, s >> 3, s & 7, qb, 0, g_wid); }
            } else { const int m = q + 8 * (u - 128);
                if (m < 8) attn_unit_diff(P, lds, 0, m >> 1, 0, 1, m & 1, l, lam, kmax, g_wid); else attn_unit_mla(P, lds, 0, m - 8, 0, 1, g_wid); }
        }
    }
}
#define XB_TMO      128
#define XB_XCNT(j)  (256  + 64 * (j))
#define XB_XSUB(j)  (1280 + 64 * (j))
#define XB_XGEN(j)  (2304 + 64 * (j))
#define XB_TOP      3328
#define XB_TOPGEN   3392
#define XCD_BAR_WORDS 3456
#define XB_SPIN_CAP (1u << 18)

__device__ __forceinline__ unsigned xb_ld(unsigned* p)              { return __hip_atomic_load(p, __ATOMIC_RELAXED, __HIP_MEMORY_SCOPE_AGENT); }
__device__ __forceinline__ unsigned xb_add(unsigned* p, unsigned v) { return __hip_atomic_fetch_add(p, v, __ATOMIC_RELAXED, __HIP_MEMORY_SCOPE_AGENT); }
__device__ __forceinline__ unsigned xb_xcc_id() { return (unsigned)__builtin_amdgcn_s_getreg((3 << 11) | 20) & 0xFu; }
#define XB_SPIN(cond, bar) do { unsigned _sp = 0; while (cond) { __builtin_amdgcn_s_sleep(1); \
    if ((++_sp & 255u) == 0u) { if (xb_ld(&(bar)[XB_TMO])) break; if (_sp > XB_SPIN_CAP) { atomicAdd(&(bar)[XB_TMO], 1u); break; } } } } while (0)

struct XcdBarrier {
    unsigned* bar; unsigned x;
    volatile LAS unsigned* st;
};

__device__ __forceinline__ XcdBarrier xcd_barrier_post(unsigned* bar, volatile LAS unsigned* st, bool leader) {
    XcdBarrier b; b.bar = bar; b.x = xb_xcc_id(); b.st = st;
    if (leader) (void)xb_add(&bar[XB_XCNT(b.x)], 1u);
    return b;
}
__device__ __forceinline__ void xcd_barrier_complete(unsigned* bar, unsigned x, unsigned& nloc, unsigned& nx) {
    const unsigned G = gridDim.x * gridDim.y * gridDim.z;
    unsigned sum, cnt, mine, sp = 0u;
    for (;;) {
        sum = 0u; cnt = 0u; mine = 0u;
#pragma unroll
        for (unsigned j = 0; j < 16; ++j) { const unsigned c = xb_ld(&bar[XB_XCNT(j)]); sum += c; cnt += (c > 0u) ? 1u : 0u; mine = (j == x) ? c : mine; }
        if (sum == G) break;
        __builtin_amdgcn_s_sleep(1);
        if ((++sp & 255u) == 0u) { if (xb_ld(&bar[XB_TMO])) break; if (sp > XB_SPIN_CAP) { atomicAdd(&bar[XB_TMO], 1u); break; } }
    }
    nloc = mine > 0u ? mine : 1u; nx = cnt > 0u ? cnt : 1u;
}

__device__ __forceinline__ void xcd_barrier(const XcdBarrier& b, int g_wid) {
    asm volatile("s_waitcnt vmcnt(0)" ::: "memory");
    __syncthreads();
    if (g_wid == 0 && lane_id() == 0) {
        unsigned* bar = b.bar;
        __builtin_amdgcn_s_waitcnt(0);
        unsigned nloc = b.st[0], nx = b.st[1];
        if (nloc == 0u) { xcd_barrier_complete(bar, b.x, nloc, nx); b.st[0] = nloc; b.st[1] = nx; }
        const unsigned old = xb_add(&bar[XB_XSUB(b.x)], 1u);
        const unsigned gen = old / nloc;
        if (old + 1u == (gen + 1u) * nloc) {
            __builtin_amdgcn_fence(__ATOMIC_RELEASE, "agent");
            asm volatile("s_waitcnt vmcnt(0)" ::: "memory");
            const unsigned og = xb_add(&bar[XB_TOP], 1u);
            const unsigned tg = og / nx;
            if (og + 1u == (tg + 1u) * nx) xb_add(&bar[XB_TOPGEN], 1u);
            else XB_SPIN(xb_ld(&bar[XB_TOPGEN]) == tg, bar);
            __builtin_amdgcn_fence(__ATOMIC_ACQUIRE, "agent");
            xb_add(&bar[XB_XGEN(b.x)], 1u);
            asm volatile("s_waitcnt vmcnt(0)" ::: "memory");
        } else {
            XB_SPIN(xb_ld(&bar[XB_XGEN(b.x)]) == gen, bar);
            __builtin_amdgcn_fence(__ATOMIC_ACQUIRE, "agent");
            asm volatile("s_waitcnt vmcnt(0)" ::: "memory");
        }
    }
    __syncthreads();
}

constexpr int LDS_BYTES = 131072 + 1024;
__global__ void __launch_bounds__(512, 2) fwd_megakernel(Params P) {
    extern __shared__ __attribute__((aligned(16))) unsigned char lds_raw[];
    LAS unsigned char* lds = (LAS unsigned char*)lds_raw;
    const int g_wid = __builtin_amdgcn_readfirstlane(threadIdx.x >> 6);
    volatile LAS unsigned* xb_st = (volatile LAS unsigned*)(lds + 131072 + 64);
    if (g_wid == 0 && lane_id() < 2) xb_st[lane_id()] = 0u;
    __syncthreads();
    const XcdBarrier xbar = xcd_barrier_post((unsigned*)(KPAR->ws + WS_CTL) + 4096, xb_st, g_wid == 0 && lane_id() == 0);
#define GRID_SYNC() xcd_barrier(xbar, g_wid)
#define WSP unsigned char* ws = KPAR->ws; asm volatile("" : "+s"(ws)); unsigned char* pool = ws + WS_POOL; (void)pool
#define PW ((bf16_t*)(ws + WS_W))
#define PXB ((bf16_t*)(ws + WS_XB))
#define PSSQ ((float*)(ws + WS_SSQ))
#define PSSQQ ((float*)(ws + WS_SSQQ))
#define PSSQKV ((float*)(ws + WS_SSQKV))
#define PXMETA ((float*)(ws + WS_XMETA))
#define PROPE ((const f32x2*)(ws + WS_ROPE))
#define PKR ((bf16_t*)(ws + WS_KR))
#define PP(off) ((bf16_t*)(pool + (off)))
#ifndef PHM
#define PHM 0xffff
#endif
#if PHM & 1
    prologue_x(P, g_wid); convert_weights(P, 0, lds, g_wid);
#if defined(PROBE_DUP) && (PROBE_DUP & 1)
    convert_weights(P, 0, lds, g_wid);
#endif
#endif
    if (KPAR->ws == nullptr) cg::this_grid().sync();
    GRID_SYNC();
    for (int l = 0; l < 2; ++l) {
#if PHM & 1
        if (l == 1) { convert_weights(P, 1, lds, g_wid); GRID_SYNC(); }
#endif
        const bool m_all = (l == 0);
#if PHM & 2
        {
            WSP; gemm_all<REWin>(lds, PXB, PW + WO_IN, 2048, 1024, REWin{PSSQ, (unsigned*)(ws + WS_CTL) + 3000 + 64 * l, PP(PO_QA), PP(PO_KVA), PKR, PP(PO_DQ), PP(PO_DK), PP(PO_DV), PSSQQ, PSSQKV, PROPE}, true, g_wid);
        }
        GRID_SYNC();
#if defined(PROBE_DUP) && (PROBE_DUP & 2)
        {
            WSP; gemm_all<REWin>(lds, PXB, PW + WO_IN, 2048, 1024, REWin{PSSQ, (unsigned*)(ws + WS_CTL) + 3000 + 64 * l, PP(PO_QA), PP(PO_KVA), PKR, PP(PO_DQ), PP(PO_DK), PP(PO_DV), PSSQQ, PSSQKV, PROPE}, true, g_wid);
        }
        GRID_SYNC();
#endif
#endif
#if PHM & 4
        {
            WSP; gemm_all<REQup>(lds, PP(PO_QA), PW + WO_Q, 768, 256, REQup{PSSQQ, PP(PO_Q), PROPE}, m_all, g_wid);
        }
        {   WSP; gemm_all<REKVup>(lds, PP(PO_KVA), PW + WO_KV, 1024, 128, REKVup{PSSQKV, PP(PO_KV)}, true, g_wid); }
        GRID_SYNC();
#if defined(PROBE_DUP) && (PROBE_DUP & 4)
        {
            WSP; gemm_all<REQup>(lds, PP(PO_QA), PW + WO_Q, 768, 256, REQup{PSSQQ, PP(PO_Q), PROPE}, m_all, g_wid);
        }
        {   WSP; gemm_all<REKVup>(lds, PP(PO_KVA), PW + WO_KV, 1024, 128, REKVup{PSSQKV, PP(PO_KV)}, true, g_wid); }
        GRID_SYNC();
#endif
#endif
#if PHM & 8
        attn_phase(P, lds, l, g_wid);
#ifdef PROBE_ATTN2
        GRID_SYNC(); attn_phase(P, lds, l + 2, g_wid);
#endif
        GRID_SYNC();
#endif
#if PHM & 16
        {   WSP; gemm_all<REStore>(lds, PP(PO_AO), PW + WO_A, 1024, 512, REStore{PP(PO_S)}, m_all, g_wid); }
        {   WSP; gemm_all<REGate>(lds, PXB, PW + WO_GA, 1024, 1024, REGate{PSSQ, KPAR->in[4] + (size_t)l * 2048, PP(PO_S), nullptr, 0}, m_all, g_wid); }
        {   WSP; gemm_all<REStore>(lds, PP(PO_DN), PW + WO_B, 1024, 512, REStore{PP(PO_YQ)}, m_all, g_wid); }
        {   WSP; gemm_all<REGate>(lds, PXB, PW + WO_GB, 1024, 1024, REGate{PSSQ, KPAR->in[4] + (size_t)l * 2048 + 1024, PP(PO_S), PP(PO_YQ), 1}, m_all, g_wid); }
        GRID_SYNC();
#if defined(PROBE_DUP) && (PROBE_DUP & 16)
        {   WSP; gemm_all<REStore>(lds, PP(PO_AO), PW + WO_A, 1024, 512, REStore{PP(PO_S)}, m_all, g_wid); }
        {   WSP; gemm_all<REGate>(lds, PXB, PW + WO_GA, 1024, 1024, REGate{PSSQ, KPAR->in[4] + (size_t)l * 2048, PP(PO_S), nullptr, 0}, m_all, g_wid); }
        {   WSP; gemm_all<REStore>(lds, PP(PO_DN), PW + WO_B, 1024, 512, REStore{PP(PO_YQ)}, m_all, g_wid); }
        {   WSP; gemm_all<REGate>(lds, PXB, PW + WO_GB, 1024, 1024, REGate{PSSQ, KPAR->in[4] + (size_t)l * 2048 + 1024, PP(PO_S), PP(PO_YQ), 1}, m_all, g_wid); }
        GRID_SYNC();
#endif
#endif
#if PHM & 32
        {
            WSP; float* out = KPAR->out; gemm_all<REResid>(lds, PP(PO_S), PW + WO_O, 1024, 1024, REResid{l == 0 ? KPAR->in[0] : out, l == 0 ? KPAR->in[1] : PXMETA, out, PXMETA, PXB, PSSQ}, m_all, g_wid);
        }
        GRID_SYNC();
#endif
#if PHM & 64
        {
            WSP; gemm_all<REUp>(lds, PXB, PW + WO_UP, 4096, 1024, REUp{PSSQ, PP(PO_H)}, m_all, g_wid);
        }
        GRID_SYNC();
#if defined(PROBE_DUP) && (PROBE_DUP & 64)
        {
            WSP; gemm_all<REUp>(lds, PXB, PW + WO_UP, 4096, 1024, REUp{PSSQ, PP(PO_H)}, m_all, g_wid);
        }
        GRID_SYNC();
#endif
#endif
#if PHM & 128
        {
            WSP; float* out = KPAR->out; gemm_all<REResid>(lds, PP(PO_H), PW + WO_DN, 1024, 4096, REResid{out, PXMETA, out, PXMETA, PXB, PSSQ}, m_all, g_wid);
        }
        GRID_SYNC();
#endif
    }
    { int tid_o = (g_wid << 6) | lane_id(); const int tid = tid_o, wid = tid >> 6, lane = tid & 63; const float* g = KPAR->in[20]; WSP; float* ssq = PSSQ; float* out = KPAR->out;
      for (int row = blockIdx.x * 8 + wid; row < MREAL; row += gridDim.x * 8) {
          const float rstd = rsqrtf(sum16p(ssq + (size_t)row * 16) * (1.0f / 1024.0f) + EPS);
          f32x4* o4 = (f32x4*)(out + (size_t)row * 1024);
#pragma unroll
          for (int j = 0; j < 4; ++j) o4[64 * j + lane] = o4[64 * j + lane] * rstd * ((const f32x4*)g)[64 * j + lane];
      } }
}

extern "C" void kernel_launch(void* const* d_in, const int* in_sizes, int n_in, void* d_out, int out_size, void* d_ws, size_t ws_size, hipStream_t stream) {
    static int grid = 0;
    if (grid == 0) {
        if (n_in != 21 || ws_size < WS_END) { fprintf(stderr, "kernel_launch: unexpected inputs (n_in %d, ws %zu < %zu)\n", n_in, ws_size, (size_t)WS_END); grid = -1; return; }
        int dev = 0, cus = 0, per_cu = 0;
        (void)hipGetDevice(&dev); (void)hipDeviceGetAttribute(&cus, hipDeviceAttributeMultiprocessorCount, dev);
        (void)hipFuncSetAttribute((const void*)fwd_megakernel, hipFuncAttributeMaxDynamicSharedMemorySize, LDS_BYTES);
        (void)hipOccupancyMaxActiveBlocksPerMultiprocessor(&per_cu, (const void*)fwd_megakernel, 512, LDS_BYTES);
        if (per_cu < 1) per_cu = 1;
        grid = cus * per_cu; if (grid > 256) grid = 256;
        (void)hipGetLastError();
    }
    if (grid < 0) return;
    (void)hipMemsetAsync((char*)d_ws + WS_CTL, 0, CTL_BYTES, stream);
    Params p{};
    for (int i = 0; i < 21; ++i) p.in[i] = (const float*)d_in[i];
    p.out = (float*)d_out; p.ws = (unsigned char*)d_ws;
    void* args[] = {&p};
    hipError_t e = hipLaunchCooperativeKernel((const void*)fwd_megakernel, dim3(grid), dim3(512), args, LDS_BYTES, stream);
    if (e != hipSuccess) fprintf(stderr, "cooperative launch failed: %s (grid %d)\n", hipGetErrorString(e), grid);
}
```

```cpp
#include <hip/hip_runtime.h>
#include <hip/hip_cooperative_groups.h>
#include <cstdio>
#include <cstdint>
namespace cg = cooperative_groups;
__device__ __forceinline__ int lane_id() { int l; asm volatile("v_mbcnt_lo_u32_b32 %0, -1, 0\n\tv_mbcnt_hi_u32_b32 %0, -1, %0" : "=v"(l)); return l; }

namespace pg8 {
#define PG8_LAS __attribute__((address_space(3)))
typedef unsigned short bf16_t;
typedef short bf16x8 __attribute__((ext_vector_type(8)));
typedef float f32x4 __attribute__((ext_vector_type(4)));
typedef unsigned u32x4 __attribute__((ext_vector_type(4)));
constexpr int BM = 256, BK = 64, HALF = 128, HTB = HALF * BK * 2  , STAGE_BYTES = 8 * HTB, NXCD = 8, WGM = 8;

__host__ __device__ __forceinline__ int lds_byte(int r, int c) { const int st = (r >> 4) * 2 + (c >> 5), rr = r & 15, cc = c & 31, ob = rr * 64 + cc * 2; return st * 1024 + (ob ^ (((ob >> 9) & 1) << 5)); }
__host__ __device__ __forceinline__ void stage_rc(int b, int& R, int& C) { const int st = b / 1024, sb = b % 1024, swz = sb ^ (((sb >> 9) & 1) << 5); R = (st >> 1) * 16 + swz / 64; C = (st & 1) * 32 + (swz % 64) / 2; }
__host__ __device__ __forceinline__ int perm32(int rho) { const int n = rho >> 4, i = rho & 15; return 8 * (i >> 2) + 4 * n + (i & 3); }

struct Unit { int pm, pn; };
struct Gemm { const bf16_t* A; const bf16_t* Bt; int M, N, K; };

struct StaticOrder {
    int nM, nN, nwg, G, c;
    __host__ __device__ void init(int M, int N, int G_, int c_) { nM = M / BM; nN = N / BM; nwg = nM * nN; G = G_; c = c_; }
    __host__ __device__ bool next(int i, Unit& u) const {
        const long L = (long)i * G + c; if (L >= nwg) return false;
        int wgid = (int)L; { const int q = nwg / NXCD, r = nwg % NXCD, xcd = wgid % NXCD, off = wgid / NXCD; wgid = (xcd < r ? xcd * (q + 1) : r * (q + 1) + (xcd - r) * q) + off; }
        const int nig = WGM * nN, gid = wgid / nig, fm = gid * WGM, gsz = (nM - fm) < WGM ? (nM - fm) : WGM;
        u.pm = fm + ((wgid % nig) % gsz); u.pn = (wgid % nig) / gsz; return true;
    }
    __device__ __forceinline__ void a_ready(const Unit&) const {}
    __device__ __forceinline__ void done(const Unit&) const {}
};

__device__ __forceinline__ unsigned cvt_pk_bf16(float lo, float hi) { unsigned r; asm volatile("v_cvt_pk_bf16_f32 %0, %1, %2" : "=v"(r) : "v"(lo), "v"(hi)); return r; }
template <class Epi, class Sched, bool ALIGN_EPI = false, bool SP2 = false>
__device__ __forceinline__ void gemm_phase(PG8_LAS unsigned char* lds, const Gemm g, const Sched& S, const Epi& E, int g_wid) {
    int tid_o = (g_wid << 6) | lane_id(); const int tid = tid_o, wid = __builtin_amdgcn_readfirstlane(tid >> 6), lane = tid & 63, wr = wid >> 2, wc = wid & 3, fr = lane & 15, fq = lane >> 4;
    const int K = g.K, nt = K / BK;
    unsigned voffA[2], voffB[2];
#pragma unroll
    for (int i = 0; i < 2; ++i) { int R, C; stage_rc(tid * 16 + i * 8192, R, C); const int Rb = Epi::PERM ? ((R & ~31) + perm32(R & 31)) : R;
        voffA[i] = (unsigned)(R * K + C) * 2u; voffB[i] = (unsigned)(Rb * K + C) * 2u; }
    const size_t kstep = (size_t)(BK * 2);
    const size_t hstep = (size_t)HALF * K * 2;
    const size_t tstep = 2 * hstep;
    const unsigned ldsw = (unsigned)wid * 1024u;
    const int aoff = lds_byte(wr * 64 + fr, fq * 8), boff = lds_byte(wc * 32 + fr, fq * 8);
#define PG8_SA(b, h) (((b) * 2 + (h)) * HTB)
#define PG8_SB(b, h) ((4 + (b) * 2 + (h)) * HTB)
#define PG8_STAGE(bufoff, gbase, voff) do { _Pragma("unroll") for (int _i = 0; _i < 2; ++_i) \
        __builtin_amdgcn_global_load_lds((const unsigned*)((const char*)(gbase) + (voff)[_i]), (PG8_LAS unsigned*)(lds + (bufoff) + ldsw + _i * 8192), 16, 0, 0); } while (0)
#define PG8_LDA(dst, b, h) do { _Pragma("unroll") for (int m = 0; m < 4; ++m) _Pragma("unroll") for (int k = 0; k < 2; ++k) dst[m][k] = *(const PG8_LAS bf16x8*)(lds + PG8_SA(b, h) + aoff + m * 2048 + k * 1024); } while (0)
#define PG8_LDB(dst, b, h) do { _Pragma("unroll") for (int n = 0; n < 2; ++n) _Pragma("unroll") for (int k = 0; k < 2; ++k) dst[n][k] = *(const PG8_LAS bf16x8*)(lds + PG8_SB(b, h) + boff + n * 2048 + k * 1024); } while (0)
#define PG8_MMA(ai, bj, At, Bt) do { __builtin_amdgcn_s_setprio(1); _Pragma("unroll") for (int m = 0; m < 4; ++m) _Pragma("unroll") for (int n = 0; n < 2; ++n) _Pragma("unroll") for (int k = 0; k < 2; ++k) \
        acc[ai][bj][m][n] = __builtin_amdgcn_mfma_f32_16x16x32_bf16(Bt[n][k], At[m][k], acc[ai][bj][m][n], 0, 0, 0); __builtin_amdgcn_s_setprio(0); } while (0)
#define PG8_WAIT_V(n) asm volatile("s_waitcnt vmcnt(" #n ")" ::: "memory")
#define PG8_WAIT_L(n) asm volatile("s_waitcnt lgkmcnt(" #n ")" ::: "memory")
#define PG8_BAR __builtin_amdgcn_s_barrier()
#define PG8_SCHED __builtin_amdgcn_sched_barrier(0)
    Unit cur, nxt; int ui = 0;
    if (!S.next(0, cur)) return;
    f32x4 acc[2][2][4][2];
#pragma unroll
    for (int a = 0; a < 2; ++a)
#pragma unroll
        for (int b = 0; b < 2; ++b)
#pragma unroll
            for (int m = 0; m < 4; ++m)
#pragma unroll
                for (int n = 0; n < 2; ++n) acc[a][b][m][n] = (f32x4){0.f, 0.f, 0.f, 0.f};
    bf16x8 At[4][2], B0[2][2], B1[2][2];
    const char* cA = (const char*)g.A + (size_t)cur.pm * tstep; const char* cB = (const char*)g.Bt + (size_t)cur.pn * tstep;
    S.a_ready(cur);
    if constexpr (SP2) {
        PG8_STAGE(PG8_SB(0, 0), cB, voffB); PG8_STAGE(PG8_SB(0, 1), cB + hstep, voffB); PG8_STAGE(PG8_SA(0, 0), cA, voffA); PG8_STAGE(PG8_SA(0, 1), cA + hstep, voffA);
        if (wr == 1) PG8_BAR;
        PG8_WAIT_V(2); PG8_BAR;
        PG8_STAGE(PG8_SB(1, 0), cB + kstep, voffB); PG8_STAGE(PG8_SA(1, 0), cA + kstep, voffA); PG8_STAGE(PG8_SB(1, 1), cB + hstep + kstep, voffB);
        PG8_WAIT_V(6); PG8_BAR;
    } else {
        PG8_STAGE(PG8_SB(0, 0), cB, voffB); PG8_STAGE(PG8_SA(0, 0), cA, voffA); PG8_STAGE(PG8_SB(0, 1), cB + hstep, voffB); PG8_STAGE(PG8_SA(0, 1), cA + hstep, voffA);
        if (wr == 1) PG8_BAR;
        PG8_WAIT_V(4); PG8_BAR;
        PG8_STAGE(PG8_SB(1, 0), cB + kstep, voffB); PG8_STAGE(PG8_SA(1, 0), cA + kstep, voffA); PG8_STAGE(PG8_SB(1, 1), cB + hstep + kstep, voffB);
        PG8_WAIT_V(6); PG8_BAR;
    }
    for (;;) {
        const bool has_next = S.next(ui + 1, nxt);
        const char* nA = has_next ? (const char*)g.A + (size_t)nxt.pm * tstep : cA; const char* nB = has_next ? (const char*)g.Bt + (size_t)nxt.pn * tstep : cB;
        for (int t = 0; t < nt; t += 2) {
            const bool last = (t == nt - 2);
            const char* a1 = cA + (size_t)(t + 1) * kstep;
            const char* a2 = last ? nA : cA + (size_t)(t + 2) * kstep; const char* b2 = last ? nB : cB + (size_t)(t + 2) * kstep;
            const char* a3 = a2 + kstep; const char* b3 = b2 + kstep;
            if (last && has_next) S.a_ready(nxt);
            if constexpr (SP2) {
            PG8_LDB(B0, 0, 0); PG8_LDB(B1, 0, 1); PG8_SCHED; PG8_LDA(At, 0, 0); PG8_STAGE(PG8_SA(1, 1), a1 + hstep, voffA);
            PG8_WAIT_V(8); PG8_WAIT_L(0); PG8_BAR; PG8_MMA(0, 0, At, B0); PG8_MMA(0, 1, At, B1); PG8_BAR; PG8_SCHED;
            PG8_LDA(At, 0, 1); PG8_STAGE(PG8_SB(0, 0), b2, voffB); PG8_STAGE(PG8_SB(0, 1), b2 + hstep, voffB); PG8_STAGE(PG8_SA(0, 0), a2, voffA);
            PG8_WAIT_V(8); PG8_WAIT_L(0); PG8_BAR; PG8_MMA(1, 0, At, B0); PG8_MMA(1, 1, At, B1); PG8_BAR; PG8_SCHED;
            PG8_LDB(B0, 1, 0); PG8_LDB(B1, 1, 1); PG8_SCHED; PG8_LDA(At, 1, 0); PG8_STAGE(PG8_SA(0, 1), a2 + hstep, voffA);
            PG8_WAIT_V(8); PG8_WAIT_L(0); PG8_BAR; PG8_MMA(0, 0, At, B0); PG8_MMA(0, 1, At, B1); PG8_BAR; PG8_SCHED;
            PG8_LDA(At, 1, 1); PG8_STAGE(PG8_SB(1, 0), b3, voffB); PG8_STAGE(PG8_SB(1, 1), b3 + hstep, voffB); PG8_STAGE(PG8_SA(1, 0), a3, voffA);
            PG8_WAIT_V(8); PG8_WAIT_L(0); PG8_BAR; PG8_MMA(1, 0, At, B0); PG8_MMA(1, 1, At, B1); PG8_BAR; PG8_SCHED;
            } else {
            PG8_LDB(B0, 0, 0); PG8_SCHED; PG8_LDA(At, 0, 0); PG8_STAGE(PG8_SA(1, 1), a1 + hstep, voffA);
            PG8_WAIT_L(8); PG8_BAR; PG8_WAIT_L(0); PG8_MMA(0, 0, At, B0); PG8_BAR; PG8_SCHED;
            PG8_LDB(B1, 0, 1); PG8_STAGE(PG8_SB(0, 0), b2, voffB);
            PG8_BAR; PG8_WAIT_L(0); PG8_MMA(0, 1, At, B1); PG8_BAR;
            PG8_LDA(At, 0, 1); PG8_STAGE(PG8_SA(0, 0), a2, voffA);
            PG8_BAR; PG8_WAIT_L(0); PG8_MMA(1, 0, At, B0); PG8_BAR; PG8_SCHED;
            PG8_STAGE(PG8_SB(0, 1), b2 + hstep, voffB);
            PG8_WAIT_V(6); PG8_BAR; PG8_MMA(1, 1, At, B1); PG8_BAR;
            PG8_LDB(B0, 1, 0); PG8_SCHED; PG8_LDA(At, 1, 0); PG8_STAGE(PG8_SA(0, 1), a2 + hstep, voffA);
            PG8_WAIT_L(8); PG8_BAR; PG8_WAIT_L(0); PG8_MMA(0, 0, At, B0); PG8_BAR; PG8_SCHED;
            PG8_LDB(B1, 1, 1); PG8_STAGE(PG8_SB(1, 0), b3, voffB);
            PG8_BAR; PG8_WAIT_L(0); PG8_MMA(0, 1, At, B1); PG8_BAR;
            PG8_LDA(At, 1, 1); PG8_STAGE(PG8_SA(1, 0), a3, voffA);
            PG8_BAR; PG8_WAIT_L(0); PG8_MMA(1, 0, At, B0); PG8_BAR; PG8_SCHED;
            PG8_STAGE(PG8_SB(1, 1), b3 + hstep, voffB);
            PG8_WAIT_V(6); PG8_BAR; PG8_MMA(1, 1, At, B1); PG8_BAR;
            }
        }
        if constexpr (ALIGN_EPI) { if (wr == 0) PG8_BAR; }
        if constexpr (!Epi::AFTER_DRAIN) { const int le_ = lane_id(); E(acc, cur, wr, wc, le_ & 15, le_ >> 4); S.done(cur); }
        if (!has_next) break;
#pragma unroll
        for (int a = 0; a < 2; ++a)
#pragma unroll
            for (int b = 0; b < 2; ++b)
#pragma unroll
                for (int m = 0; m < 4; ++m)
#pragma unroll
                    for (int n = 0; n < 2; ++n) acc[a][b][m][n] = (f32x4){0.f, 0.f, 0.f, 0.f};
        cur = nxt; cA = nA; cB = nB; ++ui;
        if constexpr (ALIGN_EPI) { if (wr == 1) PG8_BAR; }
    }
    PG8_WAIT_V(0);
    if constexpr (!ALIGN_EPI) { if (wr == 0) PG8_BAR; }
    PG8_BAR;
    if constexpr (Epi::AFTER_DRAIN) { E.fused(acc, cur, wr, wc, fr, fq, lds, wid, lane); S.done(cur); }
#undef PG8_SA
#undef PG8_SB
#undef PG8_STAGE
#undef PG8_LDA
#undef PG8_LDB
#undef PG8_MMA
#undef PG8_WAIT_V
#undef PG8_WAIT_L
#undef PG8_BAR
#undef PG8_SCHED
}
}
using pg8::bf16_t; using pg8::bf16x8; using pg8::f32x4; using pg8::u32x4;
#define LAS __attribute__((address_space(3)))
typedef float f32x16 __attribute__((ext_vector_type(16)));
typedef float f32x2 __attribute__((ext_vector_type(2)));
typedef unsigned u32x2 __attribute__((ext_vector_type(2)));
typedef short v4i16_t __attribute__((ext_vector_type(4)));

constexpr int SEQ = 8192, MREAL = 16384, MALLOC = 16448, DM = 1024, NTHR = 512;
constexpr float EPS = 1e-6f, LOG2E = 1.4426950408889634f;
constexpr size_t R1K = (size_t)MALLOC * 1024 * 2;
constexpr size_t al64k(size_t x) { return (x + 65535) & ~(size_t)65535; }
constexpr size_t WS_CTL = 0, CTL_BYTES = 65536;
constexpr size_t WS_ROPE = CTL_BYTES;
constexpr size_t WS_SSQ = al64k(WS_ROPE + (size_t)8208 * 16 * 8);
constexpr size_t WS_SSQQ = al64k(WS_SSQ + (size_t)MALLOC * 16 * 4);
constexpr size_t WS_SSQKV = al64k(WS_SSQQ + (size_t)MALLOC * 4 * 4);
constexpr size_t WS_XMETA = al64k(WS_SSQKV + (size_t)MALLOC * 4 * 4);
constexpr size_t WS_KR = al64k(WS_XMETA + 65536);
constexpr size_t WS_W = al64k(WS_KR + (size_t)MALLOC * 32 * 2);
constexpr size_t WO_IN = 0, WO_GA = 2097152, WO_GB = 3145728, WO_Q = 4194304, WO_KV = 4390912, WO_A = 4521984, WO_B = 5046272, WO_O = 5570560, WO_UP = 6619136, WO_DN = 10813440, W_ELEMS = 15007744;
constexpr size_t WS_XB = al64k(WS_W + W_ELEMS * 2);
constexpr size_t WS_POOL = al64k(WS_XB + R1K);
constexpr size_t PO_S = 0;
constexpr size_t PO_QA = PO_S, PO_KVA = PO_S + (size_t)MALLOC * 256 * 2;
constexpr size_t PO_AO = R1K, PO_DN = R1K + R1K / 2;
constexpr size_t PO_DQ = 2 * R1K, PO_DK = 2 * R1K + R1K / 2, PO_DV = 3 * R1K, PO_Q = 3 * R1K + R1K / 2, PO_KV = 4 * R1K + R1K / 4;
constexpr size_t PO_YQ = 2 * R1K;
constexpr size_t PO_H = 0;
constexpr size_t WS_END = WS_POOL + 5 * R1K + R1K / 4;
static_assert(WS_END <= (size_t)256 * 1024 * 1024, "workspace map exceeds 256 MiB");

struct Params {
    const float* in[21]; float* out; unsigned char* ws;
};

typedef const Params __attribute__((address_space(4)))* kparams_t;
__device__ __forceinline__ kparams_t kparams() { kparams_t p = (kparams_t)__builtin_amdgcn_kernarg_segment_ptr(); asm volatile("" : "+s"(p)); return p; }
#define KPAR kparams()
__device__ __forceinline__ unsigned cvt_pk(float lo, float hi) { return pg8::cvt_pk_bf16(lo, hi); }
__device__ __forceinline__ u32x2 pk4(f32x4 v) { u32x2 r; r.x = cvt_pk(v[0], v[1]); r.y = cvt_pk(v[2], v[3]); return r; }
__device__ __forceinline__ float bf2f(unsigned short b) { return __uint_as_float((unsigned)b << 16); }
__device__ __forceinline__ f32x4 ld_bf4(const bf16_t* p) { const u32x2 w = *(const u32x2*)p; return (f32x4){__uint_as_float(w.x << 16), __uint_as_float(w.x & 0xffff0000u), __uint_as_float(w.y << 16), __uint_as_float(w.y & 0xffff0000u)}; }
__device__ __forceinline__ u32x4 pk8(f32x4 a, f32x4 b) { const u32x2 x = pk4(a), y = pk4(b); return (u32x4){x.x, x.y, y.x, y.y}; }
__device__ __forceinline__ void ld_bf8(const bf16_t* p, f32x4& a, f32x4& b) { const u32x4 w = *(const u32x4*)p;
    a = (f32x4){__uint_as_float(w.x << 16), __uint_as_float(w.x & 0xffff0000u), __uint_as_float(w.y << 16), __uint_as_float(w.y & 0xffff0000u)};
    b = (f32x4){__uint_as_float(w.z << 16), __uint_as_float(w.z & 0xffff0000u), __uint_as_float(w.w << 16), __uint_as_float(w.w & 0xffff0000u)}; }
__device__ __forceinline__ float sum4v(f32x4 a) { return (a[0] + a[1]) + (a[2] + a[3]); }
__device__ __forceinline__ float sumsq4(f32x4 a) { return (a[0] * a[0] + a[1] * a[1]) + (a[2] * a[2] + a[3] * a[3]); }
__device__ __forceinline__ float sum16p(const float* p) { const f32x4* q = (const f32x4*)p; return (sum4v(q[0]) + sum4v(q[1])) + (sum4v(q[2]) + sum4v(q[3])); }
__device__ __forceinline__ float sum4p(const float* p) { return sum4v(*(const f32x4*)p); }
__device__ __forceinline__ float shx(float v, int mask) { const int l = lane_id(); return __int_as_float(__builtin_amdgcn_ds_bpermute((l ^ mask) << 2, __float_as_int(v))); }
__device__ __forceinline__ float half_max(float v) { const auto rr = __builtin_amdgcn_permlane32_swap(__float_as_uint(v), __float_as_uint(v), false, false); return fmaxf(__uint_as_float(rr[0]), __uint_as_float(rr[1])); }
__device__ __forceinline__ float half_sum(float v) { const auto rr = __builtin_amdgcn_permlane32_swap(__float_as_uint(v), __float_as_uint(v), false, false); return __uint_as_float(rr[0]) + __uint_as_float(rr[1]); }
__device__ __forceinline__ float wave_sum(float v) {
#pragma unroll
    for (int o = 1; o < 64; o <<= 1) v += shx(v, o);
    return v;
}
__device__ __forceinline__ float fq_sum(float s) { s += shx(s, 16); s += shx(s, 32); return s; }
__device__ __forceinline__ int tok_pos(int row) { return row < MREAL ? 16 + (row & (SEQ - 1)) : row - MREAL; }
__device__ __forceinline__ float sigmoidf_(float z) { return __builtin_amdgcn_rcpf(1.0f + __builtin_amdgcn_exp2f(-LOG2E * z)); }

struct REWin {
    static constexpr bool PERM = false; static constexpr int NP = 16, FENCE = 0, KMAX = 1; const float* ssq; unsigned* kmax_word; __device__ __forceinline__ const float* nsrc() const { return ssq; } bf16_t *QA, *KVA, *KR, *DQ, *DK, *DVv; float *ssqq, *ssqkv; const f32x2* rope;
    __device__ __forceinline__ void row(int row, int pn, int wc, int fq, f32x4 (&v)[2][2], float rstd) const {
#pragma unroll
        for (int bj = 0; bj < 2; ++bj)
#pragma unroll
            for (int n = 0; n < 2; ++n) v[bj][n] = v[bj][n] * rstd;
        const int cw = 32 * wc + 4 * fq;
        if (pn == 0) {
            float s = 0.f;
#pragma unroll
            for (int bj = 0; bj < 2; ++bj)
#pragma unroll
                for (int n = 0; n < 2; ++n) { *(u32x2*)(QA + (size_t)row * 256 + 128 * bj + cw + 16 * n) = pk4(v[bj][n]); s += sumsq4(v[bj][n]); }
            s = fq_sum(s); if (fq == 0) ssqq[(size_t)row * 4 + wc] = s;
        } else if (pn == 1) {
            float s = 0.f;
#pragma unroll
            for (int n = 0; n < 2; ++n) { *(u32x2*)(KVA + (size_t)row * 128 + cw + 16 * n) = pk4(v[0][n]); s += sumsq4(v[0][n]); }
            s = fq_sum(s); if (fq == 0) ssqkv[(size_t)row * 4 + wc] = s;
            if (wc == 0) {
                const f32x2* t = rope + (size_t)tok_pos(row) * 16 + 4 * fq; f32x4 a, b;
#pragma unroll
                for (int i = 0; i < 4; ++i) { const f32x2 cs = t[i]; a[i] = v[1][0][i] * cs.x - v[1][1][i] * cs.y; b[i] = v[1][0][i] * cs.y + v[1][1][i] * cs.x; }
                *(u32x2*)(KR + (size_t)row * 32 + 4 * fq) = pk4(a); *(u32x2*)(KR + (size_t)row * 32 + 16 + 4 * fq) = pk4(b);
            }
        } else {
            bf16_t* dst = DQ + (size_t)((pn - 2) >> 1) * ((size_t)MALLOC * 512); const float sc = pn < 4 ? 0.125f * LOG2E : 1.0f; const int c0 = (pn & 1) * 256;
#pragma unroll
            for (int bj = 0; bj < 2; ++bj)
#pragma unroll
                for (int n = 0; n < 2; ++n) *(u32x2*)(dst + (size_t)row * 512 + c0 + 128 * bj + cw + 16 * n) = pk4(v[bj][n] * sc);
        }
    }
};
struct REQup {
    static constexpr bool PERM = false; static constexpr int NP = 4, FENCE = 0, KMAX = 0; const float* ssqq; bf16_t* Q; const f32x2* rope; __device__ __forceinline__ const float* nsrc() const { return ssqq; }
    __device__ __forceinline__ void row(int row, int pn, int wc, int fq, f32x4 (&v)[2][2], float rstd) const {
        const float sc = rstd * (0.10206207261596577f * LOG2E);
#pragma unroll
        for (int bj = 0; bj < 2; ++bj) {
            const int g32 = 256 * pn + 128 * bj + 32 * wc; f32x4 a = v[bj][0] * sc, b = v[bj][1] * sc;
            if ((g32 % 96) == 64) {
                const f32x2* t = rope + (size_t)tok_pos(row) * 16 + 4 * fq; f32x4 a2, b2;
#pragma unroll
                for (int i = 0; i < 4; ++i) { const f32x2 cs = t[i]; a2[i] = a[i] * cs.x - b[i] * cs.y; b2[i] = a[i] * cs.y + b[i] * cs.x; }
                a = a2; b = b2;
            }
            *(u32x2*)(Q + (size_t)row * 768 + g32 + 4 * fq) = pk4(a); *(u32x2*)(Q + (size_t)row * 768 + g32 + 16 + 4 * fq) = pk4(b);
        }
    }
};
struct REKVup {
    static constexpr bool PERM = true; static constexpr int NP = 4, FENCE = 0, KMAX = 0; const float* ssqkv; bf16_t* KV; __device__ __forceinline__ const float* nsrc() const { return ssqkv; }
    __device__ __forceinline__ void row(int row, int pn, int wc, int fq, f32x4 (&v)[2][2], float rstd) const {
        const float sc = rstd;
#pragma unroll
        for (int bj = 0; bj < 2; ++bj) *(u32x4*)(KV + (size_t)row * 1024 + 256 * pn + 128 * bj + 32 * wc + 8 * fq) = pk8(v[bj][0] * sc, v[bj][1] * sc);
    }
};
struct REStore {
    static constexpr bool PERM = true; static constexpr int NP = 0, FENCE = 0, KMAX = 0; bf16_t* O; __device__ __forceinline__ const float* nsrc() const { return nullptr; }
    __device__ __forceinline__ void row(int row, int pn, int wc, int fq, f32x4 (&v)[2][2], float rstd) const {
#pragma unroll
        for (int bj = 0; bj < 2; ++bj) *(u32x4*)(O + (size_t)row * 1024 + 256 * pn + 128 * bj + 32 * wc + 8 * fq) = pk8(v[bj][0], v[bj][1]);
    }
};
struct REGate {
    static constexpr bool PERM = true; static constexpr int NP = 16, FENCE = 1, KMAX = 0; const float* ssq; const float* bias; bf16_t* Y; const bf16_t* T; int add; __device__ __forceinline__ const float* nsrc() const { return ssq; }
    __device__ __forceinline__ void row(int row, int pn, int wc, int fq, f32x4 (&v)[2][2], float rstd) const {
#pragma unroll
        for (int bj = 0; bj < 2; ++bj) {
            const int col = 256 * pn + 128 * bj + 32 * wc + 8 * fq; const f32x4 b0 = *(const f32x4*)(bias + col), b1 = *(const f32x4*)(bias + col + 4);
            f32x4 g0, g1;
#pragma unroll
            for (int i = 0; i < 4; ++i) { g0[i] = sigmoidf_(v[bj][0][i] * rstd + b0[i]); g1[i] = sigmoidf_(v[bj][1][i] * rstd + b1[i]); }
            bf16_t* yp = Y + (size_t)row * 1024 + col; f32x4 y0, y1; ld_bf8(yp, y0, y1);
            f32x4 r0, r1; if (add) { f32x4 t0, t1; ld_bf8(T + (size_t)row * 1024 + col, t0, t1); r0 = y0 + g0 * t0; r1 = y1 + g1 * t1; } else { r0 = g0 * y0; r1 = g1 * y1; }
            *(u32x4*)yp = pk8(r0, r1);
        }
    }
};
struct REResid {
    static constexpr bool PERM = true; static constexpr int NP = 0, FENCE = 1, KMAX = 0; const float* base_main; const float* base_meta; float* out_main; float* out_meta; bf16_t* XB; float* ssq; __device__ __forceinline__ const float* nsrc() const { return nullptr; }
    __device__ __forceinline__ void row(int row, int pn, int wc, int fq, f32x4 (&v)[2][2], float rstd) const {
        const float* bp = row < MREAL ? base_main + (size_t)row * 1024 : base_meta + (size_t)(row - MREAL) * 1024;
        float* op = row < MREAL ? out_main + (size_t)row * 1024 : out_meta + (size_t)(row - MREAL) * 1024;
        float s = 0.f;
#pragma unroll
        for (int bj = 0; bj < 2; ++bj) {
            const int col = 256 * pn + 128 * bj + 32 * wc + 8 * fq;
            const f32x4 x0 = *(const f32x4*)(bp + col) + v[bj][0], x1 = *(const f32x4*)(bp + col + 4) + v[bj][1];
            *(f32x4*)(op + col) = x0; *(f32x4*)(op + col + 4) = x1; *(u32x4*)(XB + (size_t)row * 1024 + col) = pk8(x0, x1); s += sumsq4(x0) + sumsq4(x1);
        }
        s = fq_sum(s); if (fq == 0) ssq[(size_t)row * 16 + pn * 4 + wc] = s;
    }
};
struct REUp {
    static constexpr bool PERM = true; static constexpr int NP = 16, FENCE = 0, KMAX = 0; const float* ssq; bf16_t* H; __device__ __forceinline__ const float* nsrc() const { return ssq; }
    __device__ __forceinline__ void row(int row, int pn, int wc, int fq, f32x4 (&v)[2][2], float rstd) const {
#pragma unroll
        for (int bj = 0; bj < 2; ++bj) { f32x4 t0 = v[bj][0] * rstd, t1 = v[bj][1] * rstd;
#pragma unroll
            for (int i = 0; i < 4; ++i) { const float r0 = fmaxf(t0[i], 0.f), r1 = fmaxf(t1[i], 0.f); t0[i] = r0 * r0; t1[i] = r1 * r1; }
            *(u32x4*)(H + (size_t)row * 4096 + 256 * pn + 128 * bj + 32 * wc + 8 * fq) = pk8(t0, t1); }
    }
};
template <int NP> __device__ __forceinline__ float row_part(const float* p, int row, int fq) {
    if (NP == 16) return sum4v(*(const f32x4*)(p + (size_t)row * 16 + 4 * fq));
    if (NP == 4) return p[(size_t)row * 4 + fq];
    return 0.f;
}
template <int NP> __device__ __forceinline__ float row_rstd(float part) {
    if (NP == 0) return 1.0f;
    const float tot = fq_sum(part);
    return rsqrtf(tot * (NP == 16 ? (1.0f / 1024.0f) : 1.0f) + EPS);
}
template <class RE> struct EpiRows {
    static constexpr bool PERM = RE::PERM, AFTER_DRAIN = false; RE e; float inv_n;
    __device__ __forceinline__ void operator()(const f32x4 (&acc)[2][2][4][2], const pg8::Unit& u, int wr, int wc, int fr, int fq) const {
        float rs[2][4];
        if (RE::NP != 0) {
            const float* ns = e.nsrc(); float part[2][4];
#pragma unroll
            for (int ai = 0; ai < 2; ++ai)
#pragma unroll
                for (int m = 0; m < 4; ++m) part[ai][m] = row_part<RE::NP>(ns, u.pm * 256 + ai * 128 + wr * 64 + m * 16 + fr, fq);
#pragma unroll
            for (int ai = 0; ai < 2; ++ai)
#pragma unroll
                for (int m = 0; m < 4; ++m) rs[ai][m] = rsqrtf(fq_sum(part[ai][m]) * inv_n + EPS);
        }
#pragma unroll
        for (int ai = 0; ai < 2; ++ai)
#pragma unroll
            for (int m = 0; m < 4; ++m) { f32x4 v[2][2] = {{acc[ai][0][m][0], acc[ai][0][m][1]}, {acc[ai][1][m][0], acc[ai][1][m][1]}};
                e.row(u.pm * 256 + ai * 128 + wr * 64 + m * 16 + fr, u.pn, wc, fq, v, RE::NP != 0 ? rs[ai][m] : 1.0f);
                if (RE::FENCE && (m & 1)) asm volatile("" ::: "memory"); }
        if constexpr (RE::KMAX != 0) { if (u.pn == 4 || u.pn == 5) {
            float kmx = 0.f;
#pragma unroll
            for (int ai = 0; ai < 2; ++ai)
#pragma unroll
                for (int m = 0; m < 4; ++m)
#pragma unroll
                    for (int bj = 0; bj < 2; ++bj) kmx = fmaxf(kmx, fq_sum(sumsq4(acc[ai][bj][m][0]) + sumsq4(acc[ai][bj][m][1])) * rs[ai][m] * rs[ai][m]);
#pragma unroll
            for (int o = 1; o < 16; o <<= 1) kmx = fmaxf(kmx, shx(kmx, o));
            if (lane_id() == 0) atomicMax(e.kmax_word, __float_as_uint(kmx)); } }
    }
};
template <class RE> __device__ __forceinline__ void meta_gemm(LAS unsigned char* lds, const bf16_t* A, const bf16_t* Bt, int N, int K, const RE& e, float inv_n, int g_wid) {
    int tid_o = (g_wid << 6) | lane_id(); const int tid = tid_o, wid = tid >> 6, lane = tid & 63, fr = lane & 15, fq = lane >> 4;
    const bf16_t* A16 = A + (size_t)MREAL * K;
    for (int u = blockIdx.x; u < N / 64; u += gridDim.x) {
        const int pn = u >> 2, wc = u & 3;
        f32x4 acc[2][2];
#pragma unroll
        for (int bj = 0; bj < 2; ++bj)
#pragma unroll
            for (int n = 0; n < 2; ++n) acc[bj][n] = (f32x4){0.f, 0.f, 0.f, 0.f};
        const int nst = K >= 256 ? K / 256 : 1, nwv = K >= 256 ? 8 : K / 32;
#pragma unroll 4
        for (int s = 0; s < (wid < nwv ? nst : 0); ++s) {
            const int k0 = (wid * nst + s) * 32 + 8 * fq;
            const bf16x8 a = *(const bf16x8*)(A16 + (size_t)fr * K + k0);
#pragma unroll
            for (int bj = 0; bj < 2; ++bj)
#pragma unroll
                for (int n = 0; n < 2; ++n) { const bf16x8 b = *(const bf16x8*)(Bt + (size_t)(256 * pn + 128 * bj + 32 * wc + (RE::PERM ? 8 * (fr >> 2) + 4 * n + (fr & 3) : 16 * n + fr)) * K + k0);
                    acc[bj][n] = __builtin_amdgcn_mfma_f32_16x16x32_bf16(b, a, acc[bj][n], 0, 0, 0); }
        }
        LAS f32x4* red = (LAS f32x4*)lds;
#pragma unroll
        for (int bj = 0; bj < 2; ++bj)
#pragma unroll
            for (int n = 0; n < 2; ++n) red[(wid * 4 + bj * 2 + n) * 64 + lane] = acc[bj][n];
        __syncthreads();
        if (wid == 0) {
            f32x4 v[2][2];
#pragma unroll
            for (int bj = 0; bj < 2; ++bj)
#pragma unroll
                for (int n = 0; n < 2; ++n) { f32x4 s = red[(bj * 2 + n) * 64 + lane];
#pragma unroll
                    for (int w = 1; w < 8; ++w) s = s + red[(w * 4 + bj * 2 + n) * 64 + lane];
                    v[bj][n] = s; }
            float rstd = 1.0f;
            if (RE::NP != 0) rstd = rsqrtf(fq_sum(row_part<RE::NP>(e.nsrc(), MREAL + fr, fq)) * inv_n + EPS);
            e.row(MREAL + fr, pn, wc, fq, v, rstd);
            if constexpr (RE::KMAX != 0) { if (pn == 4 || pn == 5) { float kmx = 0.f;
#pragma unroll
                for (int bj = 0; bj < 2; ++bj) kmx = fmaxf(kmx, fq_sum(sumsq4(v[bj][0]) + sumsq4(v[bj][1])));
#pragma unroll
                for (int o = 1; o < 16; o <<= 1) kmx = fmaxf(kmx, shx(kmx, o));
                if (lane == 0) atomicMax(e.kmax_word, __float_as_uint(kmx)); } }
        }
        __syncthreads();
    }
}
template <class RE> __device__ __forceinline__ void gemm_all(LAS unsigned char* lds, const bf16_t* A, const bf16_t* Bt, int N, int K, const RE& e, bool do_meta, int g_wid) {
    asm volatile("" : "+s"(A), "+s"(Bt));
    if (do_meta) meta_gemm<RE>(lds, A, Bt, N, K, e, 1.0f / (float)K, g_wid);
    pg8::Gemm g{A, Bt, MREAL, N, K}; pg8::StaticOrder S; S.init(MREAL, N, (int)gridDim.x, (int)blockIdx.x);
    EpiRows<RE> E{e, 1.0f / (float)K};
    pg8::gemm_phase<EpiRows<RE>, pg8::StaticOrder, true, true>(lds, g, S, E, g_wid);
}

__device__ __forceinline__ unsigned f2bf(float f) { unsigned u = __float_as_uint(f); return (u + 0x7fffu + ((u >> 16) & 1u)) >> 16; }
__device__ __forceinline__ unsigned pk2(float lo, float hi) { return f2bf(lo) | (f2bf(hi) << 16); }
__device__ __forceinline__ void transpose_item(const float* W, int ldw, int K, int col0, int ncolblk, bf16_t* WT, int row0, const float* gain, int gmask, float gscale, LAS float* scr, int item, int lane) {
    const int kb = item / ncolblk, nb = item % ncolblk, k0 = 64 * kb, n0 = 32 * nb;
#pragma unroll
    for (int i = 0; i < 8; ++i) { const int kk = 8 * i + (lane >> 3), c4 = (lane & 7) * 4; const float g = gain ? gain[(k0 + kk) & gmask] * gscale : 1.0f;
        const f32x4 w4 = *(const f32x4*)(W + (size_t)(k0 + kk) * ldw + col0 + n0 + c4);
        LAS float* d = scr + kk * 33 + c4; d[0] = w4[0] * g; d[1] = w4[1] * g; d[2] = w4[2] * g; d[3] = w4[3] * g; }
    asm volatile("s_waitcnt lgkmcnt(0)" ::: "memory");
    const int c = lane & 7;
#pragma unroll
    for (int j = 0; j < 4; ++j) { const int n = (lane >> 3) + 8 * j; const LAS float* s = scr + (8 * c) * 33 + n;
        u32x4 o; o.x = pk2(s[0 * 33], s[1 * 33]); o.y = pk2(s[2 * 33], s[3 * 33]); o.z = pk2(s[4 * 33], s[5 * 33]); o.w = pk2(s[6 * 33], s[7 * 33]);
        *(u32x4*)(WT + (size_t)(row0 + n0 + n) * K + k0 + 8 * c) = o; }
    asm volatile("s_waitcnt lgkmcnt(0)" ::: "memory");
}
__device__ __forceinline__ void convert_weights(const Params& P, int l, LAS unsigned char* lds, int g_wid) {
    int tid_o = (g_wid << 6) | lane_id(); const int tid = tid_o, wid = tid >> 6, lane = tid & 63;
    LAS float* scr = (LAS float*)(lds + wid * 16384);
    bf16_t* W = (bf16_t*)(KPAR->ws + WS_W);
    const float* w_in = KPAR->in[3] + (size_t)l * 1024 * 4000; const float* attn_norm = KPAR->in[2] + l * 1024;
    const float* w_q = KPAR->in[6] + (size_t)l * 256 * 768; const float* qn = KPAR->in[5] + l * 256;
    const float* w_kv = KPAR->in[8] + (size_t)l * 128 * 1024; const float* kvn = KPAR->in[7] + l * 128;
    const float* w_a = KPAR->in[14] + (size_t)l * 512 * 1024; const float* w_b = KPAR->in[15] + (size_t)l * 512 * 1024; const float* subln = KPAR->in[13] + l * 128;
    const float* w_o = KPAR->in[16] + (size_t)l * 1024 * 1024; const float* mlpn = KPAR->in[17] + l * 1024;
    const float* w_up = KPAR->in[18] + (size_t)l * 1024 * 4096; const float* w_dn = KPAR->in[19] + (size_t)l * 4096 * 1024;
    const float lam_scale = 1.0f - (l == 0 ? 0.2f : 0.35550907f);
    const int gw = blockIdx.x * 8 + wid, NGW = gridDim.x * 8;
    constexpr int NITEMS = 208 + 768 + 512 + 512 + 96 + 64 + 256 + 256 + 512 + 2048 + 2048;
    for (int it = gw; it < NITEMS; it += NGW) {
        int r = it;
        if (r < 208) { transpose_item(w_in, 4000, 1024, 0, 13, W + WO_IN, 0, attn_norm, 1023, 1.f, scr, r, lane); continue; } r -= 208;
        if (r < 768) { transpose_item(w_in, 4000, 1024, 416, 48, W + WO_IN, 512, attn_norm, 1023, 1.f, scr, r, lane); continue; } r -= 768;
        if (r < 512) { transpose_item(w_in, 4000, 1024, 1952, 32, W + WO_GA, 0, attn_norm, 1023, 1.f, scr, r, lane); continue; } r -= 512;
        if (r < 512) { transpose_item(w_in, 4000, 1024, 2976, 32, W + WO_GB, 0, attn_norm, 1023, 1.f, scr, r, lane); continue; } r -= 512;
        if (r < 96) { transpose_item(w_q, 768, 256, 0, 24, W + WO_Q, 0, qn, 255, 1.f, scr, r, lane); continue; } r -= 96;
        if (r < 64) { transpose_item(w_kv, 1024, 128, 0, 32, W + WO_KV, 0, kvn, 127, 1.f, scr, r, lane); continue; } r -= 64;
        if (r < 256) { transpose_item(w_a, 1024, 512, 0, 32, W + WO_A, 0, nullptr, 0, 1.f, scr, r, lane); continue; } r -= 256;
        if (r < 256) { transpose_item(w_b, 1024, 512, 0, 32, W + WO_B, 0, subln, 127, lam_scale, scr, r, lane); continue; } r -= 256;
        if (r < 512) { transpose_item(w_o, 1024, 1024, 0, 32, W + WO_O, 0, nullptr, 0, 1.f, scr, r, lane); continue; } r -= 512;
        if (r < 2048) { transpose_item(w_up, 4096, 1024, 0, 128, W + WO_UP, 0, mlpn, 1023, 1.f, scr, r, lane); continue; } r -= 2048;
        transpose_item(w_dn, 1024, 4096, 0, 32, W + WO_DN, 0, nullptr, 0, 1.f, scr, r, lane);
    }
}
__device__ __forceinline__ void prologue_x(const Params& P, int g_wid) {
    int tid_o = (g_wid << 6) | lane_id(); const int tid = tid_o, wid = tid >> 6, lane = tid & 63;
    const int gw = blockIdx.x * 8 + wid, NGW = gridDim.x * 8;
    bf16_t* XB = (bf16_t*)(KPAR->ws + WS_XB); float* ssq = (float*)(KPAR->ws + WS_SSQ);
    for (int row = gw; row < MREAL + 16; row += NGW) {
        const float* src = row < MREAL ? KPAR->in[0] + (size_t)row * 1024 : KPAR->in[1] + (size_t)(row - MREAL) * 1024;
        float s = 0.f;
#pragma unroll
        for (int j = 0; j < 4; ++j) { const f32x4 v = ((const f32x4*)src)[64 * j + lane]; s += sumsq4(v); ((u32x2*)(XB + (size_t)row * 1024))[64 * j + lane] = pk4(v); }
        s = wave_sum(s);
        if (lane < 16) ssq[(size_t)row * 16 + lane] = lane == 0 ? s : 0.f;
    }
    { bf16_t* W = (bf16_t*)(KPAR->ws + WS_W);
      for (int i = blockIdx.x * NTHR + tid; i < 96 * 1024 / 8; i += gridDim.x * NTHR) ((u32x4*)(W + WO_IN + 416 * 1024))[i] = (u32x4){0u, 0u, 0u, 0u}; }
    f32x2* rope = (f32x2*)(KPAR->ws + WS_ROPE);
    for (int e = blockIdx.x * NTHR + tid; e < 8208 * 16; e += gridDim.x * NTHR) {
        const int pos = e >> 4, i = e & 15, i4 = i & 3, i16 = i >> 2;
        const float c4 = i4 == 0 ? 1.0f : (i4 == 1 ? 0.56234132519f : (i4 == 2 ? 0.31622776602f : 0.17782794100f));
        const float s16 = i16 == 0 ? 1.0f : (i16 == 1 ? 0.1f : (i16 == 2 ? 0.01f : 0.001f));
        const float inv = c4 * s16; const float ang = (float)pos * inv;
        const double x = (double)ang; const double nq = __builtin_rint(x * 0.63661977236758134308); const double r = __builtin_fma(-nq, 1.57079632679489661923, x);
        const double r2 = r * r;
        const double sn = r * (1.0 + r2 * (-1.0 / 6 + r2 * (1.0 / 120 + r2 * (-1.0 / 5040 + r2 * (1.0 / 362880 + r2 * (-1.0 / 39916800 + r2 * (1.0 / 6227020800.0)))))));
        const double cs = 1.0 + r2 * (-0.5 + r2 * (1.0 / 24 + r2 * (-1.0 / 720 + r2 * (1.0 / 40320 + r2 * (-1.0 / 3628800 + r2 * (1.0 / 479001600.0 + r2 * (-1.0 / 87178291200.0)))))));
        const int q = ((int)nq) & 3;
        const double c = q == 0 ? cs : (q == 1 ? -sn : (q == 2 ? -cs : sn));
        const double s = q == 0 ? sn : (q == 1 ? cs : (q == 2 ? -sn : -cs));
        rope[e] = (f32x2){(float)c, (float)s};
    }
}
constexpr int AT_KBUF = 12288, AT_VBUF = 16384, AT_K = 0, AT_V = 2 * AT_KBUF, AT_ASC = AT_V + 3 * AT_VBUF, AT_QW = AT_ASC + 1024;
__device__ __forceinline__ int crow(int r, int hi) { return (r & 3) + 8 * (r >> 2) + 4 * hi; }
#define MFMA32(a, b, c) __builtin_amdgcn_mfma_f32_32x32x16_bf16((a), (b), (c), 0, 0, 0)
template <int DQK, int DV, bool ALIBI>
__device__ __forceinline__ void attn_pass(LAS unsigned char* lds, const bf16_t* Qp, int qpitch, const bf16_t* K1, int k1pitch, const bf16_t* K2, int k2pitch,
                                          const bf16_t* Vp, int vpitch, int brow0, int NT, int qreal0, int meta, float sl2, float kmax, f32x16 (&o)[DV / 32], int g_wid) {
    constexpr int NCH = DQK / 8, NDS = DQK / 16, NDB = DV / 32, VCH = DV / 8, KP = (64 * NCH + 511) / 512, VP = (64 * VCH) / 512;
    int tid_o = (g_wid << 6) | lane_id(); const int tid = tid_o, lane = tid & 63, wid = __builtin_amdgcn_readfirstlane(tid >> 6), r32 = lane & 31, hi = lane >> 5;
    bf16x8 qf[NDS];
    { const bf16_t* qrow = Qp + (size_t)(32 * wid + r32) * qpitch + 8 * hi;
#pragma unroll
      for (int ds = 0; ds < NDS; ++ds) qf[ds] = *(const bf16x8*)(qrow + 16 * ds); }
    const bf16_t* ksrc[KP]; int kpit[KP]; unsigned kdst[KP]; bool kval[KP];
#pragma unroll
    for (int i = 0; i < KP; ++i) { const int p = tid + 512 * i; kval[i] = p < 64 * NCH; const int pp = kval[i] ? p : 0; const int key = pp / NCH, c = pp % NCH;
        if (NCH <= 8 || c < 8) { ksrc[i] = K1 + (size_t)key * k1pitch + c * 8; kpit[i] = k1pitch; } else { ksrc[i] = K2 + (size_t)key * k2pitch + (c - 8) * 8; kpit[i] = k2pitch; }
        kdst[i] = AT_K + c * 1024 + ((key ^ c) << 4); }
    const bf16_t* vsrc[VP]; unsigned vdst[VP];
#pragma unroll
    for (int i = 0; i < VP; ++i) { const int p = tid + 512 * i; const int key = p / VCH, c = p % VCH; vsrc[i] = Vp + (size_t)key * vpitch + c * 8; vdst[i] = AT_V + (c >> 2) * 4096 + key * 64 + (c & 3) * 16; }
    u32x4 kregA[KP], vregA[VP];
#define AT_ISSUE(t, KR_, VR_) do { const size_t kb_ = (size_t)((t) == 0 ? MREAL : brow0 + 64 * ((t) - 1)); \
        _Pragma("unroll") for (int i = 0; i < KP; ++i) if (kval[i]) KR_[i] = *(const u32x4*)(ksrc[i] + kb_ * kpit[i]); \
        _Pragma("unroll") for (int i = 0; i < VP; ++i) VR_[i] = *(const u32x4*)(vsrc[i] + kb_ * vpitch); } while (0)
#define AT_COMMIT(kbuf, vslot, KR_, VR_) do { \
        _Pragma("unroll") for (int i = 0; i < KP; ++i) if (kval[i]) *(LAS u32x4*)(lds + kdst[i] + (kbuf) * AT_KBUF) = KR_[i]; \
        _Pragma("unroll") for (int i = 0; i < VP; ++i) *(LAS u32x4*)(lds + vdst[i] + (vslot)) = VR_[i]; } while (0)
#define AT_BAR() asm volatile("s_waitcnt lgkmcnt(0)\n\ts_barrier" ::: "memory")
#define SB() __builtin_amdgcn_sched_barrier(0)
    unsigned kaddr[NDS];
#pragma unroll
    for (int ds = 0; ds < NDS; ++ds) { const int cx = 2 * ds + hi; kaddr[ds] = AT_K + cx * 1024 + ((r32 ^ cx) << 4); }
    const unsigned vb = AT_V + ((lane >> 4) & 1) * 32 + (lane & 3) * 8 + (4 * hi + ((lane & 15) >> 2)) * 64;
    LAS float* asc = (LAS float*)(lds + AT_ASC) + wid * 32;
    float m_ref = 0.f, l = 0.f;
    f32x16 negm;
#pragma unroll
    for (int r = 0; r < 16; ++r) negm[r] = 0.f;
#pragma unroll
    for (int db = 0; db < NDB; ++db)
#pragma unroll
        for (int r = 0; r < 16; ++r) o[db][r] = 0.f;
    const int qw0 = 32 * wid, qrow_l = qw0 + r32;
    bf16x8 pa[4];
    bool resc = false;
#define P_CINIT(t) do { \
        if (ALIBI) { const int kpos0 = (t) == 0 ? 0 : 16 + 64 * ((t) - 1), qpos0 = meta ? 0 : 16 + qreal0; const float tb = sl2x * (float)(kpos0 - qpos0 + 4 * hix) - m_ref; \
            _Pragma("unroll") for (int r = 0; r < 16; ++r) { c0[r] = tb + sl2x * (float)((r & 3) + 8 * (r >> 2)); c1[r] = c0[r] + 32.0f * sl2x; } } \
        else { c0 = negm; c1 = negm; } } while (0)
#define P_KREAD(kb) do { _Pragma("unroll") for (int ds = 0; ds < NDS; ++ds) { kf0[ds] = *(const LAS bf16x8*)(lds + kaddr[ds] + (kb) * AT_KBUF); kf1[ds] = *(const LAS bf16x8*)(lds + kaddr[ds] + (kb) * AT_KBUF + 512); } } while (0)
#define P_QK() do { __builtin_amdgcn_s_setprio(1); _Pragma("unroll") for (int ds = 0; ds < NDS; ++ds) { c0 = MFMA32(kf0[ds], qf[ds], c0); c1 = MFMA32(kf1[ds], qf[ds], c1); } __builtin_amdgcn_s_setprio(0); } while (0)
#define P_VREAD(vsp, dg) do { _Pragma("unroll") for (int d2 = 0; d2 < 2; ++d2) _Pragma("unroll") for (int ks = 0; ks < 4; ++ks) { \
            const LAS unsigned char* vp_ = lds + vb + (vsp) + ((dg) + d2) * 4096 + ks * 1024; \
            vlo[d2][ks] = __builtin_amdgcn_ds_read_tr16_b64_v4i16((LAS v4i16_t*)vp_); vhh[d2][ks] = __builtin_amdgcn_ds_read_tr16_b64_v4i16((LAS v4i16_t*)(vp_ + 512)); } } while (0)
#define P_PV(dg, ksa) do { __builtin_amdgcn_s_setprio(1); _Pragma("unroll") for (int ks = (ksa); ks < (ksa) + 2; ++ks) _Pragma("unroll") for (int d2 = 0; d2 < 2; ++d2) { \
            const bf16x8 vf_ = __builtin_shufflevector(vlo[d2][ks], vhh[d2][ks], 0, 1, 2, 3, 4, 5, 6, 7); o[(dg) + d2] = MFMA32(pa[ks], vf_, o[(dg) + d2]); } __builtin_amdgcn_s_setprio(0); } while (0)
#define P_MASKMAX(t) do { \
        int lim; if ((t) == 0) lim = meta ? (qrow_l < 15 ? qrow_l : 15) : 15; else lim = qreal0 + qrow_l - 64 * ((t) - 1); \
        if (__any(lim < 63)) { \
            _Pragma("unroll") for (int r = 0; r < 16; ++r) { const int kidx = crow(r, hix); if (kidx > lim) c0[r] = -INFINITY; if (kidx + 32 > lim) c1[r] = -INFINITY; } } \
        float mx = fmaxf(c0[0], c1[0]); \
        _Pragma("unroll") for (int r = 1; r < 16; ++r) mx = fmaxf(fmaxf(mx, c0[r]), c1[r]); \
        mx = half_max(mx); \
        if ((t) == 0 || __any(mx > 90.0f)) { \
            const float dl = (t) == 0 ? mx : fmaxf(mx, 0.f); \
            m_ref += dl; \
            _Pragma("unroll") for (int r = 0; r < 16; ++r) { c0[r] -= dl; c1[r] -= dl; negm[r] = -m_ref; } \
            if ((t) != 0) { const float alpha = __builtin_amdgcn_exp2f(-dl); l *= alpha; if (hi == 0) asc[r32] = alpha; resc = true; } \
        } } while (0)
#define P_EXP0() do { _Pragma("unroll") for (int r = 0; r < 16; ++r) c0[r] = __builtin_amdgcn_exp2f(c0[r]); } while (0)
#define P_EXP1SUM() do { float rs0 = 0.f, rs1 = 0.f; \
        _Pragma("unroll") for (int r = 0; r < 16; ++r) { c1[r] = __builtin_amdgcn_exp2f(c1[r]); rs0 += c0[r]; rs1 += c1[r]; } l += rs0 + rs1; } while (0)
#define P_PACK() do { _Pragma("unroll") for (int s = 0; s < 2; ++s) { u32x4 w0, w1; \
        _Pragma("unroll") for (int j = 0; j < 4; ++j) { w0[j] = cvt_pk(c0[8 * s + 2 * j], c0[8 * s + 2 * j + 1]); w1[j] = cvt_pk(c1[8 * s + 2 * j], c1[8 * s + 2 * j + 1]); } \
        pa[s] = __builtin_bit_cast(bf16x8, w0); pa[2 + s] = __builtin_bit_cast(bf16x8, w1); } } while (0)
#define P_RESC() do { if (resc) { resc = false; \
        _Pragma("unroll") for (int g = 0; g < 4; ++g) { const f32x4 a4 = *(const LAS f32x4*)(asc + 8 * g + 4 * hi); \
            _Pragma("unroll") for (int db = 0; db < NDB; ++db) _Pragma("unroll") for (int i = 0; i < 4; ++i) o[db][4 * g + i] *= a4[i]; } } } while (0)
#define AT_OPAQUE() float sl2x = sl2; int hix = hi; asm volatile("" : "+v"(sl2x), "+v"(hix))
    int skip = 0;
    if (ALIBI && !meta && NT > 6) {
        const bf16_t* krow = K1 + (size_t)(brow0 + qreal0 + 32 * wid + r32) * k1pitch + 8 * hi;
        float dot = 0.f, qn2 = 0.f;
#pragma unroll
        for (int ds = 0; ds < NDS; ++ds) { const bf16x8 kk = *(const bf16x8*)(krow + 16 * ds);
#pragma unroll
            for (int j = 0; j < 8; ++j) { const float qv = bf2f((unsigned short)qf[ds][j]), kv = bf2f((unsigned short)kk[j]); dot += qv * kv; qn2 += qv * qv; } }
        dot = half_sum(dot); qn2 = half_sum(qn2);
        float T = dot + sl2 * (float)(32 * wid + r32) - sqrtf(qn2) * kmax - 0.5f;
#pragma unroll
        for (int o2 = 1; o2 < 32; o2 <<= 1) T = fminf(T, shx(T, o2));
        LAS float* tm = (LAS float*)(lds + AT_ASC);
        if (lane == 0) tm[32 * wid] = T;
        AT_BAR();
        float Tmin = tm[0];
#pragma unroll
        for (int w = 1; w < 8; ++w) Tmin = fminf(Tmin, tm[32 * w]);
        const float X = ((Tmin - 48.0f) / sl2 + (float)(qreal0 + 1)) * (1.0f / 64.0f);
        int J = X > 2.0f ? (int)X - 1 : 0;
        J = J < NT - 5 ? J : NT - 5;
        skip = __builtin_amdgcn_readfirstlane(J > 0 ? J : 0);
        NT -= skip;
    }
#define TJ(t) ((t) == 0 ? 0 : (t) + skip)
    int vs_prev = 0, vs_cur = AT_VBUF, vs_next = 2 * AT_VBUF;
    AT_ISSUE(0, kregA, vregA); AT_COMMIT(0, 0, kregA, vregA);
    AT_BAR();
    {
        f32x16 c0, c1; bf16x8 kf0[NDS], kf1[NDS]; AT_OPAQUE();
        if (NT > 1) AT_ISSUE(TJ(1), kregA, vregA);
        P_CINIT(0); P_KREAD(0); SB(); P_QK(); SB(); P_MASKMAX(0); P_EXP0(); P_EXP1SUM(); P_PACK();
        if (NT > 1) AT_COMMIT(1, vs_cur, kregA, vregA);
        AT_BAR();
    }
#define WAVE_HAS(j) ((j) == 0 || 64 * ((j) - 1) <= qreal0 + qw0 + 31)
    const int NT1 = (meta || NT < 5) ? NT : NT - 3;
    for (int t = 1; t < NT1; ++t) {
        f32x16 c0, c1; bf16x8 kf0[NDS], kf1[NDS]; v4i16_t vlo[2][4], vhh[2][4]; AT_OPAQUE();
        const int kb = t & 1;
        if (t + 1 < NT) AT_ISSUE(TJ(t + 1), kregA, vregA);
        P_RESC();
        P_CINIT(TJ(t)); P_KREAD(kb); SB();
        P_QK(); SB(); P_VREAD(vs_prev, 0); SB(); P_PV(0, 0); SB();
        P_MASKMAX(TJ(t)); SB();
        P_PV(0, 2); SB(); if (NDB == 4) P_VREAD(vs_prev, 2); SB();
        P_EXP0(); SB();
        if (NDB == 4) P_PV(2, 0); SB();
        P_EXP1SUM(); SB();
        if (NDB == 4) P_PV(2, 2); SB();
        P_PACK();
        if (t + 1 < NT) AT_COMMIT(kb ^ 1, vs_next, kregA, vregA);
        AT_BAR();
        const int tmp_ = vs_prev; vs_prev = vs_cur; vs_cur = vs_next; vs_next = tmp_;
    }
    for (int t = NT1; t < NT; ++t) {
        const int kb = t & 1;
        if (t + 1 < NT) AT_ISSUE(TJ(t + 1), kregA, vregA);
        if (WAVE_HAS(TJ(t - 1))) {
            v4i16_t vlo[2][4], vhh[2][4];
            P_RESC();
            P_VREAD(vs_prev, 0); SB(); P_PV(0, 0); P_PV(0, 2); SB();
            if (NDB == 4) { P_VREAD(vs_prev, 2); SB(); P_PV(2, 0); P_PV(2, 2); SB(); }
        }
        if (WAVE_HAS(TJ(t))) {
            f32x16 c0, c1; bf16x8 kf0[NDS], kf1[NDS]; AT_OPAQUE();
            P_CINIT(TJ(t)); P_KREAD(kb); SB(); P_QK(); SB(); P_MASKMAX(TJ(t)); P_EXP0(); P_EXP1SUM(); P_PACK();
        }
        if (t + 1 < NT) AT_COMMIT(kb ^ 1, vs_next, kregA, vregA);
        AT_BAR();
        const int tmp_ = vs_prev; vs_prev = vs_cur; vs_cur = vs_next; vs_next = tmp_;
    }
    {
        if (WAVE_HAS(TJ(NT - 1))) {
            v4i16_t vlo[2][4], vhh[2][4];
            P_RESC();
            P_VREAD(vs_prev, 0); SB(); P_PV(0, 0); P_PV(0, 2); SB();
            if (NDB == 4) { P_VREAD(vs_prev, 2); SB(); P_PV(2, 0); P_PV(2, 2); SB(); }
        }
        AT_BAR();
    }
#undef WAVE_HAS
    l = half_sum(l);
    const float inv = 1.0f / l;
    if (hi == 0) asc[r32] = inv;
#pragma unroll
    for (int g = 0; g < 4; ++g) { const f32x4 a4 = *(const LAS f32x4*)(asc + 8 * g + 4 * hi);
#pragma unroll
        for (int db = 0; db < NDB; ++db)
#pragma unroll
            for (int i = 0; i < 4; ++i) o[db][4 * g + i] *= a4[i]; }
#undef AT_ISSUE
#undef AT_COMMIT
#undef AT_BAR
#undef SB
#undef P_CINIT
#undef P_KREAD
#undef P_QK
#undef P_VREAD
#undef P_PV
#undef P_MASKMAX
#undef P_EXP0
#undef P_EXP1SUM
#undef P_PACK
#undef P_RESC
#undef AT_OPAQUE
#undef TJ
}
template <int NDB> __device__ __forceinline__ void store_rows16(LAS unsigned char* lds, const f32x16 (&o)[NDB], const float (&scl)[16], bf16_t* dst  , int ld, int meta, int wid, int lane) {
    constexpr int PITCH = NDB * 64 + 16, CH = NDB * 4;
    static_assert(8 * 32 * PITCH <= AT_ASC, "output staging overlaps the softmax scratch");
    const int r32 = lane & 31, hi = lane >> 5;
    LAS unsigned char* st = lds + wid * (32 * PITCH);
#pragma unroll
    for (int r = 0; r < 16; ++r)
#pragma unroll
        for (int db = 0; db < NDB; ++db) *(LAS bf16_t*)(st + crow(r, hi) * PITCH + (db * 32 + r32) * 2) = (bf16_t)f2bf(o[db][r] * scl[r]);
#pragma unroll
    for (int k = 0; k < NDB * 2; ++k) { const int id = lane + 64 * k, row = id / CH, ch = id % CH;
        const u32x4 vv = *(const LAS u32x4*)(st + row * PITCH + ch * 16);
        if (!meta || 32 * wid + row < 16) *(u32x4*)(dst + (size_t)(32 * wid + row) * ld + ch * 8) = vv; }
}
__device__ __forceinline__ void attn_unit_mla(const Params& P, LAS unsigned char* lds, int b, int h, int qb, int meta, int g_wid) {
    const bf16_t* Q = (const bf16_t*)(KPAR->ws + WS_POOL + PO_Q); const bf16_t* KV = (const bf16_t*)(KPAR->ws + WS_POOL + PO_KV); const bf16_t* KR = (const bf16_t*)(KPAR->ws + WS_KR);
    bf16_t* AO = (bf16_t*)(KPAR->ws + WS_POOL + PO_AO);
    int tid_o = (g_wid << 6) | lane_id(); const int tid = tid_o, lane = tid & 63, wid = tid >> 6, r32 = lane & 31, hi = lane >> 5;
    const int row0 = meta ? MREAL : b * SEQ + 256 * qb, NT = meta ? 1 : 1 + 4 * (qb + 1);
    f32x16 o[2];
    attn_pass<96, 64, false>(lds, Q + (size_t)row0 * 768 + h * 96, 768, KV + h * 128, 1024, KR, 32, KV + h * 128 + 64, 1024, b * SEQ, NT, 256 * qb, meta, 0.f, 0.f, o, g_wid);
    float one[16];
#pragma unroll
    for (int r = 0; r < 16; ++r) one[r] = 1.0f;
    (void)r32; (void)hi;
    store_rows16<2>(lds, o, one, AO + (size_t)row0 * 512 + h * 64, 512, meta, wid, lane);
}
__device__ __forceinline__ void attn_unit_diff(const Params& P, LAS unsigned char* lds, int b, int h, int qb, int meta, int map, int l, float lam, float kmax, int g_wid) {
    const bf16_t* DQ = (const bf16_t*)(KPAR->ws + WS_POOL + PO_DQ); const bf16_t* DK = (const bf16_t*)(KPAR->ws + WS_POOL + PO_DK); const bf16_t* DVv = (const bf16_t*)(KPAR->ws + WS_POOL + PO_DV);
    const int row0 = meta ? MREAL : b * SEQ + 256 * qb, NT = meta ? 1 : 1 + 4 * (qb + 1);
    const float sl2 = LOG2E * (h == 0 ? 0.25f : (h == 1 ? 0.0625f : (h == 2 ? 0.015625f : 0.00390625f)));
    f32x16 o[4];
    attn_pass<64, 128, true>(lds, DQ + (size_t)row0 * 512 + h * 128 + 64 * map, 512, DK + h * 128 + 64 * map, 512, nullptr, 0, DVv + h * 128, 512, b * SEQ, NT, 256 * qb, meta, sl2, kmax, o, g_wid);
    const int unit = meta ? 256 + h : ((b * 4 + h) * 32 + qb);
    unsigned* cw = (unsigned*)(KPAR->ws + WS_CTL) + 8192 + l * 1024 + unit * 2;
    const int tid = (g_wid << 6) | lane_id(), lane = tid & 63, wid = tid >> 6, r32 = lane & 31, hi = lane >> 5;
    float* st4 = (float*)(KPAR->ws + WS_POOL + PO_S) + (meta ? (size_t)256 * 32768 + (size_t)h * 4096 : (size_t)unit * 32768) + (size_t)tid * 64;
    const bool parks = !meta || wid == 0;
    static_assert((size_t)256 * 131072 + 4 * 16384 <= R1K, "parking slots exceed the S region");
    if (tid == 0) *(LAS unsigned*)(lds + AT_QW + 64) = __hip_atomic_fetch_add(cw, 1u, __ATOMIC_RELAXED, __HIP_MEMORY_SCOPE_AGENT);
    __syncthreads();
    const unsigned first = *(LAS unsigned*)(lds + AT_QW + 64) == 0u;
    if (first) {
#pragma unroll
        for (int db = 0; db < 4; ++db)
#pragma unroll
            for (int g = 0; g < 4; ++g) if (parks) ((f32x4*)st4)[db * 4 + g] = (f32x4){o[db][4 * g], o[db][4 * g + 1], o[db][4 * g + 2], o[db][4 * g + 3]};
        asm volatile("s_waitcnt vmcnt(0)" ::: "memory");
        __syncthreads();
        if (tid == 0) { __builtin_amdgcn_fence(__ATOMIC_RELEASE, "agent"); asm volatile("s_waitcnt vmcnt(0)" ::: "memory");
                        __hip_atomic_store(cw + 1, 1u, __ATOMIC_RELAXED, __HIP_MEMORY_SCOPE_AGENT); }
        return;
    }
    if (tid == 0) { while (__hip_atomic_load(cw + 1, __ATOMIC_RELAXED, __HIP_MEMORY_SCOPE_AGENT) == 0u) __builtin_amdgcn_s_sleep(2);
                    __builtin_amdgcn_fence(__ATOMIC_ACQUIRE, "agent"); asm volatile("s_waitcnt vmcnt(0)" ::: "memory"); }
    __syncthreads();
    bf16_t* DN = (bf16_t*)(KPAR->ws + WS_POOL + PO_DN);
    const float ca = map == 0 ? 1.0f : -lam, cb = map == 0 ? -lam : 1.0f;
#pragma unroll
    for (int db = 0; db < 4; ++db)
#pragma unroll
        for (int g = 0; g < 4; ++g) { f32x4 s4 = (f32x4){0.f, 0.f, 0.f, 0.f}; if (parks) s4 = __builtin_nontemporal_load((const f32x4*)st4 + db * 4 + g);
#pragma unroll
            for (int i = 0; i < 4; ++i) o[db][4 * g + i] = map == 0 ? (o[db][4 * g + i] - lam * s4[i]) : (s4[i] - lam * o[db][4 * g + i]); }
    (void)ca; (void)cb;
    float rs[16];
#pragma unroll
    for (int r = 0; r < 16; ++r) {
        float ss = (o[0][r] * o[0][r] + o[1][r] * o[1][r]) + (o[2][r] * o[2][r] + o[3][r] * o[3][r]);
        ss += shx(ss, 1); ss += shx(ss, 2); ss += shx(ss, 4); ss += shx(ss, 8); ss += shx(ss, 16);
        rs[r] = rsqrtf(ss * (1.0f / 128.0f) + EPS);
    }
    (void)r32; (void)hi;
    store_rows16<4>(lds, o, rs, DN + (size_t)row0 * 512 + h * 128, 512, meta, wid, lane);
}
__device__ __forceinline__ void attn_phase(const Params& P, LAS unsigned char* lds, int lc, int g_wid) {
    const int l = lc & 1;
    int tid_o = (g_wid << 6) | lane_id(); const int tid = tid_o, lane = tid & 63;
    const float s1 = wave_sum(KPAR->in[9][l * 64 + lane] * KPAR->in[10][l * 64 + lane]), s2 = wave_sum(KPAR->in[11][l * 64 + lane] * KPAR->in[12][l * 64 + lane]);
    const float lam = expf(s1) - expf(s2) + (l == 0 ? 0.2f : 0.35550907f);
    const float kmax = sqrtf(2.0f * __uint_as_float(__hip_atomic_load((unsigned*)(KPAR->ws + WS_CTL) + 3000 + 64 * l, __ATOMIC_RELAXED, __HIP_MEMORY_SCOPE_AGENT))) * 1.01f;
    const int xcc = (int)((unsigned)__builtin_amdgcn_s_getreg((3 << 11) | 20) & 7u);
    for (int qi = 0; qi < 8; ++qi) {
        const int q = (xcc + qi) & 7;
        unsigned* ctr = (unsigned*)(KPAR->ws + WS_CTL) + 64 * (lc * 8 + q);
        for (;;) {
            if (tid == 0) *(LAS unsigned*)(lds + AT_QW) = atomicAdd(ctr, 1u);
            __syncthreads();
            const int u = (int)*(LAS unsigned*)(lds + AT_QW);
            __syncthreads();
            if (u >= (l == 0 ? 130 : 128)) break;
            if (u < 128) { const int qb = 31 - (u >> 2), j = u & 3;
                if (j < 2) attn_unit_diff(P, lds, q >> 2, (qb & 1) ? 3 - (q & 3) : (q & 3), qb, 0, j, l, lam, kmax, g_wid);     else { const int s = q + 8 * (j - 2); attn_unit_mla(P, lds, s >> 3, s & 7, qb, 0, g_wid); }
            } else { const int m = q + 8 * (u - 128);
                if (m < 8) attn_unit_diff(P, lds, 0, m >> 1, 0, 1, m & 1, l, lam, kmax, g_wid); else attn_unit_mla(P, lds, 0, m - 8, 0, 1, g_wid); }
        }
    }
}
#define XB_TMO      128
#define XB_XCNT(j)  (256  + 64 * (j))
#define XB_XSUB(j)  (1280 + 64 * (j))
#define XB_XGEN(j)  (2304 + 64 * (j))
#define XB_TOP      3328
#define XB_TOPGEN   3392
#define XCD_BAR_WORDS 3456
#define XB_SPIN_CAP (1u << 18)

__device__ __forceinline__ unsigned xb_ld(unsigned* p)              { return __hip_atomic_load(p, __ATOMIC_RELAXED, __HIP_MEMORY_SCOPE_AGENT); }
__device__ __forceinline__ unsigned xb_add(unsigned* p, unsigned v) { return __hip_atomic_fetch_add(p, v, __ATOMIC_RELAXED, __HIP_MEMORY_SCOPE_AGENT); }
__device__ __forceinline__ unsigned xb_xcc_id() { return (unsigned)__builtin_amdgcn_s_getreg((3 << 11) | 20) & 0xFu; }
#define XB_SPIN(cond, bar) do { unsigned _sp = 0; while (cond) { __builtin_amdgcn_s_sleep(1); \
    if ((++_sp & 255u) == 0u) { if (xb_ld(&(bar)[XB_TMO])) break; if (_sp > XB_SPIN_CAP) { atomicAdd(&(bar)[XB_TMO], 1u); break; } } } } while (0)

struct XcdBarrier {
    unsigned* bar; unsigned x;
    volatile LAS unsigned* st;
};

__device__ __forceinline__ XcdBarrier xcd_barrier_post(unsigned* bar, volatile LAS unsigned* st, bool leader) {
    XcdBarrier b; b.bar = bar; b.x = xb_xcc_id(); b.st = st;
    if (leader) (void)xb_add(&bar[XB_XCNT(b.x)], 1u);
    return b;
}
__device__ __forceinline__ void xcd_barrier_complete(unsigned* bar, unsigned x, unsigned& nloc, unsigned& nx) {
    const unsigned G = gridDim.x * gridDim.y * gridDim.z;
    unsigned sum, cnt, mine, sp = 0u;
    for (;;) {
        sum = 0u; cnt = 0u; mine = 0u;
#pragma unroll
        for (unsigned j = 0; j < 16; ++j) { const unsigned c = xb_ld(&bar[XB_XCNT(j)]); sum += c; cnt += (c > 0u) ? 1u : 0u; mine = (j == x) ? c : mine; }
        if (sum == G) break;
        __builtin_amdgcn_s_sleep(1);
        if ((++sp & 255u) == 0u) { if (xb_ld(&bar[XB_TMO])) break; if (sp > XB_SPIN_CAP) { atomicAdd(&bar[XB_TMO], 1u); break; } }
    }
    nloc = mine > 0u ? mine : 1u; nx = cnt > 0u ? cnt : 1u;
}

__device__ __forceinline__ void xcd_barrier(const XcdBarrier& b, int g_wid) {
    asm volatile("s_waitcnt vmcnt(0)" ::: "memory");
    __syncthreads();
    if (g_wid == 0 && lane_id() == 0) {
        unsigned* bar = b.bar;
        __builtin_amdgcn_s_waitcnt(0);
        unsigned nloc = b.st[0], nx = b.st[1];
        if (nloc == 0u) { xcd_barrier_complete(bar, b.x, nloc, nx); b.st[0] = nloc; b.st[1] = nx; }
        const unsigned old = xb_add(&bar[XB_XSUB(b.x)], 1u);
        const unsigned gen = old / nloc;
        if (old + 1u == (gen + 1u) * nloc) {
            __builtin_amdgcn_fence(__ATOMIC_RELEASE, "agent");
            asm volatile("s_waitcnt vmcnt(0)" ::: "memory");
            const unsigned og = xb_add(&bar[XB_TOP], 1u);
            const unsigned tg = og / nx;
            if (og + 1u == (tg + 1u) * nx) xb_add(&bar[XB_TOPGEN], 1u);
            else XB_SPIN(xb_ld(&bar[XB_TOPGEN]) == tg, bar);
            __builtin_amdgcn_fence(__ATOMIC_ACQUIRE, "agent");
            xb_add(&bar[XB_XGEN(b.x)], 1u);
            asm volatile("s_waitcnt vmcnt(0)" ::: "memory");
        } else {
            XB_SPIN(xb_ld(&bar[XB_XGEN(b.x)]) == gen, bar);
            __builtin_amdgcn_fence(__ATOMIC_ACQUIRE, "agent");
            asm volatile("s_waitcnt vmcnt(0)" ::: "memory");
        }
    }
    __syncthreads();
}

constexpr int LDS_BYTES = 131072 + 1024;
__global__ void __launch_bounds__(512, 2) fwd_megakernel(Params P) {
    extern __shared__ __attribute__((aligned(16))) unsigned char lds_raw[];
    LAS unsigned char* lds = (LAS unsigned char*)lds_raw;
    const int g_wid = __builtin_amdgcn_readfirstlane(threadIdx.x >> 6);
    volatile LAS unsigned* xb_st = (volatile LAS unsigned*)(lds + 131072 + 64);
    if (g_wid == 0 && lane_id() < 2) xb_st[lane_id()] = 0u;
    __syncthreads();
    const XcdBarrier xbar = xcd_barrier_post((unsigned*)(KPAR->ws + WS_CTL) + 4096, xb_st, g_wid == 0 && lane_id() == 0);
#define GRID_SYNC() xcd_barrier(xbar, g_wid)
#define WSP unsigned char* ws = KPAR->ws; asm volatile("" : "+s"(ws)); unsigned char* pool = ws + WS_POOL; (void)pool
#define PW ((bf16_t*)(ws + WS_W))
#define PXB ((bf16_t*)(ws + WS_XB))
#define PSSQ ((float*)(ws + WS_SSQ))
#define PSSQQ ((float*)(ws + WS_SSQQ))
#define PSSQKV ((float*)(ws + WS_SSQKV))
#define PXMETA ((float*)(ws + WS_XMETA))
#define PROPE ((const f32x2*)(ws + WS_ROPE))
#define PKR ((bf16_t*)(ws + WS_KR))
#define PP(off) ((bf16_t*)(pool + (off)))
#ifndef PHM
#define PHM 0xffff
#endif
#if PHM & 1
    prologue_x(P, g_wid); convert_weights(P, 0, lds, g_wid);
#if defined(PROBE_DUP) && (PROBE_DUP & 1)
    convert_weights(P, 0, lds, g_wid);
#endif
#endif
    if (KPAR->ws == nullptr) cg::this_grid().sync();
    GRID_SYNC();
    for (int l = 0; l < 2; ++l) {
#if PHM & 1
        if (l == 1) { convert_weights(P, 1, lds, g_wid); GRID_SYNC(); }
#endif
        const bool m_all = (l == 0);
#if PHM & 2
        {
            WSP; gemm_all<REWin>(lds, PXB, PW + WO_IN, 2048, 1024, REWin{PSSQ, (unsigned*)(ws + WS_CTL) + 3000 + 64 * l, PP(PO_QA), PP(PO_KVA), PKR, PP(PO_DQ), PP(PO_DK), PP(PO_DV), PSSQQ, PSSQKV, PROPE}, true, g_wid);
        }
        GRID_SYNC();
#if defined(PROBE_DUP) && (PROBE_DUP & 2)
        {
            WSP; gemm_all<REWin>(lds, PXB, PW + WO_IN, 2048, 1024, REWin{PSSQ, (unsigned*)(ws + WS_CTL) + 3000 + 64 * l, PP(PO_QA), PP(PO_KVA), PKR, PP(PO_DQ), PP(PO_DK), PP(PO_DV), PSSQQ, PSSQKV, PROPE}, true, g_wid);
        }
        GRID_SYNC();
#endif
#endif
#if PHM & 4
        {
            WSP; gemm_all<REQup>(lds, PP(PO_QA), PW + WO_Q, 768, 256, REQup{PSSQQ, PP(PO_Q), PROPE}, m_all, g_wid);
        }
        {   WSP; gemm_all<REKVup>(lds, PP(PO_KVA), PW + WO_KV, 1024, 128, REKVup{PSSQKV, PP(PO_KV)}, true, g_wid); }
        GRID_SYNC();
#if defined(PROBE_DUP) && (PROBE_DUP & 4)
        {
            WSP; gemm_all<REQup>(lds, PP(PO_QA), PW + WO_Q, 768, 256, REQup{PSSQQ, PP(PO_Q), PROPE}, m_all, g_wid);
        }
        {   WSP; gemm_all<REKVup>(lds, PP(PO_KVA), PW + WO_KV, 1024, 128, REKVup{PSSQKV, PP(PO_KV)}, true, g_wid); }
        GRID_SYNC();
#endif
#endif
#if PHM & 8
        attn_phase(P, lds, l, g_wid);
#ifdef PROBE_ATTN2
        GRID_SYNC(); attn_phase(P, lds, l + 2, g_wid);
#endif
        GRID_SYNC();
#endif
#if PHM & 16
        {   WSP; gemm_all<REStore>(lds, PP(PO_AO), PW + WO_A, 1024, 512, REStore{PP(PO_S)}, m_all, g_wid); }
        {   WSP; gemm_all<REGate>(lds, PXB, PW + WO_GA, 1024, 1024, REGate{PSSQ, KPAR->in[4] + (size_t)l * 2048, PP(PO_S), nullptr, 0}, m_all, g_wid); }
        {   WSP; gemm_all<REStore>(lds, PP(PO_DN), PW + WO_B, 1024, 512, REStore{PP(PO_YQ)}, m_all, g_wid); }
        {   WSP; gemm_all<REGate>(lds, PXB, PW + WO_GB, 1024, 1024, REGate{PSSQ, KPAR->in[4] + (size_t)l * 2048 + 1024, PP(PO_S), PP(PO_YQ), 1}, m_all, g_wid); }
        GRID_SYNC();
#if defined(PROBE_DUP) && (PROBE_DUP & 16)
        {   WSP; gemm_all<REStore>(lds, PP(PO_AO), PW + WO_A, 1024, 512, REStore{PP(PO_S)}, m_all, g_wid); }
        {   WSP; gemm_all<REGate>(lds, PXB, PW + WO_GA, 1024, 1024, REGate{PSSQ, KPAR->in[4] + (size_t)l * 2048, PP(PO_S), nullptr, 0}, m_all, g_wid); }
        {   WSP; gemm_all<REStore>(lds, PP(PO_DN), PW + WO_B, 1024, 512, REStore{PP(PO_YQ)}, m_all, g_wid); }
        {   WSP; gemm_all<REGate>(lds, PXB, PW + WO_GB, 1024, 1024, REGate{PSSQ, KPAR->in[4] + (size_t)l * 2048 + 1024, PP(PO_S), PP(PO_YQ), 1}, m_all, g_wid); }
        GRID_SYNC();
#endif
#endif
#if PHM & 32
        {
            WSP; float* out = KPAR->out; gemm_all<REResid>(lds, PP(PO_S), PW + WO_O, 1024, 1024, REResid{l == 0 ? KPAR->in[0] : out, l == 0 ? KPAR->in[1] : PXMETA, out, PXMETA, PXB, PSSQ}, m_all, g_wid);
        }
        GRID_SYNC();
#endif
#if PHM & 64
        {
            WSP; gemm_all<REUp>(lds, PXB, PW + WO_UP, 4096, 1024, REUp{PSSQ, PP(PO_H)}, m_all, g_wid);
        }
        GRID_SYNC();
#if defined(PROBE_DUP) && (PROBE_DUP & 64)
        {
            WSP; gemm_all<REUp>(lds, PXB, PW + WO_UP, 4096, 1024, REUp{PSSQ, PP(PO_H)}, m_all, g_wid);
        }
        GRID_SYNC();
#endif
#endif
#if PHM & 128
        {
            WSP; float* out = KPAR->out; gemm_all<REResid>(lds, PP(PO_H), PW + WO_DN, 1024, 4096, REResid{out, PXMETA, out, PXMETA, PXB, PSSQ}, m_all, g_wid);
        }
        GRID_SYNC();
#endif
    }
    { int tid_o = (g_wid << 6) | lane_id(); const int tid = tid_o, wid = tid >> 6, lane = tid & 63; const float* g = KPAR->in[20]; WSP; float* ssq = PSSQ; float* out = KPAR->out;
      for (int row = blockIdx.x * 8 + wid; row < MREAL; row += gridDim.x * 8) {
          const float rstd = rsqrtf(sum16p(ssq + (size_t)row * 16) * (1.0f / 1024.0f) + EPS);
          f32x4* o4 = (f32x4*)(out + (size_t)row * 1024);
#pragma unroll
          for (int j = 0; j < 4; ++j) o4[64 * j + lane] = o4[64 * j + lane] * rstd * ((const f32x4*)g)[64 * j + lane];
      } }
}

extern "C" void kernel_launch(void* const* d_in, const int* in_sizes, int n_in, void* d_out, int out_size, void* d_ws, size_t ws_size, hipStream_t stream) {
    static int grid = 0;
    if (grid == 0) {
        if (n_in != 21 || ws_size < WS_END) { fprintf(stderr, "kernel_launch: unexpected inputs (n_in %d, ws %zu < %zu)\n", n_in, ws_size, (size_t)WS_END); grid = -1; return; }
        int dev = 0, cus = 0, per_cu = 0;
        (void)hipGetDevice(&dev); (void)hipDeviceGetAttribute(&cus, hipDeviceAttributeMultiprocessorCount, dev);
        (void)hipFuncSetAttribute((const void*)fwd_megakernel, hipFuncAttributeMaxDynamicSharedMemorySize, LDS_BYTES);
        (void)hipOccupancyMaxActiveBlocksPerMultiprocessor(&per_cu, (const void*)fwd_megakernel, 512, LDS_BYTES);
        if (per_cu < 1) per_cu = 1;
        grid = cus * per_cu; if (grid > 256) grid = 256;
        (void)hipGetLastError();
    }
    if (grid < 0) return;
    (void)hipMemsetAsync((char*)d_ws + WS_CTL, 0, CTL_BYTES, stream);
    Params p{};
    for (int i = 0; i < 21; ++i) p.in[i] = (const float*)d_in[i];
    p.out = (float*)d_out; p.ws = (unsigned char*)d_ws;
    void* args[] = {&p};
    hipError_t e = hipLaunchCooperativeKernel((const void*)fwd_megakernel, dim3(grid), dim3(512), args, LDS_BYTES, stream);
    if (e != hipSuccess) fprintf(stderr, "cooperative launch failed: %s (grid %d)\n", hipGetErrorString(e), grid);
}
```

```cpp
#include <hip/hip_runtime.h>
#include <hip/hip_cooperative_groups.h>
#include <cstdio>
#include <cstdint>
namespace cg = cooperative_groups;
__device__ __forceinline__ int lane_id() { int l; asm volatile("v_mbcnt_lo_u32_b32 %0, -1, 0\n\tv_mbcnt_hi_u32_b32 %0, -1, %0" : "=v"(l)); return l; }

namespace pg8 {
#define PG8_LAS __attribute__((address_space(3)))
typedef unsigned short bf16_t;
typedef short bf16x8 __attribute__((ext_vector_type(8)));
typedef float f32x4 __attribute__((ext_vector_type(4)));
typedef unsigned u32x4 __attribute__((ext_vector_type(4)));
constexpr int BM = 256, BK = 64, HALF = 128, HTB = HALF * BK * 2  , STAGE_BYTES = 8 * HTB, NXCD = 8, WGM = 8;

__host__ __device__ __forceinline__ int lds_byte(int r, int c) { const int st = (r >> 4) * 2 + (c >> 5), rr = r & 15, cc = c & 31, ob = rr * 64 + cc * 2; return st * 1024 + (ob ^ (((ob >> 9) & 1) << 5)); }
__host__ __device__ __forceinline__ void stage_rc(int b, int& R, int& C) { const int st = b / 1024, sb = b % 1024, swz = sb ^ (((sb >> 9) & 1) << 5); R = (st >> 1) * 16 + swz / 64; C = (st & 1) * 32 + (swz % 64) / 2; }
__host__ __device__ __forceinline__ int perm32(int rho) { const int n = rho >> 4, i = rho & 15; return 8 * (i >> 2) + 4 * n + (i & 3); }

struct Unit { int pm, pn; };
struct Gemm { const bf16_t* A; const bf16_t* Bt; int M, N, K; };

struct StaticOrder {
    int nM, nN, nwg, G, c;
    __host__ __device__ void init(int M, int N, int G_, int c_) { nM = M / BM; nN = N / BM; nwg = nM * nN; G = G_; c = c_; }
    __host__ __device__ bool next(int i, Unit& u) const {
        const long L = (long)i * G + c; if (L >= nwg) return false;
        int wgid = (int)L; { const int q = nwg / NXCD, r = nwg % NXCD, xcd = wgid % NXCD, off = wgid / NXCD; wgid = (xcd < r ? xcd * (q + 1) : r * (q + 1) + (xcd - r) * q) + off; }
        const int nig = WGM * nN, gid = wgid / nig, fm = gid * WGM, gsz = (nM - fm) < WGM ? (nM - fm) : WGM;
        u.pm = fm + ((wgid % nig) % gsz); u.pn = (wgid % nig) / gsz; return true;
    }
    __device__ __forceinline__ void a_ready(const Unit&) const {}
    __device__ __forceinline__ void done(const Unit&) const {}
};

__device__ __forceinline__ unsigned cvt_pk_bf16(float lo, float hi) { unsigned r; asm volatile("v_cvt_pk_bf16_f32 %0, %1, %2" : "=v"(r) : "v"(lo), "v"(hi)); return r; }
template <class Epi, class Sched, bool ALIGN_EPI = false, bool SP2 = false>
__device__ __forceinline__ void gemm_phase(PG8_LAS unsigned char* lds, const Gemm g, const Sched& S, const Epi& E, int g_wid) {
    int tid_o = (g_wid << 6) | lane_id(); const int tid = tid_o, wid = __builtin_amdgcn_readfirstlane(tid >> 6), lane = tid & 63, wr = wid >> 2, wc = wid & 3, fr = lane & 15, fq = lane >> 4;
    const int K = g.K, nt = K / BK;
    unsigned voffA[2], voffB[2];
#pragma unroll
    for (int i = 0; i < 2; ++i) { int R, C; stage_rc(tid * 16 + i * 8192, R, C); const int Rb = Epi::PERM ? ((R & ~31) + perm32(R & 31)) : R;
        voffA[i] = (unsigned)(R * K + C) * 2u; voffB[i] = (unsigned)(Rb * K + C) * 2u; }
    const size_t kstep = (size_t)(BK * 2);
    const size_t hstep = (size_t)HALF * K * 2;
    const size_t tstep = 2 * hstep;
    const unsigned ldsw = (unsigned)wid * 1024u;
    const int aoff = lds_byte(wr * 64 + fr, fq * 8), boff = lds_byte(wc * 32 + fr, fq * 8);
#define PG8_SA(b, h) (((b) * 2 + (h)) * HTB)
#define PG8_SB(b, h) ((4 + (b) * 2 + (h)) * HTB)
#define PG8_STAGE(bufoff, gbase, voff) do { _Pragma("unroll") for (int _i = 0; _i < 2; ++_i) \
        __builtin_amdgcn_global_load_lds((const unsigned*)((const char*)(gbase) + (voff)[_i]), (PG8_LAS unsigned*)(lds + (bufoff) + ldsw + _i * 8192), 16, 0, 0); } while (0)
#define PG8_LDA(dst, b, h) do { _Pragma("unroll") for (int m = 0; m < 4; ++m) _Pragma("unroll") for (int k = 0; k < 2; ++k) dst[m][k] = *(const PG8_LAS bf16x8*)(lds + PG8_SA(b, h) + aoff + m * 2048 + k * 1024); } while (0)
#define PG8_LDB(dst, b, h) do { _Pragma("unroll") for (int n = 0; n < 2; ++n) _Pragma("unroll") for (int k = 0; k < 2; ++k) dst[n][k] = *(const PG8_LAS bf16x8*)(lds + PG8_SB(b, h) + boff + n * 2048 + k * 1024); } while (0)
#define PG8_MMA(ai, bj, At, Bt) do { __builtin_amdgcn_s_setprio(1); _Pragma("unroll") for (int m = 0; m < 4; ++m) _Pragma("unroll") for (int n = 0; n < 2; ++n) _Pragma("unroll") for (int k = 0; k < 2; ++k) \
        acc[ai][bj][m][n] = __builtin_amdgcn_mfma_f32_16x16x32_bf16(Bt[n][k], At[m][k], acc[ai][bj][m][n], 0, 0, 0); __builtin_amdgcn_s_setprio(0); } while (0)
#define PG8_WAIT_V(n) asm volatile("s_waitcnt vmcnt(" #n ")" ::: "memory")
#define PG8_WAIT_L(n) asm volatile("s_waitcnt lgkmcnt(" #n ")" ::: "memory")
#define PG8_BAR __builtin_amdgcn_s_barrier()
#define PG8_SCHED __builtin_amdgcn_sched_barrier(0)
    Unit cur, nxt; int ui = 0;
    if (!S.next(0, cur)) return;
    f32x4 acc[2][2][4][2];
#pragma unroll
    for (int a = 0; a < 2; ++a)
#pragma unroll
        for (int b = 0; b < 2; ++b)
#pragma unroll
            for (int m = 0; m < 4; ++m)
#pragma unroll
                for (int n = 0; n < 2; ++n) acc[a][b][m][n] = (f32x4){0.f, 0.f, 0.f, 0.f};
    bf16x8 At[4][2], B0[2][2], B1[2][2];
    const char* cA = (const char*)g.A + (size_t)cur.pm * tstep; const char* cB = (const char*)g.Bt + (size_t)cur.pn * tstep;
    S.a_ready(cur);
    if constexpr (SP2) {
        PG8_STAGE(PG8_SB(0, 0), cB, voffB); PG8_STAGE(PG8_SB(0, 1), cB + hstep, voffB); PG8_STAGE(PG8_SA(0, 0), cA, voffA); PG8_STAGE(PG8_SA(0, 1), cA + hstep, voffA);
        if (wr == 1) PG8_BAR;
        PG8_WAIT_V(2); PG8_BAR;
        PG8_STAGE(PG8_SB(1, 0), cB + kstep, voffB); PG8_STAGE(PG8_SA(1, 0), cA + kstep, voffA); PG8_STAGE(PG8_SB(1, 1), cB + hstep + kstep, voffB);
        PG8_WAIT_V(6); PG8_BAR;
    } else {
        PG8_STAGE(PG8_SB(0, 0), cB, voffB); PG8_STAGE(PG8_SA(0, 0), cA, voffA); PG8_STAGE(PG8_SB(0, 1), cB + hstep, voffB); PG8_STAGE(PG8_SA(0, 1), cA + hstep, voffA);
        if (wr == 1) PG8_BAR;
        PG8_WAIT_V(4); PG8_BAR;
        PG8_STAGE(PG8_SB(1, 0), cB + kstep, voffB); PG8_STAGE(PG8_SA(1, 0), cA + kstep, voffA); PG8_STAGE(PG8_SB(1, 1), cB + hstep + kstep, voffB);
        PG8_WAIT_V(6); PG8_BAR;
    }
    for (;;) {
        const bool has_next = S.next(ui + 1, nxt);
        const char* nA = has_next ? (const char*)g.A + (size_t)nxt.pm * tstep : cA; const char* nB = has_next ? (const char*)g.Bt + (size_t)nxt.pn * tstep : cB;
        for (int t = 0; t < nt; t += 2) {
            const bool last = (t == nt - 2);
            const char* a1 = cA + (size_t)(t + 1) * kstep;
            const char* a2 = last ? nA : cA + (size_t)(t + 2) * kstep; const char* b2 = last ? nB : cB + (size_t)(t + 2) * kstep;
            const char* a3 = a2 + kstep; const char* b3 = b2 + kstep;
            if (last && has_next) S.a_ready(nxt);
            if constexpr (SP2) {
            PG8_LDB(B0, 0, 0); PG8_LDB(B1, 0, 1); PG8_SCHED; PG8_LDA(At, 0, 0); PG8_STAGE(PG8_SA(1, 1), a1 + hstep, voffA);
            PG8_WAIT_V(8); PG8_WAIT_L(0); PG8_BAR; PG8_MMA(0, 0, At, B0); PG8_MMA(0, 1, At, B1); PG8_BAR; PG8_SCHED;
            PG8_LDA(At, 0, 1); PG8_STAGE(PG8_SB(0, 0), b2, voffB); PG8_STAGE(PG8_SB(0, 1), b2 + hstep, voffB); PG8_STAGE(PG8_SA(0, 0), a2, voffA);
            PG8_WAIT_V(8); PG8_WAIT_L(0); PG8_BAR; PG8_MMA(1, 0, At, B0); PG8_MMA(1, 1, At, B1); PG8_BAR; PG8_SCHED;
            PG8_LDB(B0, 1, 0); PG8_LDB(B1, 1, 1); PG8_SCHED; PG8_LDA(At, 1, 0); PG8_STAGE(PG8_SA(0, 1), a2 + hstep, voffA);
            PG8_WAIT_V(8); PG8_WAIT_L(0); PG8_BAR; PG8_MMA(0, 0, At, B0); PG8_MMA(0, 1, At, B1); PG8_BAR; PG8_SCHED;
            PG8_LDA(At, 1, 1); PG8_STAGE(PG8_SB(1, 0), b3, voffB); PG8_STAGE(PG8_SB(1, 1), b3 + hstep, voffB); PG8_STAGE(PG8_SA(1, 0), a3, voffA);
            PG8_WAIT_V(8); PG8_WAIT_L(0); PG8_BAR; PG8_MMA(1, 0, At, B0); PG8_MMA(1, 1, At, B1); PG8_BAR; PG8_SCHED;
            } else {
            PG8_LDB(B0, 0, 0); PG8_SCHED; PG8_LDA(At, 0, 0); PG8_STAGE(PG8_SA(1, 1), a1 + hstep, voffA);
            PG8_WAIT_L(8); PG8_BAR; PG8_WAIT_L(0); PG8_MMA(0, 0, At, B0); PG8_BAR; PG8_SCHED;
            PG8_LDB(B1, 0, 1); PG8_STAGE(PG8_SB(0, 0), b2, voffB);
            PG8_BAR; PG8_WAIT_L(0); PG8_MMA(0, 1, At, B1); PG8_BAR;
            PG8_LDA(At, 0, 1); PG8_STAGE(PG8_SA(0, 0), a2, voffA);
            PG8_BAR; PG8_WAIT_L(0); PG8_MMA(1, 0, At, B0); PG8_BAR; PG8_SCHED;
            PG8_STAGE(PG8_SB(0, 1), b2 + hstep, voffB);
            PG8_WAIT_V(6); PG8_BAR; PG8_MMA(1, 1, At, B1); PG8_BAR;
            PG8_LDB(B0, 1, 0); PG8_SCHED; PG8_LDA(At, 1, 0); PG8_STAGE(PG8_SA(0, 1), a2 + hstep, voffA);
            PG8_WAIT_L(8); PG8_BAR; PG8_WAIT_L(0); PG8_MMA(0, 0, At, B0); PG8_BAR; PG8_SCHED;
            PG8_LDB(B1, 1, 1); PG8_STAGE(PG8_SB(1, 0), b3, voffB);
            PG8_BAR; PG8_WAIT_L(0); PG8_MMA(0, 1, At, B1); PG8_BAR;
            PG8_LDA(At, 1, 1); PG8_STAGE(PG8_SA(1, 0), a3, voffA);
            PG8_BAR; PG8_WAIT_L(0); PG8_MMA(1, 0, At, B0); PG8_BAR; PG8_SCHED;
            PG8_STAGE(PG8_SB(1, 1), b3 + hstep, voffB);
            PG8_WAIT_V(6); PG8_BAR; PG8_MMA(1, 1, At, B1); PG8_BAR;
            }
        }
        if constexpr (ALIGN_EPI) { if (wr == 0) PG8_BAR; }
        if constexpr (!Epi::AFTER_DRAIN) { const int le_ = lane_id(); E(acc, cur, wr, wc, le_ & 15, le_ >> 4); S.done(cur); }
        if (!has_next) break;
#pragma unroll
        for (int a = 0; a < 2; ++a)
#pragma unroll
            for (int b = 0; b < 2; ++b)
#pragma unroll
                for (int m = 0; m < 4; ++m)
#pragma unroll
                    for (int n = 0; n < 2; ++n) acc[a][b][m][n] = (f32x4){0.f, 0.f, 0.f, 0.f};
        cur = nxt; cA = nA; cB = nB; ++ui;
        if constexpr (ALIGN_EPI) { if (wr == 1) PG8_BAR; }
    }
    PG8_WAIT_V(0);
    if constexpr (!ALIGN_EPI) { if (wr == 0) PG8_BAR; }
    PG8_BAR;
    if constexpr (Epi::AFTER_DRAIN) { E.fused(acc, cur, wr, wc, fr, fq, lds, wid, lane); S.done(cur); }
#undef PG8_SA
#undef PG8_SB
#undef PG8_STAGE
#undef PG8_LDA
#undef PG8_LDB
#undef PG8_MMA
#undef PG8_WAIT_V
#undef PG8_WAIT_L
#undef PG8_BAR
#undef PG8_SCHED
}
}
using pg8::bf16_t; using pg8::bf16x8; using pg8::f32x4; using pg8::u32x4;
#define LAS __attribute__((address_space(3)))
typedef float f32x16 __attribute__((ext_vector_type(16)));
typedef float f32x2 __attribute__((ext_vector_type(2)));
typedef unsigned u32x2 __attribute__((ext_vector_type(2)));
typedef short v4i16_t __attribute__((ext_vector_type(4)));

constexpr int SEQ = 8192, MREAL = 16384, MALLOC = 16448, DM = 1024, NTHR = 512;
constexpr float EPS = 1e-6f, LOG2E = 1.4426950408889634f;
constexpr size_t R1K = (size_t)MALLOC * 1024 * 2;
constexpr size_t al64k(size_t x) { return (x + 65535) & ~(size_t)65535; }
constexpr size_t WS_CTL = 0, CTL_BYTES = 65536;
constexpr size_t WS_ROPE = CTL_BYTES;
constexpr size_t WS_SSQ = al64k(WS_ROPE + (size_t)8208 * 16 * 8);
constexpr size_t WS_SSQQ = al64k(WS_SSQ + (size_t)MALLOC * 16 * 4);
constexpr size_t WS_SSQKV = al64k(WS_SSQQ + (size_t)MALLOC * 4 * 4);
constexpr size_t WS_XMETA = al64k(WS_SSQKV + (size_t)MALLOC * 4 * 4);
constexpr size_t WS_KR = al64k(WS_XMETA + 65536);
constexpr size_t WS_W = al64k(WS_KR + (size_t)MALLOC * 32 * 2);
constexpr size_t WO_IN = 0, WO_GA = 2097152, WO_GB = 3145728, WO_Q = 4194304, WO_KV = 4390912, WO_A = 4521984, WO_B = 5046272, WO_O = 5570560, WO_UP = 6619136, WO_DN = 10813440, W_ELEMS = 15007744;
constexpr size_t WS_XB = al64k(WS_W + W_ELEMS * 2);
constexpr size_t WS_POOL = al64k(WS_XB + R1K);
constexpr size_t PO_S = 0;
constexpr size_t PO_QA = PO_S, PO_KVA = PO_S + (size_t)MALLOC * 256 * 2;
constexpr size_t PO_AO = R1K, PO_DN = R1K + R1K / 2;
constexpr size_t PO_DQ = 2 * R1K, PO_DK = 2 * R1K + R1K / 2, PO_DV = 3 * R1K, PO_Q = 3 * R1K + R1K / 2, PO_KV = 4 * R1K + R1K / 4;
constexpr size_t PO_YQ = 2 * R1K;
constexpr size_t PO_H = 0;
constexpr size_t WS_END = WS_POOL + 5 * R1K + R1K / 4;
static_assert(WS_END <= (size_t)256 * 1024 * 1024, "workspace map exceeds 256 MiB");

struct Params {
    const float* in[21]; float* out; unsigned char* ws;
};

typedef const Params __attribute__((address_space(4)))* kparams_t;
__device__ __forceinline__ kparams_t kparams() { kparams_t p = (kparams_t)__builtin_amdgcn_kernarg_segment_ptr(); asm volatile("" : "+s"(p)); return p; }
#define KPAR kparams()
__device__ __forceinline__ unsigned cvt_pk(float lo, float hi) { return pg8::cvt_pk_bf16(lo, hi); }
__device__ __forceinline__ u32x2 pk4(f32x4 v) { u32x2 r; r.x = cvt_pk(v[0], v[1]); r.y = cvt_pk(v[2], v[3]); return r; }
__device__ __forceinline__ float bf2f(unsigned short b) { return __uint_as_float((unsigned)b << 16); }
__device__ __forceinline__ f32x4 ld_bf4(const bf16_t* p) { const u32x2 w = *(const u32x2*)p; return (f32x4){__uint_as_float(w.x << 16), __uint_as_float(w.x & 0xffff0000u), __uint_as_float(w.y << 16), __uint_as_float(w.y & 0xffff0000u)}; }
__device__ __forceinline__ u32x4 pk8(f32x4 a, f32x4 b) { const u32x2 x = pk4(a), y = pk4(b); return (u32x4){x.x, x.y, y.x, y.y}; }
__device__ __forceinline__ void ld_bf8(const bf16_t* p, f32x4& a, f32x4& b) { const u32x4 w = *(const u32x4*)p;
    a = (f32x4){__uint_as_float(w.x << 16), __uint_as_float(w.x & 0xffff0000u), __uint_as_float(w.y << 16), __uint_as_float(w.y & 0xffff0000u)};
    b = (f32x4){__uint_as_float(w.z << 16), __uint_as_float(w.z & 0xffff0000u), __uint_as_float(w.w << 16), __uint_as_float(w.w & 0xffff0000u)}; }
__device__ __forceinline__ float sum4v(f32x4 a) { return (a[0] + a[1]) + (a[2] + a[3]); }
__device__ __forceinline__ float sumsq4(f32x4 a) { return (a[0] * a[0] + a[1] * a[1]) + (a[2] * a[2] + a[3] * a[3]); }
__device__ __forceinline__ float sum16p(const float* p) { const f32x4* q = (const f32x4*)p; return (sum4v(q[0]) + sum4v(q[1])) + (sum4v(q[2]) + sum4v(q[3])); }
__device__ __forceinline__ float sum4p(const float* p) { return sum4v(*(const f32x4*)p); }
__device__ __forceinline__ float shx(float v, int mask) { const int l = lane_id(); return __int_as_float(__builtin_amdgcn_ds_bpermute((l ^ mask) << 2, __float_as_int(v))); }
__device__ __forceinline__ float half_max(float v) { const auto rr = __builtin_amdgcn_permlane32_swap(__float_as_uint(v), __float_as_uint(v), false, false); return fmaxf(__uint_as_float(rr[0]), __uint_as_float(rr[1])); }
__device__ __forceinline__ float half_sum(float v) { const auto rr = __builtin_amdgcn_permlane32_swap(__float_as_uint(v), __float_as_uint(v), false, false); return __uint_as_float(rr[0]) + __uint_as_float(rr[1]); }
__device__ __forceinline__ float wave_sum(float v) {
#pragma unroll
    for (int o = 1; o < 64; o <<= 1) v += shx(v, o);
    return v;
}
__device__ __forceinline__ float fq_sum(float s) { s += shx(s, 16); s += shx(s, 32); return s; }
__device__ __forceinline__ int tok_pos(int row) { return row < MREAL ? 16 + (row & (SEQ - 1)) : row - MREAL; }
__device__ __forceinline__ float sigmoidf_(float z) { return __builtin_amdgcn_rcpf(1.0f + __builtin_amdgcn_exp2f(-LOG2E * z)); }

struct REWin {
    static constexpr bool PERM = false; static constexpr int NP = 16, FENCE = 0, KMAX = 1; const float* ssq; unsigned* kmax_word; __device__ __forceinline__ const float* nsrc() const { return ssq; } bf16_t *QA, *KVA, *KR, *DQ, *DK, *DVv; float *ssqq, *ssqkv; const f32x2* rope;
    __device__ __forceinline__ void row(int row, int pn, int wc, int fq, f32x4 (&v)[2][2], float rstd) const {
#pragma unroll
        for (int bj = 0; bj < 2; ++bj)
#pragma unroll
            for (int n = 0; n < 2; ++n) v[bj][n] = v[bj][n] * rstd;
        const int cw = 32 * wc + 4 * fq;
        if (pn == 0) {
            float s = 0.f;
#pragma unroll
            for (int bj = 0; bj < 2; ++bj)
#pragma unroll
                for (int n = 0; n < 2; ++n) { *(u32x2*)(QA + (size_t)row * 256 + 128 * bj + cw + 16 * n) = pk4(v[bj][n]); s += sumsq4(v[bj][n]); }
            s = fq_sum(s); if (fq == 0) ssqq[(size_t)row * 4 + wc] = s;
        } else if (pn == 1) {
            float s = 0.f;
#pragma unroll
            for (int n = 0; n < 2; ++n) { *(u32x2*)(KVA + (size_t)row * 128 + cw + 16 * n) = pk4(v[0][n]); s += sumsq4(v[0][n]); }
            s = fq_sum(s); if (fq == 0) ssqkv[(size_t)row * 4 + wc] = s;
            if (wc == 0) {
                const f32x2* t = rope + (size_t)tok_pos(row) * 16 + 4 * fq; f32x4 a, b;
#pragma unroll
                for (int i = 0; i < 4; ++i) { const f32x2 cs = t[i]; a[i] = v[1][0][i] * cs.x - v[1][1][i] * cs.y; b[i] = v[1][0][i] * cs.y + v[1][1][i] * cs.x; }
                *(u32x2*)(KR + (size_t)row * 32 + 4 * fq) = pk4(a); *(u32x2*)(KR + (size_t)row * 32 + 16 + 4 * fq) = pk4(b);
            }
        } else {
            bf16_t* dst = DQ + (size_t)((pn - 2) >> 1) * ((size_t)MALLOC * 512); const float sc = pn < 4 ? 0.125f * LOG2E : 1.0f; const int c0 = (pn & 1) * 256;
#pragma unroll
            for (int bj = 0; bj < 2; ++bj)
#pragma unroll
                for (int n = 0; n < 2; ++n) *(u32x2*)(dst + (size_t)row * 512 + c0 + 128 * bj + cw + 16 * n) = pk4(v[bj][n] * sc);
        }
    }
};
struct REQup {
    static constexpr bool PERM = false; static constexpr int NP = 4, FENCE = 0, KMAX = 0; const float* ssqq; bf16_t* Q; const f32x2* rope; __device__ __forceinline__ const float* nsrc() const { return ssqq; }
    __device__ __forceinline__ void row(int row, int pn, int wc, int fq, f32x4 (&v)[2][2], float rstd) const {
        const float sc = rstd * (0.10206207261596577f * LOG2E);
#pragma unroll
        for (int bj = 0; bj < 2; ++bj) {
            const int g32 = 256 * pn + 128 * bj + 32 * wc; f32x4 a = v[bj][0] * sc, b = v[bj][1] * sc;
            if ((g32 % 96) == 64) {
                const f32x2* t = rope + (size_t)tok_pos(row) * 16 + 4 * fq; f32x4 a2, b2;
#pragma unroll
                for (int i = 0; i < 4; ++i) { const f32x2 cs = t[i]; a2[i] = a[i] * cs.x - b[i] * cs.y; b2[i] = a[i] * cs.y + b[i] * cs.x; }
                a = a2; b = b2;
            }
            *(u32x2*)(Q + (size_t)row * 768 + g32 + 4 * fq) = pk4(a); *(u32x2*)(Q + (size_t)row * 768 + g32 + 16 + 4 * fq) = pk4(b);
        }
    }
};
struct REKVup {
    static constexpr bool PERM = true; static constexpr int NP = 4, FENCE = 0, KMAX = 0; const float* ssqkv; bf16_t* KV; __device__ __forceinline__ const float* nsrc() const { return ssqkv; }
    __device__ __forceinline__ void row(int row, int pn, int wc, int fq, f32x4 (&v)[2][2], float rstd) const {
        const float sc = rstd;
#pragma unroll
        for (int bj = 0; bj < 2; ++bj) *(u32x4*)(KV + (size_t)row * 1024 + 256 * pn + 128 * bj + 32 * wc + 8 * fq) = pk8(v[bj][0] * sc, v[bj][1] * sc);
    }
};
struct REStore {
    static constexpr bool PERM = true; static constexpr int NP = 0, FENCE = 0, KMAX = 0; bf16_t* O; __device__ __forceinline__ const float* nsrc() const { return nullptr; }
    __device__ __forceinline__ void row(int row, int pn, int wc, int fq, f32x4 (&v)[2][2], float rstd) const {
#pragma unroll
        for (int bj = 0; bj < 2; ++bj) *(u32x4*)(O + (size_t)row * 1024 + 256 * pn + 128 * bj + 32 * wc + 8 * fq) = pk8(v[bj][0], v[bj][1]);
    }
};
struct REGate {
    static constexpr bool PERM = true; static constexpr int NP = 16, FENCE = 1, KMAX = 0; const float* ssq; const float* bias; bf16_t* Y; const bf16_t* T; int add; __device__ __forceinline__ const float* nsrc() const { return ssq; }
    __device__ __forceinline__ void row(int row, int pn, int wc, int fq, f32x4 (&v)[2][2], float rstd) const {
#pragma unroll
        for (int bj = 0; bj < 2; ++bj) {
            const int col = 256 * pn + 128 * bj + 32 * wc + 8 * fq; const f32x4 b0 = *(const f32x4*)(bias + col), b1 = *(const f32x4*)(bias + col + 4);
            f32x4 g0, g1;
#pragma unroll
            for (int i = 0; i < 4; ++i) { g0[i] = sigmoidf_(v[bj][0][i] * rstd + b0[i]); g1[i] = sigmoidf_(v[bj][1][i] * rstd + b1[i]); }
            bf16_t* yp = Y + (size_t)row * 1024 + col; f32x4 y0, y1; ld_bf8(yp, y0, y1);
            f32x4 r0, r1; if (add) { f32x4 t0, t1; ld_bf8(T + (size_t)row * 1024 + col, t0, t1); r0 = y0 + g0 * t0; r1 = y1 + g1 * t1; } else { r0 = g0 * y0; r1 = g1 * y1; }
            *(u32x4*)yp = pk8(r0, r1);
        }
    }
};
struct REResid {
    static constexpr bool PERM = true; static constexpr int NP = 0, FENCE = 1, KMAX = 0; const float* base_main; const float* base_meta; float* out_main; float* out_meta; bf16_t* XB; float* ssq; __device__ __forceinline__ const float* nsrc() const { return nullptr; }
    __device__ __forceinline__ void row(int row, int pn, int wc, int fq, f32x4 (&v)[2][2], float rstd) const {
        const float* bp = row < MREAL ? base_main + (size_t)row * 1024 : base_meta + (size_t)(row - MREAL) * 1024;
        float* op = row < MREAL ? out_main + (size_t)row * 1024 : out_meta + (size_t)(row - MREAL) * 1024;
        float s = 0.f;
#pragma unroll
        for (int bj = 0; bj < 2; ++bj) {
            const int col = 256 * pn + 128 * bj + 32 * wc + 8 * fq;
            const f32x4 x0 = *(const f32x4*)(bp + col) + v[bj][0], x1 = *(const f32x4*)(bp + col + 4) + v[bj][1];
            *(f32x4*)(op + col) = x0; *(f32x4*)(op + col + 4) = x1; if (XB) *(u32x4*)(XB + (size_t)row * 1024 + col) = pk8(x0, x1); s += sumsq4(x0) + sumsq4(x1);
        }
        s = fq_sum(s); if (fq == 0) ssq[(size_t)row * 16 + pn * 4 + wc] = s;
    }
};
struct REUp {
    static constexpr bool PERM = true; static constexpr int NP = 16, FENCE = 0, KMAX = 0; const float* ssq; bf16_t* H; __device__ __forceinline__ const float* nsrc() const { return ssq; }
    __device__ __forceinline__ void row(int row, int pn, int wc, int fq, f32x4 (&v)[2][2], float rstd) const {
#pragma unroll
        for (int bj = 0; bj < 2; ++bj) { f32x4 t0 = v[bj][0] * rstd, t1 = v[bj][1] * rstd;
#pragma unroll
            for (int i = 0; i < 4; ++i) { const float r0 = fmaxf(t0[i], 0.f), r1 = fmaxf(t1[i], 0.f); t0[i] = r0 * r0; t1[i] = r1 * r1; }
            *(u32x4*)(H + (size_t)row * 4096 + 256 * pn + 128 * bj + 32 * wc + 8 * fq) = pk8(t0, t1); }
    }
};
template <int NP> __device__ __forceinline__ float row_part(const float* p, int row, int fq) {
    if (NP == 16) return sum4v(*(const f32x4*)(p + (size_t)row * 16 + 4 * fq));
    if (NP == 4) return p[(size_t)row * 4 + fq];
    return 0.f;
}
template <int NP> __device__ __forceinline__ float row_rstd(float part) {
    if (NP == 0) return 1.0f;
    const float tot = fq_sum(part);
    return rsqrtf(tot * (NP == 16 ? (1.0f / 1024.0f) : 1.0f) + EPS);
}
template <class RE> struct EpiRows {
    static constexpr bool PERM = RE::PERM, AFTER_DRAIN = false; RE e; float inv_n;
    __device__ __forceinline__ void operator()(const f32x4 (&acc)[2][2][4][2], const pg8::Unit& u, int wr, int wc, int fr, int fq) const {
        float rs[2][4];
        if (RE::NP != 0) {
            const float* ns = e.nsrc(); float part[2][4];
#pragma unroll
            for (int ai = 0; ai < 2; ++ai)
#pragma unroll
                for (int m = 0; m < 4; ++m) part[ai][m] = row_part<RE::NP>(ns, u.pm * 256 + ai * 128 + wr * 64 + m * 16 + fr, fq);
#pragma unroll
            for (int ai = 0; ai < 2; ++ai)
#pragma unroll
                for (int m = 0; m < 4; ++m) rs[ai][m] = rsqrtf(fq_sum(part[ai][m]) * inv_n + EPS);
        }
#pragma unroll
        for (int ai = 0; ai < 2; ++ai)
#pragma unroll
            for (int m = 0; m < 4; ++m) { f32x4 v[2][2] = {{acc[ai][0][m][0], acc[ai][0][m][1]}, {acc[ai][1][m][0], acc[ai][1][m][1]}};
                e.row(u.pm * 256 + ai * 128 + wr * 64 + m * 16 + fr, u.pn, wc, fq, v, RE::NP != 0 ? rs[ai][m] : 1.0f);
                if (RE::FENCE && (m & 1)) asm volatile("" ::: "memory"); }
        if constexpr (RE::KMAX != 0) { if (u.pn == 4 || u.pn == 5) {
            float kmx = 0.f;
#pragma unroll
            for (int ai = 0; ai < 2; ++ai)
#pragma unroll
                for (int m = 0; m < 4; ++m)
#pragma unroll
                    for (int bj = 0; bj < 2; ++bj) kmx = fmaxf(kmx, fq_sum(sumsq4(acc[ai][bj][m][0]) + sumsq4(acc[ai][bj][m][1])) * rs[ai][m] * rs[ai][m]);
#pragma unroll
            for (int o = 1; o < 16; o <<= 1) kmx = fmaxf(kmx, shx(kmx, o));
            if (lane_id() == 0) atomicMax(e.kmax_word, __float_as_uint(kmx)); } }
    }
};
template <class RE> __device__ __forceinline__ void meta_gemm(LAS unsigned char* lds, const bf16_t* A, const bf16_t* Bt, int N, int K, const RE& e, float inv_n, int g_wid) {
    int tid_o = (g_wid << 6) | lane_id(); const int tid = tid_o, wid = tid >> 6, lane = tid & 63, fr = lane & 15, fq = lane >> 4;
    const bf16_t* A16 = A + (size_t)MREAL * K;
    for (int u = blockIdx.x; u < N / 64; u += gridDim.x) {
        const int pn = u >> 2, wc = u & 3;
        f32x4 acc[2][2];
#pragma unroll
        for (int bj = 0; bj < 2; ++bj)
#pragma unroll
            for (int n = 0; n < 2; ++n) acc[bj][n] = (f32x4){0.f, 0.f, 0.f, 0.f};
        const int nst = K >= 256 ? K / 256 : 1, nwv = K >= 256 ? 8 : K / 32;
#pragma unroll 4
        for (int s = 0; s < (wid < nwv ? nst : 0); ++s) {
            const int k0 = (wid * nst + s) * 32 + 8 * fq;
            const bf16x8 a = *(const bf16x8*)(A16 + (size_t)fr * K + k0);
#pragma unroll
            for (int bj = 0; bj < 2; ++bj)
#pragma unroll
                for (int n = 0; n < 2; ++n) { const bf16x8 b = *(const bf16x8*)(Bt + (size_t)(256 * pn + 128 * bj + 32 * wc + (RE::PERM ? 8 * (fr >> 2) + 4 * n + (fr & 3) : 16 * n + fr)) * K + k0);
                    acc[bj][n] = __builtin_amdgcn_mfma_f32_16x16x32_bf16(b, a, acc[bj][n], 0, 0, 0); }
        }
        LAS f32x4* red = (LAS f32x4*)lds;
#pragma unroll
        for (int bj = 0; bj < 2; ++bj)
#pragma unroll
            for (int n = 0; n < 2; ++n) red[(wid * 4 + bj * 2 + n) * 64 + lane] = acc[bj][n];
        __syncthreads();
        if (wid == 0) {
            f32x4 v[2][2];
#pragma unroll
            for (int bj = 0; bj < 2; ++bj)
#pragma unroll
                for (int n = 0; n < 2; ++n) { f32x4 s = red[(bj * 2 + n) * 64 + lane];
#pragma unroll
                    for (int w = 1; w < 8; ++w) s = s + red[(w * 4 + bj * 2 + n) * 64 + lane];
                    v[bj][n] = s; }
            float rstd = 1.0f;
            if (RE::NP != 0) rstd = rsqrtf(fq_sum(row_part<RE::NP>(e.nsrc(), MREAL + fr, fq)) * inv_n + EPS);
            e.row(MREAL + fr, pn, wc, fq, v, rstd);
            if constexpr (RE::KMAX != 0) { if (pn == 4 || pn == 5) { float kmx = 0.f;
#pragma unroll
                for (int bj = 0; bj < 2; ++bj) kmx = fmaxf(kmx, fq_sum(sumsq4(v[bj][0]) + sumsq4(v[bj][1])));
#pragma unroll
                for (int o = 1; o < 16; o <<= 1) kmx = fmaxf(kmx, shx(kmx, o));
                if (lane == 0) atomicMax(e.kmax_word, __float_as_uint(kmx)); } }
        }
        __syncthreads();
    }
}
template <class RE> __device__ __forceinline__ void gemm_all(LAS unsigned char* lds, const bf16_t* A, const bf16_t* Bt, int N, int K, const RE& e, bool do_meta, int g_wid) {
    asm volatile("" : "+s"(A), "+s"(Bt));
    if (do_meta) meta_gemm<RE>(lds, A, Bt, N, K, e, 1.0f / (float)K, g_wid);
    pg8::Gemm g{A, Bt, MREAL, N, K}; pg8::StaticOrder S; S.init(MREAL, N, (int)gridDim.x, (int)blockIdx.x);
    EpiRows<RE> E{e, 1.0f / (float)K};
    pg8::gemm_phase<EpiRows<RE>, pg8::StaticOrder, true, true>(lds, g, S, E, g_wid);
}

__device__ __forceinline__ unsigned f2bf(float f) { unsigned u = __float_as_uint(f); return (u + 0x7fffu + ((u >> 16) & 1u)) >> 16; }
__device__ __forceinline__ unsigned pk2(float lo, float hi) { return f2bf(lo) | (f2bf(hi) << 16); }
__device__ __forceinline__ void transpose_item(const float* W, int ldw, int K, int col0, int ncolblk, bf16_t* WT, int row0, const float* gain, int gmask, float gscale, LAS float* scr, int item, int lane) {
    const int kb = item / ncolblk, nb = item % ncolblk, k0 = 64 * kb, n0 = 32 * nb;
#pragma unroll
    for (int i = 0; i < 8; ++i) { const int kk = 8 * i + (lane >> 3), c4 = (lane & 7) * 4; const float g = gain ? gain[(k0 + kk) & gmask] * gscale : 1.0f;
        const f32x4 w4 = *(const f32x4*)(W + (size_t)(k0 + kk) * ldw + col0 + n0 + c4);
        LAS float* d = scr + kk * 33 + c4; d[0] = w4[0] * g; d[1] = w4[1] * g; d[2] = w4[2] * g; d[3] = w4[3] * g; }
    asm volatile("s_waitcnt lgkmcnt(0)" ::: "memory");
    const int c = lane & 7;
#pragma unroll
    for (int j = 0; j < 4; ++j) { const int n = (lane >> 3) + 8 * j; const LAS float* s = scr + (8 * c) * 33 + n;
        u32x4 o; o.x = pk2(s[0 * 33], s[1 * 33]); o.y = pk2(s[2 * 33], s[3 * 33]); o.z = pk2(s[4 * 33], s[5 * 33]); o.w = pk2(s[6 * 33], s[7 * 33]);
        *(u32x4*)(WT + (size_t)(row0 + n0 + n) * K + k0 + 8 * c) = o; }
    asm volatile("s_waitcnt lgkmcnt(0)" ::: "memory");
}
__device__ __forceinline__ void convert_weights(const Params& P, int l, LAS unsigned char* lds, int g_wid) {
    int tid_o = (g_wid << 6) | lane_id(); const int tid = tid_o, wid = tid >> 6, lane = tid & 63;
    LAS float* scr = (LAS float*)(lds + wid * 16384);
    bf16_t* W = (bf16_t*)(KPAR->ws + WS_W);
    const float* w_in = KPAR->in[3] + (size_t)l * 1024 * 4000; const float* attn_norm = KPAR->in[2] + l * 1024;
    const float* w_q = KPAR->in[6] + (size_t)l * 256 * 768; const float* qn = KPAR->in[5] + l * 256;
    const float* w_kv = KPAR->in[8] + (size_t)l * 128 * 1024; const float* kvn = KPAR->in[7] + l * 128;
    const float* w_a = KPAR->in[14] + (size_t)l * 512 * 1024; const float* w_b = KPAR->in[15] + (size_t)l * 512 * 1024; const float* subln = KPAR->in[13] + l * 128;
    const float* w_o = KPAR->in[16] + (size_t)l * 1024 * 1024; const float* mlpn = KPAR->in[17] + l * 1024;
    const float* w_up = KPAR->in[18] + (size_t)l * 1024 * 4096; const float* w_dn = KPAR->in[19] + (size_t)l * 4096 * 1024;
    const float lam_scale = 1.0f - (l == 0 ? 0.2f : 0.35550907f);
    const int gw = blockIdx.x * 8 + wid, NGW = gridDim.x * 8;
    constexpr int NITEMS = 208 + 768 + 512 + 512 + 96 + 64 + 256 + 256 + 512 + 2048 + 2048;
    for (int it = gw; it < NITEMS; it += NGW) {
        int r = it;
        if (r < 208) { transpose_item(w_in, 4000, 1024, 0, 13, W + WO_IN, 0, attn_norm, 1023, 1.f, scr, r, lane); continue; } r -= 208;
        if (r < 768) { transpose_item(w_in, 4000, 1024, 416, 48, W + WO_IN, 512, attn_norm, 1023, 1.f, scr, r, lane); continue; } r -= 768;
        if (r < 512) { transpose_item(w_in, 4000, 1024, 1952, 32, W + WO_GA, 0, attn_norm, 1023, 1.f, scr, r, lane); continue; } r -= 512;
        if (r < 512) { transpose_item(w_in, 4000, 1024, 2976, 32, W + WO_GB, 0, attn_norm, 1023, 1.f, scr, r, lane); continue; } r -= 512;
        if (r < 96) { transpose_item(w_q, 768, 256, 0, 24, W + WO_Q, 0, qn, 255, 1.f, scr, r, lane); continue; } r -= 96;
        if (r < 64) { transpose_item(w_kv, 1024, 128, 0, 32, W + WO_KV, 0, kvn, 127, 1.f, scr, r, lane); continue; } r -= 64;
        if (r < 256) { transpose_item(w_a, 1024, 512, 0, 32, W + WO_A, 0, nullptr, 0, 1.f, scr, r, lane); continue; } r -= 256;
        if (r < 256) { transpose_item(w_b, 1024, 512, 0, 32, W + WO_B, 0, subln, 127, lam_scale, scr, r, lane); continue; } r -= 256;
        if (r < 512) { transpose_item(w_o, 1024, 1024, 0, 32, W + WO_O, 0, nullptr, 0, 1.f, scr, r, lane); continue; } r -= 512;
        if (r < 2048) { transpose_item(w_up, 4096, 1024, 0, 128, W + WO_UP, 0, mlpn, 1023, 1.f, scr, r, lane); continue; } r -= 2048;
        transpose_item(w_dn, 1024, 4096, 0, 32, W + WO_DN, 0, nullptr, 0, 1.f, scr, r, lane);
    }
}
__device__ __forceinline__ void prologue_x(const Params& P, int g_wid) {
    int tid_o = (g_wid << 6) | lane_id(); const int tid = tid_o, wid = tid >> 6, lane = tid & 63;
    const int gw = blockIdx.x * 8 + wid, NGW = gridDim.x * 8;
    bf16_t* XB = (bf16_t*)(KPAR->ws + WS_XB); float* ssq = (float*)(KPAR->ws + WS_SSQ);
    for (int row = gw; row < MREAL + 16; row += NGW) {
        const float* src = row < MREAL ? KPAR->in[0] + (size_t)row * 1024 : KPAR->in[1] + (size_t)(row - MREAL) * 1024;
        float s = 0.f;
#pragma unroll
        for (int j = 0; j < 2; ++j) { const f32x4 v0 = ((const f32x4*)src)[128 * j + 2 * lane], v1 = ((const f32x4*)src)[128 * j + 2 * lane + 1]; s += sumsq4(v0) + sumsq4(v1); ((u32x4*)(XB + (size_t)row * 1024))[64 * j + lane] = pk8(v0, v1); }
        s = wave_sum(s);
        if (lane < 16) ssq[(size_t)row * 16 + lane] = lane == 0 ? s : 0.f;
    }
    { bf16_t* W = (bf16_t*)(KPAR->ws + WS_W);
      for (int i = blockIdx.x * NTHR + tid; i < 96 * 1024 / 8; i += gridDim.x * NTHR) ((u32x4*)(W + WO_IN + 416 * 1024))[i] = (u32x4){0u, 0u, 0u, 0u}; }
    f32x2* rope = (f32x2*)(KPAR->ws + WS_ROPE);
    for (int e = blockIdx.x * NTHR + tid; e < 8208 * 16; e += gridDim.x * NTHR) {
        const int pos = e >> 4, i = e & 15, i4 = i & 3, i16 = i >> 2;
        const float c4 = i4 == 0 ? 1.0f : (i4 == 1 ? 0.56234132519f : (i4 == 2 ? 0.31622776602f : 0.17782794100f));
        const float s16 = i16 == 0 ? 1.0f : (i16 == 1 ? 0.1f : (i16 == 2 ? 0.01f : 0.001f));
        const float inv = c4 * s16; const float ang = (float)pos * inv;
        const double x = (double)ang; const double nq = __builtin_rint(x * 0.63661977236758134308); const double r = __builtin_fma(-nq, 1.57079632679489661923, x);
        const double r2 = r * r;
        const double sn = r * (1.0 + r2 * (-1.0 / 6 + r2 * (1.0 / 120 + r2 * (-1.0 / 5040 + r2 * (1.0 / 362880 + r2 * (-1.0 / 39916800 + r2 * (1.0 / 6227020800.0)))))));
        const double cs = 1.0 + r2 * (-0.5 + r2 * (1.0 / 24 + r2 * (-1.0 / 720 + r2 * (1.0 / 40320 + r2 * (-1.0 / 3628800 + r2 * (1.0 / 479001600.0 + r2 * (-1.0 / 87178291200.0)))))));
        const int q = ((int)nq) & 3;
        const double c = q == 0 ? cs : (q == 1 ? -sn : (q == 2 ? -cs : sn));
        const double s = q == 0 ? sn : (q == 1 ? cs : (q == 2 ? -sn : -cs));
        rope[e] = (f32x2){(float)c, (float)s};
    }
}
constexpr int AT_KBUF = 12288, AT_VBUF = 16384, AT_K = 0, AT_V = 2 * AT_KBUF, AT_ASC = AT_V + 3 * AT_VBUF, AT_QW = AT_ASC + 1024;
__device__ __forceinline__ int crow(int r, int hi) { return (r & 3) + 8 * (r >> 2) + 4 * hi; }
#define MFMA32(a, b, c) __builtin_amdgcn_mfma_f32_32x32x16_bf16((a), (b), (c), 0, 0, 0)
template <int DQK, int DV, bool ALIBI>
__device__ __forceinline__ void attn_pass(LAS unsigned char* lds, const bf16_t* Qp, int qpitch, const bf16_t* K1, int k1pitch, const bf16_t* K2, int k2pitch,
                                          const bf16_t* Vp, int vpitch, int brow0, int NT, int qreal0, int meta, float sl2, float kmax, f32x16 (&o)[DV / 32], int g_wid) {
    constexpr int NCH = DQK / 8, NDS = DQK / 16, NDB = DV / 32, VCH = DV / 8, KP = (64 * NCH + 511) / 512, VP = (64 * VCH) / 512;
    int tid_o = (g_wid << 6) | lane_id(); const int tid = tid_o, lane = tid & 63, wid = __builtin_amdgcn_readfirstlane(tid >> 6), r32 = lane & 31, hi = lane >> 5;
    bf16x8 qf[NDS];
    { const bf16_t* qrow = Qp + (size_t)(32 * wid + r32) * qpitch + 8 * hi;
#pragma unroll
      for (int ds = 0; ds < NDS; ++ds) qf[ds] = *(const bf16x8*)(qrow + 16 * ds); }
    const bf16_t* ksrc[KP]; int kpit[KP]; unsigned kdst[KP]; bool kval[KP];
#pragma unroll
    for (int i = 0; i < KP; ++i) { const int p = tid + 512 * i; kval[i] = p < 64 * NCH; const int pp = kval[i] ? p : 0; const int key = pp / NCH, c = pp % NCH;
        if (NCH <= 8 || c < 8) { ksrc[i] = K1 + (size_t)key * k1pitch + c * 8; kpit[i] = k1pitch; } else { ksrc[i] = K2 + (size_t)key * k2pitch + (c - 8) * 8; kpit[i] = k2pitch; }
        kdst[i] = AT_K + c * 1024 + ((key ^ c) << 4); }
    const bf16_t* vsrc[VP]; unsigned vdst[VP];
#pragma unroll
    for (int i = 0; i < VP; ++i) { const int p = tid + 512 * i; const int key = p / VCH, c = p % VCH; vsrc[i] = Vp + (size_t)key * vpitch + c * 8; vdst[i] = AT_V + (c >> 2) * 4096 + key * 64 + (c & 3) * 16; }
    u32x4 kregA[KP], vregA[VP];
#define AT_ISSUE(t, KR_, VR_) do { const size_t kb_ = (size_t)((t) == 0 ? MREAL : brow0 + 64 * ((t) - 1)); \
        _Pragma("unroll") for (int i = 0; i < KP; ++i) if (kval[i]) KR_[i] = *(const u32x4*)(ksrc[i] + kb_ * kpit[i]); \
        _Pragma("unroll") for (int i = 0; i < VP; ++i) VR_[i] = *(const u32x4*)(vsrc[i] + kb_ * vpitch); } while (0)
#define AT_COMMIT(kbuf, vslot, KR_, VR_) do { \
        _Pragma("unroll") for (int i = 0; i < KP; ++i) if (kval[i]) *(LAS u32x4*)(lds + kdst[i] + (kbuf) * AT_KBUF) = KR_[i]; \
        _Pragma("unroll") for (int i = 0; i < VP; ++i) *(LAS u32x4*)(lds + vdst[i] + (vslot)) = VR_[i]; } while (0)
#define AT_BAR() asm volatile("s_waitcnt lgkmcnt(0)\n\ts_barrier" ::: "memory")
#define SB() __builtin_amdgcn_sched_barrier(0)
    unsigned kaddr[NDS];
#pragma unroll
    for (int ds = 0; ds < NDS; ++ds) { const int cx = 2 * ds + hi; kaddr[ds] = AT_K + cx * 1024 + ((r32 ^ cx) << 4); }
    const unsigned vb = AT_V + ((lane >> 4) & 1) * 32 + (lane & 3) * 8 + (4 * hi + ((lane & 15) >> 2)) * 64;
    LAS float* asc = (LAS float*)(lds + AT_ASC) + wid * 32;
    float m_ref = 0.f, l = 0.f;
    f32x16 negm;
#pragma unroll
    for (int r = 0; r < 16; ++r) negm[r] = 0.f;
#pragma unroll
    for (int db = 0; db < NDB; ++db)
#pragma unroll
        for (int r = 0; r < 16; ++r) o[db][r] = 0.f;
    const int qw0 = 32 * wid, qrow_l = qw0 + r32;
    bf16x8 pa[4];
    bool resc = false;
#define P_CINIT(t) do { \
        if (ALIBI) { const int kpos0 = (t) == 0 ? 0 : 16 + 64 * ((t) - 1), qpos0 = meta ? 0 : 16 + qreal0; const float tb = sl2x * (float)(kpos0 - qpos0 + 4 * hix) - m_ref; \
            _Pragma("unroll") for (int r = 0; r < 16; ++r) { c0[r] = tb + sl2x * (float)((r & 3) + 8 * (r >> 2)); c1[r] = c0[r] + 32.0f * sl2x; } } \
        else { c0 = negm; c1 = negm; } } while (0)
#define P_KREAD(kb) do { _Pragma("unroll") for (int ds = 0; ds < NDS; ++ds) { kf0[ds] = *(const LAS bf16x8*)(lds + kaddr[ds] + (kb) * AT_KBUF); kf1[ds] = *(const LAS bf16x8*)(lds + kaddr[ds] + (kb) * AT_KBUF + 512); } } while (0)
#define P_QK() do { __builtin_amdgcn_s_setprio(1); _Pragma("unroll") for (int ds = 0; ds < NDS; ++ds) { c0 = MFMA32(kf0[ds], qf[ds], c0); c1 = MFMA32(kf1[ds], qf[ds], c1); } __builtin_amdgcn_s_setprio(0); } while (0)
#define P_VREAD(vsp, dg) do { _Pragma("unroll") for (int d2 = 0; d2 < 2; ++d2) _Pragma("unroll") for (int ks = 0; ks < 4; ++ks) { \
            const LAS unsigned char* vp_ = lds + vb + (vsp) + ((dg) + d2) * 4096 + ks * 1024; \
            vlo[d2][ks] = __builtin_amdgcn_ds_read_tr16_b64_v4i16((LAS v4i16_t*)vp_); vhh[d2][ks] = __builtin_amdgcn_ds_read_tr16_b64_v4i16((LAS v4i16_t*)(vp_ + 512)); } } while (0)
#define P_PV(dg, ksa) do { __builtin_amdgcn_s_setprio(1); _Pragma("unroll") for (int ks = (ksa); ks < (ksa) + 2; ++ks) _Pragma("unroll") for (int d2 = 0; d2 < 2; ++d2) { \
            const bf16x8 vf_ = __builtin_shufflevector(vlo[d2][ks], vhh[d2][ks], 0, 1, 2, 3, 4, 5, 6, 7); o[(dg) + d2] = MFMA32(pa[ks], vf_, o[(dg) + d2]); } __builtin_amdgcn_s_setprio(0); } while (0)
#define P_MASKMAX(t) do { \
        int lim; if ((t) == 0) lim = meta ? (qrow_l < 15 ? qrow_l : 15) : 15; else lim = qreal0 + qrow_l - 64 * ((t) - 1); \
        if (__any(lim < 63)) { \
            _Pragma("unroll") for (int r = 0; r < 16; ++r) { const int kidx = crow(r, hix); if (kidx > lim) c0[r] = -INFINITY; if (kidx + 32 > lim) c1[r] = -INFINITY; } } \
        float mx = fmaxf(c0[0], c1[0]); \
        _Pragma("unroll") for (int r = 1; r < 16; ++r) mx = fmaxf(fmaxf(mx, c0[r]), c1[r]); \
        mx = half_max(mx); \
        if ((t) == 0 || __any(mx > 90.0f)) { \
            const float dl = (t) == 0 ? mx : fmaxf(mx, 0.f); \
            m_ref += dl; \
            _Pragma("unroll") for (int r = 0; r < 16; ++r) { c0[r] -= dl; c1[r] -= dl; negm[r] = -m_ref; } \
            if ((t) != 0) { const float alpha = __builtin_amdgcn_exp2f(-dl); l *= alpha; if (hi == 0) asc[r32] = alpha; resc = true; } \
        } } while (0)
#define P_EXP0() do { _Pragma("unroll") for (int r = 0; r < 16; ++r) c0[r] = __builtin_amdgcn_exp2f(c0[r]); } while (0)
#define P_EXP1SUM() do { float rs0 = 0.f, rs1 = 0.f; \
        _Pragma("unroll") for (int r = 0; r < 16; ++r) { c1[r] = __builtin_amdgcn_exp2f(c1[r]); rs0 += c0[r]; rs1 += c1[r]; } l += rs0 + rs1; } while (0)
#define P_PACK() do { _Pragma("unroll") for (int s = 0; s < 2; ++s) { u32x4 w0, w1; \
        _Pragma("unroll") for (int j = 0; j < 4; ++j) { w0[j] = cvt_pk(c0[8 * s + 2 * j], c0[8 * s + 2 * j + 1]); w1[j] = cvt_pk(c1[8 * s + 2 * j], c1[8 * s + 2 * j + 1]); } \
        pa[s] = __builtin_bit_cast(bf16x8, w0); pa[2 + s] = __builtin_bit_cast(bf16x8, w1); } } while (0)
#define P_RESC() do { if (resc) { resc = false; \
        _Pragma("unroll") for (int g = 0; g < 4; ++g) { const f32x4 a4 = *(const LAS f32x4*)(asc + 8 * g + 4 * hi); \
            _Pragma("unroll") for (int db = 0; db < NDB; ++db) _Pragma("unroll") for (int i = 0; i < 4; ++i) o[db][4 * g + i] *= a4[i]; } } } while (0)
#define AT_OPAQUE() float sl2x = sl2; int hix = hi; asm volatile("" : "+v"(sl2x), "+v"(hix))
    int skip = 0;
    if (ALIBI && !meta && NT > 6) {
        const bf16_t* krow = K1 + (size_t)(brow0 + qreal0 + 32 * wid + r32) * k1pitch + 8 * hi;
        float dot = 0.f, qn2 = 0.f;
#pragma unroll
        for (int ds = 0; ds < NDS; ++ds) { const bf16x8 kk = *(const bf16x8*)(krow + 16 * ds);
#pragma unroll
            for (int j = 0; j < 8; ++j) { const float qv = bf2f((unsigned short)qf[ds][j]), kv = bf2f((unsigned short)kk[j]); dot += qv * kv; qn2 += qv * qv; } }
        dot = half_sum(dot); qn2 = half_sum(qn2);
        float T = dot + sl2 * (float)(32 * wid + r32) - sqrtf(qn2) * kmax - 0.5f;
#pragma unroll
        for (int o2 = 1; o2 < 32; o2 <<= 1) T = fminf(T, shx(T, o2));
        LAS float* tm = (LAS float*)(lds + AT_ASC);
        if (lane == 0) tm[32 * wid] = T;
        AT_BAR();
        float Tmin = tm[0];
#pragma unroll
        for (int w = 1; w < 8; ++w) Tmin = fminf(Tmin, tm[32 * w]);
        const float X = ((Tmin - 48.0f) / sl2 + (float)(qreal0 + 1)) * (1.0f / 64.0f);
        int J = X > 2.0f ? (int)X - 1 : 0;
        J = J < NT - 5 ? J : NT - 5;
        skip = __builtin_amdgcn_readfirstlane(J > 0 ? J : 0);
        NT -= skip;
    }
#define TJ(t) ((t) == 0 ? 0 : (t) + skip)
    int vs_prev = 0, vs_cur = AT_VBUF, vs_next = 2 * AT_VBUF;
    AT_ISSUE(0, kregA, vregA); AT_COMMIT(0, 0, kregA, vregA);
    AT_BAR();
    {
        f32x16 c0, c1; bf16x8 kf0[NDS], kf1[NDS]; AT_OPAQUE();
        if (NT > 1) AT_ISSUE(TJ(1), kregA, vregA);
        P_CINIT(0); P_KREAD(0); SB(); P_QK(); SB(); P_MASKMAX(0); P_EXP0(); P_EXP1SUM(); P_PACK();
        if (NT > 1) AT_COMMIT(1, vs_cur, kregA, vregA);
        AT_BAR();
    }
#define WAVE_HAS(j) ((j) == 0 || 64 * ((j) - 1) <= qreal0 + qw0 + 31)
    const int NT1 = (meta || NT < 5) ? NT : NT - 3;
    for (int t = 1; t < NT1; ++t) {
        f32x16 c0, c1; bf16x8 kf0[NDS], kf1[NDS]; v4i16_t vlo[2][4], vhh[2][4]; AT_OPAQUE();
        const int kb = t & 1;
        if (t + 1 < NT) AT_ISSUE(TJ(t + 1), kregA, vregA);
        P_RESC();
        P_CINIT(TJ(t)); P_KREAD(kb); SB();
        P_QK(); SB(); P_VREAD(vs_prev, 0); SB(); P_PV(0, 0); SB();
        P_MASKMAX(TJ(t)); SB();
        P_PV(0, 2); SB(); if (NDB == 4) P_VREAD(vs_prev, 2); SB();
        P_EXP0(); SB();
        if (NDB == 4) P_PV(2, 0); SB();
        P_EXP1SUM(); SB();
        if (NDB == 4) P_PV(2, 2); SB();
        P_PACK();
        if (t + 1 < NT) AT_COMMIT(kb ^ 1, vs_next, kregA, vregA);
        AT_BAR();
        const int tmp_ = vs_prev; vs_prev = vs_cur; vs_cur = vs_next; vs_next = tmp_;
    }
    for (int t = NT1; t < NT; ++t) {
        const int kb = t & 1;
        if (t + 1 < NT) AT_ISSUE(TJ(t + 1), kregA, vregA);
        if (WAVE_HAS(TJ(t - 1))) {
            v4i16_t vlo[2][4], vhh[2][4];
            P_RESC();
            P_VREAD(vs_prev, 0); SB(); P_PV(0, 0); P_PV(0, 2); SB();
            if (NDB == 4) { P_VREAD(vs_prev, 2); SB(); P_PV(2, 0); P_PV(2, 2); SB(); }
        }
        if (WAVE_HAS(TJ(t))) {
            f32x16 c0, c1; bf16x8 kf0[NDS], kf1[NDS]; AT_OPAQUE();
            P_CINIT(TJ(t)); P_KREAD(kb); SB(); P_QK(); SB(); P_MASKMAX(TJ(t)); P_EXP0(); P_EXP1SUM(); P_PACK();
        }
        if (t + 1 < NT) AT_COMMIT(kb ^ 1, vs_next, kregA, vregA);
        AT_BAR();
        const int tmp_ = vs_prev; vs_prev = vs_cur; vs_cur = vs_next; vs_next = tmp_;
    }
    {
        if (WAVE_HAS(TJ(NT - 1))) {
            v4i16_t vlo[2][4], vhh[2][4];
            P_RESC();
            P_VREAD(vs_prev, 0); SB(); P_PV(0, 0); P_PV(0, 2); SB();
            if (NDB == 4) { P_VREAD(vs_prev, 2); SB(); P_PV(2, 0); P_PV(2, 2); SB(); }
        }
        AT_BAR();
    }
#undef WAVE_HAS
    l = half_sum(l);
    const float inv = 1.0f / l;
    if (hi == 0) asc[r32] = inv;
#pragma unroll
    for (int g = 0; g < 4; ++g) { const f32x4 a4 = *(const LAS f32x4*)(asc + 8 * g + 4 * hi);
#pragma unroll
        for (int db = 0; db < NDB; ++db)
#pragma unroll
            for (int i = 0; i < 4; ++i) o[db][4 * g + i] *= a4[i]; }
#undef AT_ISSUE
#undef AT_COMMIT
#undef AT_BAR
#undef SB
#undef P_CINIT
#undef P_KREAD
#undef P_QK
#undef P_VREAD
#undef P_PV
#undef P_MASKMAX
#undef P_EXP0
#undef P_EXP1SUM
#undef P_PACK
#undef P_RESC
#undef AT_OPAQUE
#undef TJ
}
template <int NDB> __device__ __forceinline__ void store_rows16(LAS unsigned char* lds, const f32x16 (&o)[NDB], const float (&scl)[16], bf16_t* dst  , int ld, int meta, int wid, int lane) {
    constexpr int PITCH = NDB * 64 + 16, CH = NDB * 4;
    static_assert(8 * 32 * PITCH <= AT_ASC, "output staging overlaps the softmax scratch");
    const int r32 = lane & 31, hi = lane >> 5;
    LAS unsigned char* st = lds + wid * (32 * PITCH);
#pragma unroll
    for (int r = 0; r < 16; ++r)
#pragma unroll
        for (int db = 0; db < NDB; ++db) *(LAS bf16_t*)(st + crow(r, hi) * PITCH + (db * 32 + r32) * 2) = (bf16_t)f2bf(o[db][r] * scl[r]);
#pragma unroll
    for (int k = 0; k < NDB * 2; ++k) { const int id = lane + 64 * k, row = id / CH, ch = id % CH;
        const u32x4 vv = *(const LAS u32x4*)(st + row * PITCH + ch * 16);
        if (!meta || 32 * wid + row < 16) *(u32x4*)(dst + (size_t)(32 * wid + row) * ld + ch * 8) = vv; }
}
__device__ __forceinline__ void attn_unit_mla(const Params& P, LAS unsigned char* lds, int b, int h, int qb, int meta, int g_wid) {
    const bf16_t* Q = (const bf16_t*)(KPAR->ws + WS_POOL + PO_Q); const bf16_t* KV = (const bf16_t*)(KPAR->ws + WS_POOL + PO_KV); const bf16_t* KR = (const bf16_t*)(KPAR->ws + WS_KR);
    bf16_t* AO = (bf16_t*)(KPAR->ws + WS_POOL + PO_AO);
    int tid_o = (g_wid << 6) | lane_id(); const int tid = tid_o, lane = tid & 63, wid = tid >> 6, r32 = lane & 31, hi = lane >> 5;
    const int row0 = meta ? MREAL : b * SEQ + 256 * qb, NT = meta ? 1 : 1 + 4 * (qb + 1);
    f32x16 o[2];
    attn_pass<96, 64, false>(lds, Q + (size_t)row0 * 768 + h * 96, 768, KV + h * 128, 1024, KR, 32, KV + h * 128 + 64, 1024, b * SEQ, NT, 256 * qb, meta, 0.f, 0.f, o, g_wid);
    float one[16];
#pragma unroll
    for (int r = 0; r < 16; ++r) one[r] = 1.0f;
    (void)r32; (void)hi;
    store_rows16<2>(lds, o, one, AO + (size_t)row0 * 512 + h * 64, 512, meta, wid, lane);
}
__device__ __forceinline__ void attn_unit_diff(const Params& P, LAS unsigned char* lds, int b, int h, int qb, int meta, int map, int l, float lam, float kmax, int g_wid) {
    const bf16_t* DQ = (const bf16_t*)(KPAR->ws + WS_POOL + PO_DQ); const bf16_t* DK = (const bf16_t*)(KPAR->ws + WS_POOL + PO_DK); const bf16_t* DVv = (const bf16_t*)(KPAR->ws + WS_POOL + PO_DV);
    const int row0 = meta ? MREAL : b * SEQ + 256 * qb, NT = meta ? 1 : 1 + 4 * (qb + 1);
    const float sl2 = LOG2E * (h == 0 ? 0.25f : (h == 1 ? 0.0625f : (h == 2 ? 0.015625f : 0.00390625f)));
    f32x16 o[4];
    attn_pass<64, 128, true>(lds, DQ + (size_t)row0 * 512 + h * 128 + 64 * map, 512, DK + h * 128 + 64 * map, 512, nullptr, 0, DVv + h * 128, 512, b * SEQ, NT, 256 * qb, meta, sl2, kmax, o, g_wid);
    const int unit = meta ? 256 + h : ((b * 4 + h) * 32 + qb);
    unsigned* cw = (unsigned*)(KPAR->ws + WS_CTL) + 8192 + l * 1024 + unit * 2;
    const int tid = (g_wid << 6) | lane_id(), lane = tid & 63, wid = tid >> 6, r32 = lane & 31, hi = lane >> 5;
    float* st4 = (float*)(KPAR->ws + WS_POOL + PO_S) + (meta ? (size_t)256 * 32768 + (size_t)h * 4096 : (size_t)unit * 32768) + (size_t)tid * 64;
    const bool parks = !meta || wid == 0;
    static_assert((size_t)256 * 131072 + 4 * 16384 <= R1K, "parking slots exceed the S region");
    if (tid == 0) *(LAS unsigned*)(lds + AT_QW + 64) = __hip_atomic_fetch_add(cw, 1u, __ATOMIC_RELAXED, __HIP_MEMORY_SCOPE_AGENT);
    __syncthreads();
    const unsigned first = *(LAS unsigned*)(lds + AT_QW + 64) == 0u;
    if (first) {
#pragma unroll
        for (int db = 0; db < 4; ++db)
#pragma unroll
            for (int g = 0; g < 4; ++g) if (parks) ((f32x4*)st4)[db * 4 + g] = (f32x4){o[db][4 * g], o[db][4 * g + 1], o[db][4 * g + 2], o[db][4 * g + 3]};
        asm volatile("s_waitcnt vmcnt(0)" ::: "memory");
        __syncthreads();
        if (tid == 0) { __builtin_amdgcn_fence(__ATOMIC_RELEASE, "agent"); asm volatile("s_waitcnt vmcnt(0)" ::: "memory");
                        __hip_atomic_store(cw + 1, 1u, __ATOMIC_RELAXED, __HIP_MEMORY_SCOPE_AGENT); }
        return;
    }
    if (tid == 0) { while (__hip_atomic_load(cw + 1, __ATOMIC_RELAXED, __HIP_MEMORY_SCOPE_AGENT) == 0u) __builtin_amdgcn_s_sleep(2);
                    __builtin_amdgcn_fence(__ATOMIC_ACQUIRE, "agent"); asm volatile("s_waitcnt vmcnt(0)" ::: "memory"); }
    __syncthreads();
    bf16_t* DN = (bf16_t*)(KPAR->ws + WS_POOL + PO_DN);
    const float ca = map == 0 ? 1.0f : -lam, cb = map == 0 ? -lam : 1.0f;
#pragma unroll
    for (int db = 0; db < 4; ++db)
#pragma unroll
        for (int g = 0; g < 4; ++g) { f32x4 s4 = (f32x4){0.f, 0.f, 0.f, 0.f}; if (parks) s4 = __builtin_nontemporal_load((const f32x4*)st4 + db * 4 + g);
#pragma unroll
            for (int i = 0; i < 4; ++i) o[db][4 * g + i] = map == 0 ? (o[db][4 * g + i] - lam * s4[i]) : (s4[i] - lam * o[db][4 * g + i]); }
    (void)ca; (void)cb;
    float rs[16];
#pragma unroll
    for (int r = 0; r < 16; ++r) {
        float ss = (o[0][r] * o[0][r] + o[1][r] * o[1][r]) + (o[2][r] * o[2][r] + o[3][r] * o[3][r]);
        ss += shx(ss, 1); ss += shx(ss, 2); ss += shx(ss, 4); ss += shx(ss, 8); ss += shx(ss, 16);
        rs[r] = rsqrtf(ss * (1.0f / 128.0f) + EPS);
    }
    (void)r32; (void)hi;
    store_rows16<4>(lds, o, rs, DN + (size_t)row0 * 512 + h * 128, 512, meta, wid, lane);
}
__device__ __forceinline__ void attn_phase(const Params& P, LAS unsigned char* lds, int lc, int g_wid) {
    const int l = lc & 1;
    int tid_o = (g_wid << 6) | lane_id(); const int tid = tid_o, lane = tid & 63;
    const float s1 = wave_sum(KPAR->in[9][l * 64 + lane] * KPAR->in[10][l * 64 + lane]), s2 = wave_sum(KPAR->in[11][l * 64 + lane] * KPAR->in[12][l * 64 + lane]);
    const float lam = expf(s1) - expf(s2) + (l == 0 ? 0.2f : 0.35550907f);
    const float kmax = sqrtf(2.0f * __uint_as_float(__hip_atomic_load((unsigned*)(KPAR->ws + WS_CTL) + 3000 + 64 * l, __ATOMIC_RELAXED, __HIP_MEMORY_SCOPE_AGENT))) * 1.01f;
    const int xcc = (int)((unsigned)__builtin_amdgcn_s_getreg((3 << 11) | 20) & 7u);
    for (int qi = 0; qi < 8; ++qi) {
        const int q = (xcc + qi) & 7;
        unsigned* ctr = (unsigned*)(KPAR->ws + WS_CTL) + 64 * (lc * 8 + q);
        for (;;) {
            if (tid == 0) *(LAS unsigned*)(lds + AT_QW) = atomicAdd(ctr, 1u);
            __syncthreads();
            const int u = (int)*(LAS unsigned*)(lds + AT_QW);
            __syncthreads();
            if (u >= (l == 0 ? 130 : 128)) break;
            if (u < 128) { const int qb = 31 - (u >> 2), j = u & 3;
                if (j < 2) attn_unit_diff(P, lds, q >> 2, (qb & 1) ? 3 - (q & 3) : (q & 3), qb, 0, j, l, lam, kmax, g_wid);     else { const int s = q + 8 * (j - 2); attn_unit_mla(P, lds, s >> 3, s & 7, qb, 0, g_wid); }
            } else { const int m = q + 8 * (u - 128);
                if (m < 8) attn_unit_diff(P, lds, 0, m >> 1, 0, 1, m & 1, l, lam, kmax, g_wid); else attn_unit_mla(P, lds, 0, m - 8, 0, 1, g_wid); }
        }
    }
}
#define XB_TMO      128
#define XB_XCNT(j)  (256  + 64 * (j))
#define XB_XSUB(j)  (1280 + 64 * (j))
#define XB_XGEN(j)  (2304 + 64 * (j))
#define XB_TOP      3328
#define XB_TOPGEN   3392
#define XCD_BAR_WORDS 3456
#define XB_SPIN_CAP (1u << 18)

__device__ __forceinline__ unsigned xb_ld(unsigned* p)              { return __hip_atomic_load(p, __ATOMIC_RELAXED, __HIP_MEMORY_SCOPE_AGENT); }
__device__ __forceinline__ unsigned xb_add(unsigned* p, unsigned v) { return __hip_atomic_fetch_add(p, v, __ATOMIC_RELAXED, __HIP_MEMORY_SCOPE_AGENT); }
__device__ __forceinline__ unsigned xb_xcc_id() { return (unsigned)__builtin_amdgcn_s_getreg((3 << 11) | 20) & 0xFu; }
#define XB_SPIN(cond, bar) do { unsigned _sp = 0; while (cond) { __builtin_amdgcn_s_sleep(1); \
    if ((++_sp & 255u) == 0u) { if (xb_ld(&(bar)[XB_TMO])) break; if (_sp > XB_SPIN_CAP) { atomicAdd(&(bar)[XB_TMO], 1u); break; } } } } while (0)

struct XcdBarrier {
    unsigned* bar; unsigned x;
    volatile LAS unsigned* st;
};

__device__ __forceinline__ XcdBarrier xcd_barrier_post(unsigned* bar, volatile LAS unsigned* st, bool leader) {
    XcdBarrier b; b.bar = bar; b.x = xb_xcc_id(); b.st = st;
    if (leader) (void)xb_add(&bar[XB_XCNT(b.x)], 1u);
    return b;
}
__device__ __forceinline__ void xcd_barrier_complete(unsigned* bar, unsigned x, unsigned& nloc, unsigned& nx) {
    const unsigned G = gridDim.x * gridDim.y * gridDim.z;
    unsigned sum, cnt, mine, sp = 0u;
    for (;;) {
        sum = 0u; cnt = 0u; mine = 0u;
#pragma unroll
        for (unsigned j = 0; j < 16; ++j) { const unsigned c = xb_ld(&bar[XB_XCNT(j)]); sum += c; cnt += (c > 0u) ? 1u : 0u; mine = (j == x) ? c : mine; }
        if (sum == G) break;
        __builtin_amdgcn_s_sleep(1);
        if ((++sp & 255u) == 0u) { if (xb_ld(&bar[XB_TMO])) break; if (sp > XB_SPIN_CAP) { atomicAdd(&bar[XB_TMO], 1u); break; } }
    }
    nloc = mine > 0u ? mine : 1u; nx = cnt > 0u ? cnt : 1u;
}

__device__ __forceinline__ void xcd_barrier(const XcdBarrier& b, int g_wid) {
    asm volatile("s_waitcnt vmcnt(0)" ::: "memory");
    __syncthreads();
    if (g_wid == 0 && lane_id() == 0) {
        unsigned* bar = b.bar;
        __builtin_amdgcn_s_waitcnt(0);
        unsigned nloc = b.st[0], nx = b.st[1];
        if (nloc == 0u) { xcd_barrier_complete(bar, b.x, nloc, nx); b.st[0] = nloc; b.st[1] = nx; }
        const unsigned old = xb_add(&bar[XB_XSUB(b.x)], 1u);
        const unsigned gen = old / nloc;
        if (old + 1u == (gen + 1u) * nloc) {
            __builtin_amdgcn_fence(__ATOMIC_RELEASE, "agent");
            asm volatile("s_waitcnt vmcnt(0)" ::: "memory");
            const unsigned og = xb_add(&bar[XB_TOP], 1u);
            const unsigned tg = og / nx;
            if (og + 1u == (tg + 1u) * nx) xb_add(&bar[XB_TOPGEN], 1u);
            else XB_SPIN(xb_ld(&bar[XB_TOPGEN]) == tg, bar);
            __builtin_amdgcn_fence(__ATOMIC_ACQUIRE, "agent");
            xb_add(&bar[XB_XGEN(b.x)], 1u);
            asm volatile("s_waitcnt vmcnt(0)" ::: "memory");
        } else {
            XB_SPIN(xb_ld(&bar[XB_XGEN(b.x)]) == gen, bar);
            __builtin_amdgcn_fence(__ATOMIC_ACQUIRE, "agent");
            asm volatile("s_waitcnt vmcnt(0)" ::: "memory");
        }
    }
    __syncthreads();
}

constexpr int LDS_BYTES = 131072 + 1024;
__global__ void __launch_bounds__(512, 2) fwd_megakernel(Params P) {
    extern __shared__ __attribute__((aligned(16))) unsigned char lds_raw[];
    LAS unsigned char* lds = (LAS unsigned char*)lds_raw;
    const int g_wid = __builtin_amdgcn_readfirstlane(threadIdx.x >> 6);
    volatile LAS unsigned* xb_st = (volatile LAS unsigned*)(lds + 131072 + 64);
    if (g_wid == 0 && lane_id() < 2) xb_st[lane_id()] = 0u;
    __syncthreads();
    const XcdBarrier xbar = xcd_barrier_post((unsigned*)(KPAR->ws + WS_CTL) + 4096, xb_st, g_wid == 0 && lane_id() == 0);
#define GRID_SYNC() xcd_barrier(xbar, g_wid)
#define WSP unsigned char* ws = KPAR->ws; asm volatile("" : "+s"(ws)); unsigned char* pool = ws + WS_POOL; (void)pool
#define PW ((bf16_t*)(ws + WS_W))
#define PXB ((bf16_t*)(ws + WS_XB))
#define PSSQ ((float*)(ws + WS_SSQ))
#define PSSQQ ((float*)(ws + WS_SSQQ))
#define PSSQKV ((float*)(ws + WS_SSQKV))
#define PXMETA ((float*)(ws + WS_XMETA))
#define PROPE ((const f32x2*)(ws + WS_ROPE))
#define PKR ((bf16_t*)(ws + WS_KR))
#define PP(off) ((bf16_t*)(pool + (off)))
#ifndef PHM
#define PHM 0xffff
#endif
#if PHM & 1
    prologue_x(P, g_wid); convert_weights(P, 0, lds, g_wid);
#if defined(PROBE_DUP) && (PROBE_DUP & 1)
    convert_weights(P, 0, lds, g_wid);
#endif
#endif
    if (KPAR->ws == nullptr) cg::this_grid().sync();
    GRID_SYNC();
    for (int l = 0; l < 2; ++l) {
#if PHM & 1
        if (l == 1) { convert_weights(P, 1, lds, g_wid); GRID_SYNC(); }
#endif
        const bool m_all = (l == 0);
#if PHM & 2
        {
            WSP; gemm_all<REWin>(lds, PXB, PW + WO_IN, 2048, 1024, REWin{PSSQ, (unsigned*)(ws + WS_CTL) + 3000 + 64 * l, PP(PO_QA), PP(PO_KVA), PKR, PP(PO_DQ), PP(PO_DK), PP(PO_DV), PSSQQ, PSSQKV, PROPE}, true, g_wid);
        }
        GRID_SYNC();
#if defined(PROBE_DUP) && (PROBE_DUP & 2)
        {
            WSP; gemm_all<REWin>(lds, PXB, PW + WO_IN, 2048, 1024, REWin{PSSQ, (unsigned*)(ws + WS_CTL) + 3000 + 64 * l, PP(PO_QA), PP(PO_KVA), PKR, PP(PO_DQ), PP(PO_DK), PP(PO_DV), PSSQQ, PSSQKV, PROPE}, true, g_wid);
        }
        GRID_SYNC();
#endif
#endif
#if PHM & 4
        {
            WSP; gemm_all<REQup>(lds, PP(PO_QA), PW + WO_Q, 768, 256, REQup{PSSQQ, PP(PO_Q), PROPE}, m_all, g_wid);
        }
        {   WSP; gemm_all<REKVup>(lds, PP(PO_KVA), PW + WO_KV, 1024, 128, REKVup{PSSQKV, PP(PO_KV)}, true, g_wid); }
        GRID_SYNC();
#if defined(PROBE_DUP) && (PROBE_DUP & 4)
        {
            WSP; gemm_all<REQup>(lds, PP(PO_QA), PW + WO_Q, 768, 256, REQup{PSSQQ, PP(PO_Q), PROPE}, m_all, g_wid);
        }
        {   WSP; gemm_all<REKVup>(lds, PP(PO_KVA), PW + WO_KV, 1024, 128, REKVup{PSSQKV, PP(PO_KV)}, true, g_wid); }
        GRID_SYNC();
#endif
#endif
#if PHM & 8
        attn_phase(P, lds, l, g_wid);
#ifdef PROBE_ATTN2
        GRID_SYNC(); attn_phase(P, lds, l + 2, g_wid);
#endif
        GRID_SYNC();
#endif
#if PHM & 16
        {   WSP; gemm_all<REStore>(lds, PP(PO_AO), PW + WO_A, 1024, 512, REStore{PP(PO_S)}, m_all, g_wid); }
        {   WSP; gemm_all<REGate>(lds, PXB, PW + WO_GA, 1024, 1024, REGate{PSSQ, KPAR->in[4] + (size_t)l * 2048, PP(PO_S), nullptr, 0}, m_all, g_wid); }
        {   WSP; gemm_all<REStore>(lds, PP(PO_DN), PW + WO_B, 1024, 512, REStore{PP(PO_YQ)}, m_all, g_wid); }
        {   WSP; gemm_all<REGate>(lds, PXB, PW + WO_GB, 1024, 1024, REGate{PSSQ, KPAR->in[4] + (size_t)l * 2048 + 1024, PP(PO_S), PP(PO_YQ), 1}, m_all, g_wid); }
        GRID_SYNC();
#if defined(PROBE_DUP) && (PROBE_DUP & 16)
        {   WSP; gemm_all<REStore>(lds, PP(PO_AO), PW + WO_A, 1024, 512, REStore{PP(PO_S)}, m_all, g_wid); }
        {   WSP; gemm_all<REGate>(lds, PXB, PW + WO_GA, 1024, 1024, REGate{PSSQ, KPAR->in[4] + (size_t)l * 2048, PP(PO_S), nullptr, 0}, m_all, g_wid); }
        {   WSP; gemm_all<REStore>(lds, PP(PO_DN), PW + WO_B, 1024, 512, REStore{PP(PO_YQ)}, m_all, g_wid); }
        {   WSP; gemm_all<REGate>(lds, PXB, PW + WO_GB, 1024, 1024, REGate{PSSQ, KPAR->in[4] + (size_t)l * 2048 + 1024, PP(PO_S), PP(PO_YQ), 1}, m_all, g_wid); }
        GRID_SYNC();
#endif
#endif
#if PHM & 32
        {
            WSP; float* out = KPAR->out; gemm_all<REResid>(lds, PP(PO_S), PW + WO_O, 1024, 1024, REResid{l == 0 ? KPAR->in[0] : out, l == 0 ? KPAR->in[1] : PXMETA, out, PXMETA, PXB, PSSQ}, m_all, g_wid);
        }
        GRID_SYNC();
#endif
#if PHM & 64
        {
            WSP; gemm_all<REUp>(lds, PXB, PW + WO_UP, 4096, 1024, REUp{PSSQ, PP(PO_H)}, m_all, g_wid);
        }
        GRID_SYNC();
#if defined(PROBE_DUP) && (PROBE_DUP & 64)
        {
            WSP; gemm_all<REUp>(lds, PXB, PW + WO_UP, 4096, 1024, REUp{PSSQ, PP(PO_H)}, m_all, g_wid);
        }
        GRID_SYNC();
#endif
#endif
#if PHM & 128
        {
            WSP; float* out = KPAR->out; gemm_all<REResid>(lds, PP(PO_H), PW + WO_DN, 1024, 4096, REResid{out, PXMETA, out, PXMETA, l == 1 ? (bf16_t*)nullptr : PXB, PSSQ}, m_all, g_wid);
        }
        GRID_SYNC();
#endif
    }
    { int tid_o = (g_wid << 6) | lane_id(); const int tid = tid_o, wid = tid >> 6, lane = tid & 63; const float* g = KPAR->in[20]; WSP; float* ssq = PSSQ; float* out = KPAR->out;
      for (int row = blockIdx.x * 8 + wid; row < MREAL; row += gridDim.x * 8) {
          const float rstd = rsqrtf(sum16p(ssq + (size_t)row * 16) * (1.0f / 1024.0f) + EPS);
          f32x4* o4 = (f32x4*)(out + (size_t)row * 1024);
#pragma unroll
          for (int j = 0; j < 4; ++j) o4[64 * j + lane] = o4[64 * j + lane] * rstd * ((const f32x4*)g)[64 * j + lane];
      } }
}

extern "C" void kernel_launch(void* const* d_in, const int* in_sizes, int n_in, void* d_out, int out_size, void* d_ws, size_t ws_size, hipStream_t stream) {
    static int grid = 0;
    if (grid == 0) {
        if (n_in != 21 || ws_size < WS_END) { fprintf(stderr, "kernel_launch: unexpected inputs (n_in %d, ws %zu < %zu)\n", n_in, ws_size, (size_t)WS_END); grid = -1; return; }
        int dev = 0, cus = 0, per_cu = 0;
        (void)hipGetDevice(&dev); (void)hipDeviceGetAttribute(&cus, hipDeviceAttributeMultiprocessorCount, dev);
        (void)hipFuncSetAttribute((const void*)fwd_megakernel, hipFuncAttributeMaxDynamicSharedMemorySize, LDS_BYTES);
        (void)hipOccupancyMaxActiveBlocksPerMultiprocessor(&per_cu, (const void*)fwd_megakernel, 512, LDS_BYTES);
        if (per_cu < 1) per_cu = 1;
        grid = cus * per_cu; if (grid > 256) grid = 256;
        (void)hipGetLastError();
    }
    if (grid < 0) return;
    (void)hipMemsetAsync((char*)d_ws + WS_CTL, 0, CTL_BYTES, stream);
    Params p{};
    for (int i = 0; i < 21; ++i) p.in[i] = (const float*)d_in[i];
    p.out = (float*)d_out; p.ws = (unsigned char*)d_ws;
    void* args[] = {&p};
    hipError_t e = hipLaunchCooperativeKernel((const void*)fwd_megakernel, dim3(grid), dim3(512), args, LDS_BYTES, stream);
    if (e != hipSuccess) fprintf(stderr, "cooperative launch failed: %s (grid %d)\n", hipGetErrorString(e), grid);
}
```

```cpp
#include <hip/hip_runtime.h>
#include <hip/hip_cooperative_groups.h>
#include <cstdio>
#include <cstdint>
namespace cg = cooperative_groups;
__device__ __forceinline__ int lane_id() { int l; asm volatile("v_mbcnt_lo_u32_b32 %0, -1, 0\n\tv_mbcnt_hi_u32_b32 %0, -1, %0" : "=v"(l)); return l; }

namespace pg8 {
#define PG8_LAS __attribute__((address_space(3)))
typedef unsigned short bf16_t;
typedef short bf16x8 __attribute__((ext_vector_type(8)));
typedef float f32x4 __attribute__((ext_vector_type(4)));
typedef unsigned u32x4 __attribute__((ext_vector_type(4)));
constexpr int BM = 256, BK = 64, HALF = 128, HTB = HALF * BK * 2  , STAGE_BYTES = 8 * HTB, NXCD = 8, WGM = 8;

__host__ __device__ __forceinline__ int lds_byte(int r, int c) { const int st = (r >> 4) * 2 + (c >> 5), rr = r & 15, cc = c & 31, ob = rr * 64 + cc * 2; return st * 1024 + (ob ^ (((ob >> 9) & 1) << 5)); }
__host__ __device__ __forceinline__ void stage_rc(int b, int& R, int& C) { const int st = b / 1024, sb = b % 1024, swz = sb ^ (((sb >> 9) & 1) << 5); R = (st >> 1) * 16 + swz / 64; C = (st & 1) * 32 + (swz % 64) / 2; }
__host__ __device__ __forceinline__ int perm32(int rho) { const int n = rho >> 4, i = rho & 15; return 8 * (i >> 2) + 4 * n + (i & 3); }

struct Unit { int pm, pn; };
struct Gemm { const bf16_t* A; const bf16_t* Bt; int M, N, K; };

struct StaticOrder {
    int nM, nN, nwg, G, c;
    __host__ __device__ void init(int M, int N, int G_, int c_) { nM = M / BM; nN = N / BM; nwg = nM * nN; G = G_; c = c_; }
    __host__ __device__ bool next(int i, Unit& u) const {
        const long L = (long)i * G + c; if (L >= nwg) return false;
        int wgid = (int)L; { const int q = nwg / NXCD, r = nwg % NXCD, xcd = wgid % NXCD, off = wgid / NXCD; wgid = (xcd < r ? xcd * (q + 1) : r * (q + 1) + (xcd - r) * q) + off; }
        const int nig = WGM * nN, gid = wgid / nig, fm = gid * WGM, gsz = (nM - fm) < WGM ? (nM - fm) : WGM;
        u.pm = fm + ((wgid % nig) % gsz); u.pn = (wgid % nig) / gsz; return true;
    }
    __device__ __forceinline__ void a_ready(const Unit&) const {}
    __device__ __forceinline__ void done(const Unit&) const {}
};

__device__ __forceinline__ unsigned cvt_pk_bf16(float lo, float hi) { unsigned r; asm volatile("v_cvt_pk_bf16_f32 %0, %1, %2" : "=v"(r) : "v"(lo), "v"(hi)); return r; }
template <class Epi, class Sched, bool ALIGN_EPI = false, bool SP2 = false>
__device__ __forceinline__ void gemm_phase(PG8_LAS unsigned char* lds, const Gemm g, const Sched& S, const Epi& E, int g_wid) {
    int tid_o = (g_wid << 6) | lane_id(); const int tid = tid_o, wid = __builtin_amdgcn_readfirstlane(tid >> 6), lane = tid & 63, wr = wid >> 2, wc = wid & 3, fr = lane & 15, fq = lane >> 4;
    const int K = g.K, nt = K / BK;
    unsigned voffA[2], voffB[2];
#pragma unroll
    for (int i = 0; i < 2; ++i) { int R, C; stage_rc(tid * 16 + i * 8192, R, C); const int Rb = Epi::PERM ? ((R & ~31) + perm32(R & 31)) : R;
        voffA[i] = (unsigned)(R * K + C) * 2u; voffB[i] = (unsigned)(Rb * K + C) * 2u; }
    const size_t kstep = (size_t)(BK * 2);
    const size_t hstep = (size_t)HALF * K * 2;
    const size_t tstep = 2 * hstep;
    const unsigned ldsw = (unsigned)wid * 1024u;
    const int aoff = lds_byte(wr * 64 + fr, fq * 8), boff = lds_byte(wc * 32 + fr, fq * 8);
#define PG8_SA(b, h) (((b) * 2 + (h)) * HTB)
#define PG8_SB(b, h) ((4 + (b) * 2 + (h)) * HTB)
#define PG8_STAGE(bufoff, gbase, voff) do { _Pragma("unroll") for (int _i = 0; _i < 2; ++_i) \
        __builtin_amdgcn_global_load_lds((const unsigned*)((const char*)(gbase) + (voff)[_i]), (PG8_LAS unsigned*)(lds + (bufoff) + ldsw + _i * 8192), 16, 0, 0); } while (0)
#define PG8_LDA(dst, b, h) do { _Pragma("unroll") for (int m = 0; m < 4; ++m) _Pragma("unroll") for (int k = 0; k < 2; ++k) dst[m][k] = *(const PG8_LAS bf16x8*)(lds + PG8_SA(b, h) + aoff + m * 2048 + k * 1024); } while (0)
#define PG8_LDB(dst, b, h) do { _Pragma("unroll") for (int n = 0; n < 2; ++n) _Pragma("unroll") for (int k = 0; k < 2; ++k) dst[n][k] = *(const PG8_LAS bf16x8*)(lds + PG8_SB(b, h) + boff + n * 2048 + k * 1024); } while (0)
#define PG8_MMA(ai, bj, At, Bt) do { __builtin_amdgcn_s_setprio(1); _Pragma("unroll") for (int m = 0; m < 4; ++m) _Pragma("unroll") for (int n = 0; n < 2; ++n) _Pragma("unroll") for (int k = 0; k < 2; ++k) \
        acc[ai][bj][m][n] = __builtin_amdgcn_mfma_f32_16x16x32_bf16(Bt[n][k], At[m][k], acc[ai][bj][m][n], 0, 0, 0); __builtin_amdgcn_s_setprio(0); } while (0)
#define PG8_WAIT_V(n) asm volatile("s_waitcnt vmcnt(" #n ")" ::: "memory")
#define PG8_WAIT_L(n) asm volatile("s_waitcnt lgkmcnt(" #n ")" ::: "memory")
#define PG8_BAR __builtin_amdgcn_s_barrier()
#define PG8_SCHED __builtin_amdgcn_sched_barrier(0)
    Unit cur, nxt; int ui = 0;
    if (!S.next(0, cur)) return;
    f32x4 acc[2][2][4][2];
#pragma unroll
    for (int a = 0; a < 2; ++a)
#pragma unroll
        for (int b = 0; b < 2; ++b)
#pragma unroll
            for (int m = 0; m < 4; ++m)
#pragma unroll
                for (int n = 0; n < 2; ++n) acc[a][b][m][n] = (f32x4){0.f, 0.f, 0.f, 0.f};
    bf16x8 At[4][2], B0[2][2], B1[2][2];
    const char* cA = (const char*)g.A + (size_t)cur.pm * tstep; const char* cB = (const char*)g.Bt + (size_t)cur.pn * tstep;
    S.a_ready(cur);
    if constexpr (SP2) {
        PG8_STAGE(PG8_SB(0, 0), cB, voffB); PG8_STAGE(PG8_SB(0, 1), cB + hstep, voffB); PG8_STAGE(PG8_SA(0, 0), cA, voffA); PG8_STAGE(PG8_SA(0, 1), cA + hstep, voffA);
        if (wr == 1) PG8_BAR;
        PG8_WAIT_V(2); PG8_BAR;
        PG8_STAGE(PG8_SB(1, 0), cB + kstep, voffB); PG8_STAGE(PG8_SA(1, 0), cA + kstep, voffA); PG8_STAGE(PG8_SB(1, 1), cB + hstep + kstep, voffB);
        PG8_WAIT_V(6); PG8_BAR;
    } else {
        PG8_STAGE(PG8_SB(0, 0), cB, voffB); PG8_STAGE(PG8_SA(0, 0), cA, voffA); PG8_STAGE(PG8_SB(0, 1), cB + hstep, voffB); PG8_STAGE(PG8_SA(0, 1), cA + hstep, voffA);
        if (wr == 1) PG8_BAR;
        PG8_WAIT_V(4); PG8_BAR;
        PG8_STAGE(PG8_SB(1, 0), cB + kstep, voffB); PG8_STAGE(PG8_SA(1, 0), cA + kstep, voffA); PG8_STAGE(PG8_SB(1, 1), cB + hstep + kstep, voffB);
        PG8_WAIT_V(6); PG8_BAR;
    }
    for (;;) {
        const bool has_next = S.next(ui + 1, nxt);
        const char* nA = has_next ? (const char*)g.A + (size_t)nxt.pm * tstep : cA; const char* nB = has_next ? (const char*)g.Bt + (size_t)nxt.pn * tstep : cB;
        for (int t = 0; t < nt; t += 2) {
            const bool last = (t == nt - 2);
            const char* a1 = cA + (size_t)(t + 1) * kstep;
            const char* a2 = last ? nA : cA + (size_t)(t + 2) * kstep; const char* b2 = last ? nB : cB + (size_t)(t + 2) * kstep;
            const char* a3 = a2 + kstep; const char* b3 = b2 + kstep;
            if (last && has_next) S.a_ready(nxt);
            if constexpr (SP2) {
            PG8_LDB(B0, 0, 0); PG8_LDB(B1, 0, 1); PG8_SCHED; PG8_LDA(At, 0, 0); PG8_STAGE(PG8_SA(1, 1), a1 + hstep, voffA);
            PG8_WAIT_V(8); PG8_WAIT_L(0); PG8_BAR; PG8_MMA(0, 0, At, B0); PG8_MMA(0, 1, At, B1); PG8_BAR; PG8_SCHED;
            PG8_LDA(At, 0, 1); PG8_STAGE(PG8_SB(0, 0), b2, voffB); PG8_STAGE(PG8_SB(0, 1), b2 + hstep, voffB); PG8_STAGE(PG8_SA(0, 0), a2, voffA);
            PG8_WAIT_V(8); PG8_WAIT_L(0); PG8_BAR; PG8_MMA(1, 0, At, B0); PG8_MMA(1, 1, At, B1); PG8_BAR; PG8_SCHED;
            PG8_LDB(B0, 1, 0); PG8_LDB(B1, 1, 1); PG8_SCHED; PG8_LDA(At, 1, 0); PG8_STAGE(PG8_SA(0, 1), a2 + hstep, voffA);
            PG8_WAIT_V(8); PG8_WAIT_L(0); PG8_BAR; PG8_MMA(0, 0, At, B0); PG8_MMA(0, 1, At, B1); PG8_BAR; PG8_SCHED;
            PG8_LDA(At, 1, 1); PG8_STAGE(PG8_SB(1, 0), b3, voffB); PG8_STAGE(PG8_SB(1, 1), b3 + hstep, voffB); PG8_STAGE(PG8_SA(1, 0), a3, voffA);
            PG8_WAIT_V(8); PG8_WAIT_L(0); PG8_BAR; PG8_MMA(1, 0, At, B0); PG8_MMA(1, 1, At, B1); PG8_BAR; PG8_SCHED;
            } else {
            PG8_LDB(B0, 0, 0); PG8_SCHED; PG8_LDA(At, 0, 0); PG8_STAGE(PG8_SA(1, 1), a1 + hstep, voffA);
            PG8_WAIT_L(8); PG8_BAR; PG8_WAIT_L(0); PG8_MMA(0, 0, At, B0); PG8_BAR; PG8_SCHED;
            PG8_LDB(B1, 0, 1); PG8_STAGE(PG8_SB(0, 0), b2, voffB);
            PG8_BAR; PG8_WAIT_L(0); PG8_MMA(0, 1, At, B1); PG8_BAR;
            PG8_LDA(At, 0, 1); PG8_STAGE(PG8_SA(0, 0), a2, voffA);
            PG8_BAR; PG8_WAIT_L(0); PG8_MMA(1, 0, At, B0); PG8_BAR; PG8_SCHED;
            PG8_STAGE(PG8_SB(0, 1), b2 + hstep, voffB);
            PG8_WAIT_V(6); PG8_BAR; PG8_MMA(1, 1, At, B1); PG8_BAR;
            PG8_LDB(B0, 1, 0); PG8_SCHED; PG8_LDA(At, 1, 0); PG8_STAGE(PG8_SA(0, 1), a2 + hstep, voffA);
            PG8_WAIT_L(8); PG8_BAR; PG8_WAIT_L(0); PG8_MMA(0, 0, At, B0); PG8_BAR; PG8_SCHED;
            PG8_LDB(B1, 1, 1); PG8_STAGE(PG8_SB(1, 0), b3, voffB);
            PG8_BAR; PG8_WAIT_L(0); PG8_MMA(0, 1, At, B1); PG8_BAR;
            PG8_LDA(At, 1, 1); PG8_STAGE(PG8_SA(1, 0), a3, voffA);
            PG8_BAR; PG8_WAIT_L(0); PG8_MMA(1, 0, At, B0); PG8_BAR; PG8_SCHED;
            PG8_STAGE(PG8_SB(1, 1), b3 + hstep, voffB);
            PG8_WAIT_V(6); PG8_BAR; PG8_MMA(1, 1, At, B1); PG8_BAR;
            }
        }
        if constexpr (ALIGN_EPI) { if (wr == 0) PG8_BAR; }
        if constexpr (!Epi::AFTER_DRAIN) { const int le_ = lane_id(); E(acc, cur, wr, wc, le_ & 15, le_ >> 4); S.done(cur); }
        if (!has_next) break;
#pragma unroll
        for (int a = 0; a < 2; ++a)
#pragma unroll
            for (int b = 0; b < 2; ++b)
#pragma unroll
                for (int m = 0; m < 4; ++m)
#pragma unroll
                    for (int n = 0; n < 2; ++n) acc[a][b][m][n] = (f32x4){0.f, 0.f, 0.f, 0.f};
        cur = nxt; cA = nA; cB = nB; ++ui;
        if constexpr (ALIGN_EPI) { if (wr == 1) PG8_BAR; }
    }
    PG8_WAIT_V(0);
    if constexpr (!ALIGN_EPI) { if (wr == 0) PG8_BAR; }
    PG8_BAR;
    if constexpr (Epi::AFTER_DRAIN) { E.fused(acc, cur, wr, wc, fr, fq, lds, wid, lane); S.done(cur); }
#undef PG8_SA
#undef PG8_SB
#undef PG8_STAGE
#undef PG8_LDA
#undef PG8_LDB
#undef PG8_MMA
#undef PG8_WAIT_V
#undef PG8_WAIT_L
#undef PG8_BAR
#undef PG8_SCHED
}
}
using pg8::bf16_t; using pg8::bf16x8; using pg8::f32x4; using pg8::u32x4;
#define LAS __attribute__((address_space(3)))
typedef float f32x16 __attribute__((ext_vector_type(16)));
typedef float f32x2 __attribute__((ext_vector_type(2)));
typedef unsigned u32x2 __attribute__((ext_vector_type(2)));
typedef short v4i16_t __attribute__((ext_vector_type(4)));

constexpr int SEQ = 8192, MREAL = 16384, MALLOC = 16448, DM = 1024, NTHR = 512;
constexpr float EPS = 1e-6f, LOG2E = 1.4426950408889634f;
constexpr size_t R1K = (size_t)MALLOC * 1024 * 2;
constexpr size_t al64k(size_t x) { return (x + 65535) & ~(size_t)65535; }
constexpr size_t WS_CTL = 0, CTL_BYTES = 65536;
constexpr size_t WS_ROPE = CTL_BYTES;
constexpr size_t WS_SSQ = al64k(WS_ROPE + (size_t)8208 * 16 * 8);
constexpr size_t WS_SSQQ = al64k(WS_SSQ + (size_t)MALLOC * 16 * 4);
constexpr size_t WS_SSQKV = al64k(WS_SSQQ + (size_t)MALLOC * 4 * 4);
constexpr size_t WS_XMETA = al64k(WS_SSQKV + (size_t)MALLOC * 4 * 4);
constexpr size_t WS_KR = al64k(WS_XMETA + 65536);
constexpr size_t WS_W = al64k(WS_KR + (size_t)MALLOC * 32 * 2);
constexpr size_t WO_IN = 0, WO_GA = 2097152, WO_GB = 3145728, WO_Q = 4194304, WO_KV = 4390912, WO_A = 4521984, WO_B = 5046272, WO_O = 5570560, WO_UP = 6619136, WO_DN = 10813440, W_ELEMS = 15007744;
constexpr size_t WS_XB = al64k(WS_W + W_ELEMS * 2);
constexpr size_t WS_POOL = al64k(WS_XB + R1K);
constexpr size_t PO_S = 0;
constexpr size_t PO_QA = PO_S, PO_KVA = PO_S + (size_t)MALLOC * 256 * 2;
constexpr size_t PO_AO = R1K, PO_DN = R1K + R1K / 2;
constexpr size_t PO_DQ = 2 * R1K, PO_DK = 2 * R1K + R1K / 2, PO_DV = 3 * R1K, PO_Q = 3 * R1K + R1K / 2, PO_KV = 4 * R1K + R1K / 4;
constexpr size_t PO_YQ = 2 * R1K;
constexpr size_t PO_H = 0;
constexpr size_t WS_END = WS_POOL + 5 * R1K + R1K / 4;
static_assert(WS_END <= (size_t)256 * 1024 * 1024, "workspace map exceeds 256 MiB");

struct Params {
    const float* in[21]; float* out; unsigned char* ws;
};

typedef const Params __attribute__((address_space(4)))* kparams_t;
__device__ __forceinline__ kparams_t kparams() { kparams_t p = (kparams_t)__builtin_amdgcn_kernarg_segment_ptr(); asm volatile("" : "+s"(p)); return p; }
#define KPAR kparams()
__device__ __forceinline__ unsigned cvt_pk(float lo, float hi) { return pg8::cvt_pk_bf16(lo, hi); }
__device__ __forceinline__ u32x2 pk4(f32x4 v) { u32x2 r; r.x = cvt_pk(v[0], v[1]); r.y = cvt_pk(v[2], v[3]); return r; }
__device__ __forceinline__ float bf2f(unsigned short b) { return __uint_as_float((unsigned)b << 16); }
__device__ __forceinline__ f32x4 ld_bf4(const bf16_t* p) { const u32x2 w = *(const u32x2*)p; return (f32x4){__uint_as_float(w.x << 16), __uint_as_float(w.x & 0xffff0000u), __uint_as_float(w.y << 16), __uint_as_float(w.y & 0xffff0000u)}; }
__device__ __forceinline__ u32x4 pk8(f32x4 a, f32x4 b) { const u32x2 x = pk4(a), y = pk4(b); return (u32x4){x.x, x.y, y.x, y.y}; }
__device__ __forceinline__ void ld_bf8(const bf16_t* p, f32x4& a, f32x4& b) { const u32x4 w = *(const u32x4*)p;
    a = (f32x4){__uint_as_float(w.x << 16), __uint_as_float(w.x & 0xffff0000u), __uint_as_float(w.y << 16), __uint_as_float(w.y & 0xffff0000u)};
    b = (f32x4){__uint_as_float(w.z << 16), __uint_as_float(w.z & 0xffff0000u), __uint_as_float(w.w << 16), __uint_as_float(w.w & 0xffff0000u)}; }
__device__ __forceinline__ float sum4v(f32x4 a) { return (a[0] + a[1]) + (a[2] + a[3]); }
__device__ __forceinline__ float sumsq4(f32x4 a) { return (a[0] * a[0] + a[1] * a[1]) + (a[2] * a[2] + a[3] * a[3]); }
__device__ __forceinline__ float sum16p(const float* p) { const f32x4* q = (const f32x4*)p; return (sum4v(q[0]) + sum4v(q[1])) + (sum4v(q[2]) + sum4v(q[3])); }
__device__ __forceinline__ float sum4p(const float* p) { return sum4v(*(const f32x4*)p); }
__device__ __forceinline__ float shx(float v, int mask) { const int l = lane_id(); return __int_as_float(__builtin_amdgcn_ds_bpermute((l ^ mask) << 2, __float_as_int(v))); }
__device__ __forceinline__ float half_max(float v) { const auto rr = __builtin_amdgcn_permlane32_swap(__float_as_uint(v), __float_as_uint(v), false, false); return fmaxf(__uint_as_float(rr[0]), __uint_as_float(rr[1])); }
__device__ __forceinline__ float half_sum(float v) { const auto rr = __builtin_amdgcn_permlane32_swap(__float_as_uint(v), __float_as_uint(v), false, false); return __uint_as_float(rr[0]) + __uint_as_float(rr[1]); }
__device__ __forceinline__ float wave_sum(float v) {
#pragma unroll
    for (int o = 1; o < 64; o <<= 1) v += shx(v, o);
    return v;
}
__device__ __forceinline__ float fq_sum(float s) {
    { const auto rr = __builtin_amdgcn_permlane16_swap(__float_as_uint(s), __float_as_uint(s), false, false); s = __uint_as_float(rr[0]) + __uint_as_float(rr[1]); }
    { const auto rr = __builtin_amdgcn_permlane32_swap(__float_as_uint(s), __float_as_uint(s), false, false); s = __uint_as_float(rr[0]) + __uint_as_float(rr[1]); }
    return s; }
__device__ __forceinline__ int tok_pos(int row) { return row < MREAL ? 16 + (row & (SEQ - 1)) : row - MREAL; }
__device__ __forceinline__ float sigmoidf_(float z) { return __builtin_amdgcn_rcpf(1.0f + __builtin_amdgcn_exp2f(-LOG2E * z)); }

struct REWin {
    static constexpr bool PERM = false; static constexpr int NP = 16, FENCE = 0, KMAX = 1; const float* ssq; unsigned* kmax_word; __device__ __forceinline__ const float* nsrc() const { return ssq; } bf16_t *QA, *KVA, *KR, *DQ, *DK, *DVv; float *ssqq, *ssqkv; const f32x2* rope;
    __device__ __forceinline__ void row(int row, int pn, int wc, int fq, f32x4 (&v)[2][2], float rstd) const {
#pragma unroll
        for (int bj = 0; bj < 2; ++bj)
#pragma unroll
            for (int n = 0; n < 2; ++n) v[bj][n] = v[bj][n] * rstd;
        const int cw = 32 * wc + 4 * fq;
        if (pn == 0) {
            float s = 0.f;
#pragma unroll
            for (int bj = 0; bj < 2; ++bj)
#pragma unroll
                for (int n = 0; n < 2; ++n) { *(u32x2*)(QA + (size_t)row * 256 + 128 * bj + cw + 16 * n) = pk4(v[bj][n]); s += sumsq4(v[bj][n]); }
            s = fq_sum(s); if (fq == 0) ssqq[(size_t)row * 4 + wc] = s;
        } else if (pn == 1) {
            float s = 0.f;
#pragma unroll
            for (int n = 0; n < 2; ++n) { *(u32x2*)(KVA + (size_t)row * 128 + cw + 16 * n) = pk4(v[0][n]); s += sumsq4(v[0][n]); }
            s = fq_sum(s); if (fq == 0) ssqkv[(size_t)row * 4 + wc] = s;
            if (wc == 0) {
                const f32x2* t = rope + (size_t)tok_pos(row) * 16 + 4 * fq; f32x4 a, b;
#pragma unroll
                for (int i = 0; i < 4; ++i) { const f32x2 cs = t[i]; a[i] = v[1][0][i] * cs.x - v[1][1][i] * cs.y; b[i] = v[1][0][i] * cs.y + v[1][1][i] * cs.x; }
                *(u32x2*)(KR + (size_t)row * 32 + 4 * fq) = pk4(a); *(u32x2*)(KR + (size_t)row * 32 + 16 + 4 * fq) = pk4(b);
            }
        } else {
            bf16_t* dst = DQ + (size_t)((pn - 2) >> 1) * ((size_t)MALLOC * 512); const float sc = pn < 4 ? 0.125f * LOG2E : 1.0f; const int c0 = (pn & 1) * 256;
#pragma unroll
            for (int bj = 0; bj < 2; ++bj)
#pragma unroll
                for (int n = 0; n < 2; ++n) *(u32x2*)(dst + (size_t)row * 512 + c0 + 128 * bj + cw + 16 * n) = pk4(v[bj][n] * sc);
        }
    }
};
struct REQup {
    static constexpr bool PERM = false; static constexpr int NP = 4, FENCE = 0, KMAX = 0; const float* ssqq; bf16_t* Q; const f32x2* rope; __device__ __forceinline__ const float* nsrc() const { return ssqq; }
    __device__ __forceinline__ void row(int row, int pn, int wc, int fq, f32x4 (&v)[2][2], float rstd) const {
        const float sc = rstd * (0.10206207261596577f * LOG2E);
#pragma unroll
        for (int bj = 0; bj < 2; ++bj) {
            const int g32 = 256 * pn + 128 * bj + 32 * wc; f32x4 a = v[bj][0] * sc, b = v[bj][1] * sc;
            if ((g32 % 96) == 64) {
                const f32x2* t = rope + (size_t)tok_pos(row) * 16 + 4 * fq; f32x4 a2, b2;
#pragma unroll
                for (int i = 0; i < 4; ++i) { const f32x2 cs = t[i]; a2[i] = a[i] * cs.x - b[i] * cs.y; b2[i] = a[i] * cs.y + b[i] * cs.x; }
                a = a2; b = b2;
            }
            *(u32x2*)(Q + (size_t)row * 768 + g32 + 4 * fq) = pk4(a); *(u32x2*)(Q + (size_t)row * 768 + g32 + 16 + 4 * fq) = pk4(b);
        }
    }
};
struct REKVup {
    static constexpr bool PERM = true; static constexpr int NP = 4, FENCE = 0, KMAX = 0; const float* ssqkv; bf16_t* KV; __device__ __forceinline__ const float* nsrc() const { return ssqkv; }
    __device__ __forceinline__ void row(int row, int pn, int wc, int fq, f32x4 (&v)[2][2], float rstd) const {
        const float sc = rstd;
#pragma unroll
        for (int bj = 0; bj < 2; ++bj) *(u32x4*)(KV + (size_t)row * 1024 + 256 * pn + 128 * bj + 32 * wc + 8 * fq) = pk8(v[bj][0] * sc, v[bj][1] * sc);
    }
};
struct REStore {
    static constexpr bool PERM = true; static constexpr int NP = 0, FENCE = 0, KMAX = 0; bf16_t* O; __device__ __forceinline__ const float* nsrc() const { return nullptr; }
    __device__ __forceinline__ void row(int row, int pn, int wc, int fq, f32x4 (&v)[2][2], float rstd) const {
#pragma unroll
        for (int bj = 0; bj < 2; ++bj) *(u32x4*)(O + (size_t)row * 1024 + 256 * pn + 128 * bj + 32 * wc + 8 * fq) = pk8(v[bj][0], v[bj][1]);
    }
};
struct REGate {
    static constexpr bool PERM = true; static constexpr int NP = 16, FENCE = 1, KMAX = 0; const float* ssq; const float* bias; bf16_t* Y; const bf16_t* T; int add; __device__ __forceinline__ const float* nsrc() const { return ssq; }
    __device__ __forceinline__ void row(int row, int pn, int wc, int fq, f32x4 (&v)[2][2], float rstd) const {
#pragma unroll
        for (int bj = 0; bj < 2; ++bj) {
            const int col = 256 * pn + 128 * bj + 32 * wc + 8 * fq; const f32x4 b0 = *(const f32x4*)(bias + col), b1 = *(const f32x4*)(bias + col + 4);
            f32x4 g0, g1;
#pragma unroll
            for (int i = 0; i < 4; ++i) { g0[i] = sigmoidf_(v[bj][0][i] * rstd + b0[i]); g1[i] = sigmoidf_(v[bj][1][i] * rstd + b1[i]); }
            bf16_t* yp = Y + (size_t)row * 1024 + col; f32x4 y0, y1; ld_bf8(yp, y0, y1);
            f32x4 r0, r1; if (add) { f32x4 t0, t1; ld_bf8(T + (size_t)row * 1024 + col, t0, t1); r0 = y0 + g0 * t0; r1 = y1 + g1 * t1; } else { r0 = g0 * y0; r1 = g1 * y1; }
            *(u32x4*)yp = pk8(r0, r1);
        }
    }
};
struct REResid {
    static constexpr bool PERM = true; static constexpr int NP = 0, FENCE = 1, KMAX = 0; const float* base_main; const float* base_meta; float* out_main; float* out_meta; bf16_t* XB; float* ssq; __device__ __forceinline__ const float* nsrc() const { return nullptr; }
    __device__ __forceinline__ void row(int row, int pn, int wc, int fq, f32x4 (&v)[2][2], float rstd) const {
        const float* bp = row < MREAL ? base_main + (size_t)row * 1024 : base_meta + (size_t)(row - MREAL) * 1024;
        float* op = row < MREAL ? out_main + (size_t)row * 1024 : out_meta + (size_t)(row - MREAL) * 1024;
        float s = 0.f;
#pragma unroll
        for (int bj = 0; bj < 2; ++bj) {
            const int col = 256 * pn + 128 * bj + 32 * wc + 8 * fq;
            const f32x4 x0 = *(const f32x4*)(bp + col) + v[bj][0], x1 = *(const f32x4*)(bp + col + 4) + v[bj][1];
            *(f32x4*)(op + col) = x0; *(f32x4*)(op + col + 4) = x1; if (XB) *(u32x4*)(XB + (size_t)row * 1024 + col) = pk8(x0, x1); s += sumsq4(x0) + sumsq4(x1);
        }
        s = fq_sum(s); if (fq == 0) ssq[(size_t)row * 16 + pn * 4 + wc] = s;
    }
};
struct REUp {
    static constexpr bool PERM = true; static constexpr int NP = 16, FENCE = 0, KMAX = 0; const float* ssq; bf16_t* H; __device__ __forceinline__ const float* nsrc() const { return ssq; }
    __device__ __forceinline__ void row(int row, int pn, int wc, int fq, f32x4 (&v)[2][2], float rstd) const {
#pragma unroll
        for (int bj = 0; bj < 2; ++bj) { f32x4 t0 = v[bj][0] * rstd, t1 = v[bj][1] * rstd;
#pragma unroll
            for (int i = 0; i < 4; ++i) { const float r0 = fmaxf(t0[i], 0.f), r1 = fmaxf(t1[i], 0.f); t0[i] = r0 * r0; t1[i] = r1 * r1; }
            *(u32x4*)(H + (size_t)row * 4096 + 256 * pn + 128 * bj + 32 * wc + 8 * fq) = pk8(t0, t1); }
    }
};
template <int NP> __device__ __forceinline__ float row_part(const float* p, int row, int fq) {
    if (NP == 16) return sum4v(*(const f32x4*)(p + (size_t)row * 16 + 4 * fq));
    if (NP == 4) return p[(size_t)row * 4 + fq];
    return 0.f;
}
template <int NP> __device__ __forceinline__ float row_rstd(float part) {
    if (NP == 0) return 1.0f;
    const float tot = fq_sum(part);
    return rsqrtf(tot * (NP == 16 ? (1.0f / 1024.0f) : 1.0f) + EPS);
}
template <class RE> struct EpiRows {
    static constexpr bool PERM = RE::PERM, AFTER_DRAIN = false; RE e; float inv_n;
    __device__ __forceinline__ void operator()(const f32x4 (&acc)[2][2][4][2], const pg8::Unit& u, int wr, int wc, int fr, int fq) const {
        float rs[2][4];
        if (RE::NP != 0) {
            const float* ns = e.nsrc(); float part[2][4];
#pragma unroll
            for (int ai = 0; ai < 2; ++ai)
#pragma unroll
                for (int m = 0; m < 4; ++m) part[ai][m] = row_part<RE::NP>(ns, u.pm * 256 + ai * 128 + wr * 64 + m * 16 + fr, fq);
#pragma unroll
            for (int ai = 0; ai < 2; ++ai)
#pragma unroll
                for (int m = 0; m < 4; ++m) rs[ai][m] = rsqrtf(fq_sum(part[ai][m]) * inv_n + EPS);
        }
#pragma unroll
        for (int ai = 0; ai < 2; ++ai)
#pragma unroll
            for (int m = 0; m < 4; ++m) { f32x4 v[2][2] = {{acc[ai][0][m][0], acc[ai][0][m][1]}, {acc[ai][1][m][0], acc[ai][1][m][1]}};
                e.row(u.pm * 256 + ai * 128 + wr * 64 + m * 16 + fr, u.pn, wc, fq, v, RE::NP != 0 ? rs[ai][m] : 1.0f);
                if (RE::FENCE && (m & 1)) asm volatile("" ::: "memory"); }
        if constexpr (RE::KMAX != 0) { if (u.pn == 4 || u.pn == 5) {
            float kmx = 0.f;
#pragma unroll
            for (int ai = 0; ai < 2; ++ai)
#pragma unroll
                for (int m = 0; m < 4; ++m)
#pragma unroll
                    for (int bj = 0; bj < 2; ++bj) kmx = fmaxf(kmx, fq_sum(sumsq4(acc[ai][bj][m][0]) + sumsq4(acc[ai][bj][m][1])) * rs[ai][m] * rs[ai][m]);
#pragma unroll
            for (int o = 1; o < 16; o <<= 1) kmx = fmaxf(kmx, shx(kmx, o));
            if (lane_id() == 0) atomicMax(e.kmax_word, __float_as_uint(kmx)); } }
    }
};
template <class RE> __device__ __forceinline__ void meta_gemm(LAS unsigned char* lds, const bf16_t* A, const bf16_t* Bt, int N, int K, const RE& e, float inv_n, int g_wid) {
    int tid_o = (g_wid << 6) | lane_id(); const int tid = tid_o, wid = tid >> 6, lane = tid & 63, fr = lane & 15, fq = lane >> 4;
    const bf16_t* A16 = A + (size_t)MREAL * K;
    for (int u = blockIdx.x; u < N / 64; u += gridDim.x) {
        const int pn = u >> 2, wc = u & 3;
        f32x4 acc[2][2];
#pragma unroll
        for (int bj = 0; bj < 2; ++bj)
#pragma unroll
            for (int n = 0; n < 2; ++n) acc[bj][n] = (f32x4){0.f, 0.f, 0.f, 0.f};
        const int nst = K >= 256 ? K / 256 : 1, nwv = K >= 256 ? 8 : K / 32;
#pragma unroll 4
        for (int s = 0; s < (wid < nwv ? nst : 0); ++s) {
            const int k0 = (wid * nst + s) * 32 + 8 * fq;
            const bf16x8 a = *(const bf16x8*)(A16 + (size_t)fr * K + k0);
#pragma unroll
            for (int bj = 0; bj < 2; ++bj)
#pragma unroll
                for (int n = 0; n < 2; ++n) { const bf16x8 b = *(const bf16x8*)(Bt + (size_t)(256 * pn + 128 * bj + 32 * wc + (RE::PERM ? 8 * (fr >> 2) + 4 * n + (fr & 3) : 16 * n + fr)) * K + k0);
                    acc[bj][n] = __builtin_amdgcn_mfma_f32_16x16x32_bf16(b, a, acc[bj][n], 0, 0, 0); }
        }
        LAS f32x4* red = (LAS f32x4*)lds;
#pragma unroll
        for (int bj = 0; bj < 2; ++bj)
#pragma unroll
            for (int n = 0; n < 2; ++n) red[(wid * 4 + bj * 2 + n) * 64 + lane] = acc[bj][n];
        __syncthreads();
        if (wid == 0) {
            f32x4 v[2][2];
#pragma unroll
            for (int bj = 0; bj < 2; ++bj)
#pragma unroll
                for (int n = 0; n < 2; ++n) { f32x4 s = red[(bj * 2 + n) * 64 + lane];
#pragma unroll
                    for (int w = 1; w < 8; ++w) s = s + red[(w * 4 + bj * 2 + n) * 64 + lane];
                    v[bj][n] = s; }
            float rstd = 1.0f;
            if (RE::NP != 0) rstd = rsqrtf(fq_sum(row_part<RE::NP>(e.nsrc(), MREAL + fr, fq)) * inv_n + EPS);
            e.row(MREAL + fr, pn, wc, fq, v, rstd);
            if constexpr (RE::KMAX != 0) { if (pn == 4 || pn == 5) { float kmx = 0.f;
#pragma unroll
                for (int bj = 0; bj < 2; ++bj) kmx = fmaxf(kmx, fq_sum(sumsq4(v[bj][0]) + sumsq4(v[bj][1])));
#pragma unroll
                for (int o = 1; o < 16; o <<= 1) kmx = fmaxf(kmx, shx(kmx, o));
                if (lane == 0) atomicMax(e.kmax_word, __float_as_uint(kmx)); } }
        }
        __syncthreads();
    }
}
template <class RE> __device__ __forceinline__ void gemm_all(LAS unsigned char* lds, const bf16_t* A, const bf16_t* Bt, int N, int K, const RE& e, bool do_meta, int g_wid) {
    asm volatile("" : "+s"(A), "+s"(Bt));
    if (do_meta) meta_gemm<RE>(lds, A, Bt, N, K, e, 1.0f / (float)K, g_wid);
    pg8::Gemm g{A, Bt, MREAL, N, K}; pg8::StaticOrder S; S.init(MREAL, N, (int)gridDim.x, (int)blockIdx.x);
    EpiRows<RE> E{e, 1.0f / (float)K};
    pg8::gemm_phase<EpiRows<RE>, pg8::StaticOrder, true, true>(lds, g, S, E, g_wid);
}

__device__ __forceinline__ unsigned f2bf(float f) { unsigned u = __float_as_uint(f); return (u + 0x7fffu + ((u >> 16) & 1u)) >> 16; }
__device__ __forceinline__ unsigned pk2(float lo, float hi) { return f2bf(lo) | (f2bf(hi) << 16); }
__device__ __forceinline__ void transpose_item(const float* W, int ldw, int K, int col0, int ncolblk, bf16_t* WT, int row0, const float* gain, int gmask, float gscale, LAS float* scr, int item, int lane) {
    const int kb = item / ncolblk, nb = item % ncolblk, k0 = 64 * kb, n0 = 32 * nb;
#pragma unroll
    for (int i = 0; i < 8; ++i) { const int kk = 8 * i + (lane >> 3), c4 = (lane & 7) * 4; const float g = gain ? gain[(k0 + kk) & gmask] * gscale : 1.0f;
        const f32x4 w4 = *(const f32x4*)(W + (size_t)(k0 + kk) * ldw + col0 + n0 + c4);
        LAS float* d = scr + kk * 33 + c4; d[0] = w4[0] * g; d[1] = w4[1] * g; d[2] = w4[2] * g; d[3] = w4[3] * g; }
    asm volatile("s_waitcnt lgkmcnt(0)" ::: "memory");
    const int c = lane & 7;
#pragma unroll
    for (int j = 0; j < 4; ++j) { const int n = (lane >> 3) + 8 * j; const LAS float* s = scr + (8 * c) * 33 + n;
        u32x4 o; o.x = pk2(s[0 * 33], s[1 * 33]); o.y = pk2(s[2 * 33], s[3 * 33]); o.z = pk2(s[4 * 33], s[5 * 33]); o.w = pk2(s[6 * 33], s[7 * 33]);
        *(u32x4*)(WT + (size_t)(row0 + n0 + n) * K + k0 + 8 * c) = o; }
    asm volatile("s_waitcnt lgkmcnt(0)" ::: "memory");
}
__device__ __forceinline__ void convert_weights(const Params& P, int l, LAS unsigned char* lds, int g_wid) {
    int tid_o = (g_wid << 6) | lane_id(); const int tid = tid_o, wid = tid >> 6, lane = tid & 63;
    LAS float* scr = (LAS float*)(lds + wid * 16384);
    bf16_t* W = (bf16_t*)(KPAR->ws + WS_W);
    const float* w_in = KPAR->in[3] + (size_t)l * 1024 * 4000; const float* attn_norm = KPAR->in[2] + l * 1024;
    const float* w_q = KPAR->in[6] + (size_t)l * 256 * 768; const float* qn = KPAR->in[5] + l * 256;
    const float* w_kv = KPAR->in[8] + (size_t)l * 128 * 1024; const float* kvn = KPAR->in[7] + l * 128;
    const float* w_a = KPAR->in[14] + (size_t)l * 512 * 1024; const float* w_b = KPAR->in[15] + (size_t)l * 512 * 1024; const float* subln = KPAR->in[13] + l * 128;
    const float* w_o = KPAR->in[16] + (size_t)l * 1024 * 1024; const float* mlpn = KPAR->in[17] + l * 1024;
    const float* w_up = KPAR->in[18] + (size_t)l * 1024 * 4096; const float* w_dn = KPAR->in[19] + (size_t)l * 4096 * 1024;
    const float lam_scale = 1.0f - (l == 0 ? 0.2f : 0.35550907f);
    const int gw = blockIdx.x * 8 + wid, NGW = gridDim.x * 8;
    constexpr int NITEMS = 208 + 768 + 512 + 512 + 96 + 64 + 256 + 256 + 512 + 2048 + 2048;
    for (int it = gw; it < NITEMS; it += NGW) {
        int r = it;
        if (r < 208) { transpose_item(w_in, 4000, 1024, 0, 13, W + WO_IN, 0, attn_norm, 1023, 1.f, scr, r, lane); continue; } r -= 208;
        if (r < 768) { transpose_item(w_in, 4000, 1024, 416, 48, W + WO_IN, 512, attn_norm, 1023, 1.f, scr, r, lane); continue; } r -= 768;
        if (r < 512) { transpose_item(w_in, 4000, 1024, 1952, 32, W + WO_GA, 0, attn_norm, 1023, 1.f, scr, r, lane); continue; } r -= 512;
        if (r < 512) { transpose_item(w_in, 4000, 1024, 2976, 32, W + WO_GB, 0, attn_norm, 1023, 1.f, scr, r, lane); continue; } r -= 512;
        if (r < 96) { transpose_item(w_q, 768, 256, 0, 24, W + WO_Q, 0, qn, 255, 1.f, scr, r, lane); continue; } r -= 96;
        if (r < 64) { transpose_item(w_kv, 1024, 128, 0, 32, W + WO_KV, 0, kvn, 127, 1.f, scr, r, lane); continue; } r -= 64;
        if (r < 256) { transpose_item(w_a, 1024, 512, 0, 32, W + WO_A, 0, nullptr, 0, 1.f, scr, r, lane); continue; } r -= 256;
        if (r < 256) { transpose_item(w_b, 1024, 512, 0, 32, W + WO_B, 0, subln, 127, lam_scale, scr, r, lane); continue; } r -= 256;
        if (r < 512) { transpose_item(w_o, 1024, 1024, 0, 32, W + WO_O, 0, nullptr, 0, 1.f, scr, r, lane); continue; } r -= 512;
        if (r < 2048) { transpose_item(w_up, 4096, 1024, 0, 128, W + WO_UP, 0, mlpn, 1023, 1.f, scr, r, lane); continue; } r -= 2048;
        transpose_item(w_dn, 1024, 4096, 0, 32, W + WO_DN, 0, nullptr, 0, 1.f, scr, r, lane);
    }
}
__device__ __forceinline__ void prologue_x(const Params& P, int g_wid) {
    int tid_o = (g_wid << 6) | lane_id(); const int tid = tid_o, wid = tid >> 6, lane = tid & 63;
    const int gw = blockIdx.x * 8 + wid, NGW = gridDim.x * 8;
    bf16_t* XB = (bf16_t*)(KPAR->ws + WS_XB); float* ssq = (float*)(KPAR->ws + WS_SSQ);
    for (int row = gw; row < MREAL + 16; row += NGW) {
        const float* src = row < MREAL ? KPAR->in[0] + (size_t)row * 1024 : KPAR->in[1] + (size_t)(row - MREAL) * 1024;
        float s = 0.f;
#pragma unroll
        for (int j = 0; j < 2; ++j) { const f32x4 v0 = ((const f32x4*)src)[128 * j + 2 * lane], v1 = ((const f32x4*)src)[128 * j + 2 * lane + 1]; s += sumsq4(v0) + sumsq4(v1); ((u32x4*)(XB + (size_t)row * 1024))[64 * j + lane] = pk8(v0, v1); }
        s = wave_sum(s);
        if (lane < 16) ssq[(size_t)row * 16 + lane] = lane == 0 ? s : 0.f;
    }
    { bf16_t* W = (bf16_t*)(KPAR->ws + WS_W);
      for (int i = blockIdx.x * NTHR + tid; i < 96 * 1024 / 8; i += gridDim.x * NTHR) ((u32x4*)(W + WO_IN + 416 * 1024))[i] = (u32x4){0u, 0u, 0u, 0u}; }
    f32x2* rope = (f32x2*)(KPAR->ws + WS_ROPE);
    for (int e = blockIdx.x * NTHR + tid; e < 8208 * 16; e += gridDim.x * NTHR) {
        const int pos = e >> 4, i = e & 15, i4 = i & 3, i16 = i >> 2;
        const float c4 = i4 == 0 ? 1.0f : (i4 == 1 ? 0.56234132519f : (i4 == 2 ? 0.31622776602f : 0.17782794100f));
        const float s16 = i16 == 0 ? 1.0f : (i16 == 1 ? 0.1f : (i16 == 2 ? 0.01f : 0.001f));
        const float inv = c4 * s16; const float ang = (float)pos * inv;
        const double x = (double)ang; const double nq = __builtin_rint(x * 0.63661977236758134308); const double r = __builtin_fma(-nq, 1.57079632679489661923, x);
        const double r2 = r * r;
        const double sn = r * (1.0 + r2 * (-1.0 / 6 + r2 * (1.0 / 120 + r2 * (-1.0 / 5040 + r2 * (1.0 / 362880 + r2 * (-1.0 / 39916800 + r2 * (1.0 / 6227020800.0)))))));
        const double cs = 1.0 + r2 * (-0.5 + r2 * (1.0 / 24 + r2 * (-1.0 / 720 + r2 * (1.0 / 40320 + r2 * (-1.0 / 3628800 + r2 * (1.0 / 479001600.0 + r2 * (-1.0 / 87178291200.0)))))));
        const int q = ((int)nq) & 3;
        const double c = q == 0 ? cs : (q == 1 ? -sn : (q == 2 ? -cs : sn));
        const double s = q == 0 ? sn : (q == 1 ? cs : (q == 2 ? -sn : -cs));
        rope[e] = (f32x2){(float)c, (float)s};
    }
}
constexpr int AT_KBUF = 12288, AT_VBUF = 16384, AT_K = 0, AT_V = 2 * AT_KBUF, AT_ASC = AT_V + 3 * AT_VBUF, AT_QW = AT_ASC + 1024;
__device__ __forceinline__ int crow(int r, int hi) { return (r & 3) + 8 * (r >> 2) + 4 * hi; }
#define MFMA32(a, b, c) __builtin_amdgcn_mfma_f32_32x32x16_bf16((a), (b), (c), 0, 0, 0)
template <int DQK, int DV, bool ALIBI>
__device__ __forceinline__ void attn_pass(LAS unsigned char* lds, const bf16_t* Qp, int qpitch, const bf16_t* K1, int k1pitch, const bf16_t* K2, int k2pitch,
                                          const bf16_t* Vp, int vpitch, int brow0, int NT, int qreal0, int meta, float sl2, float kmax, f32x16 (&o)[DV / 32], int g_wid) {
    constexpr int NCH = DQK / 8, NDS = DQK / 16, NDB = DV / 32, VCH = DV / 8, KP = (64 * NCH + 511) / 512, VP = (64 * VCH) / 512;
    int tid_o = (g_wid << 6) | lane_id(); const int tid = tid_o, lane = tid & 63, wid = __builtin_amdgcn_readfirstlane(tid >> 6), r32 = lane & 31, hi = lane >> 5;
    bf16x8 qf[NDS];
    { const bf16_t* qrow = Qp + (size_t)(32 * wid + r32) * qpitch + 8 * hi;
#pragma unroll
      for (int ds = 0; ds < NDS; ++ds) qf[ds] = *(const bf16x8*)(qrow + 16 * ds); }
    const bf16_t* ksrc[KP]; int kpit[KP]; unsigned kdst[KP]; bool kval[KP];
#pragma unroll
    for (int i = 0; i < KP; ++i) { const int p = tid + 512 * i; kval[i] = p < 64 * NCH; const int pp = kval[i] ? p : 0; const int key = pp / NCH, c = pp % NCH;
        if (NCH <= 8 || c < 8) { ksrc[i] = K1 + (size_t)key * k1pitch + c * 8; kpit[i] = k1pitch; } else { ksrc[i] = K2 + (size_t)key * k2pitch + (c - 8) * 8; kpit[i] = k2pitch; }
        kdst[i] = AT_K + c * 1024 + ((key ^ c) << 4); }
    const bf16_t* vsrc[VP]; unsigned vdst[VP];
#pragma unroll
    for (int i = 0; i < VP; ++i) { const int p = tid + 512 * i; const int key = p / VCH, c = p % VCH; vsrc[i] = Vp + (size_t)key * vpitch + c * 8; vdst[i] = AT_V + (c >> 2) * 4096 + key * 64 + (c & 3) * 16; }
    u32x4 kregA[KP], vregA[VP];
#define AT_ISSUE(t, KR_, VR_) do { const size_t kb_ = (size_t)((t) == 0 ? MREAL : brow0 + 64 * ((t) - 1)); \
        _Pragma("unroll") for (int i = 0; i < KP; ++i) if (kval[i]) KR_[i] = *(const u32x4*)(ksrc[i] + kb_ * kpit[i]); \
        _Pragma("unroll") for (int i = 0; i < VP; ++i) VR_[i] = *(const u32x4*)(vsrc[i] + kb_ * vpitch); } while (0)
#define AT_COMMIT(kbuf, vslot, KR_, VR_) do { \
        _Pragma("unroll") for (int i = 0; i < KP; ++i) if (kval[i]) *(LAS u32x4*)(lds + kdst[i] + (kbuf) * AT_KBUF) = KR_[i]; \
        _Pragma("unroll") for (int i = 0; i < VP; ++i) *(LAS u32x4*)(lds + vdst[i] + (vslot)) = VR_[i]; } while (0)
#define AT_BAR() asm volatile("s_waitcnt lgkmcnt(0)\n\ts_barrier" ::: "memory")
#define SB() __builtin_amdgcn_sched_barrier(0)
    unsigned kaddr[NDS];
#pragma unroll
    for (int ds = 0; ds < NDS; ++ds) { const int cx = 2 * ds + hi; kaddr[ds] = AT_K + cx * 1024 + ((r32 ^ cx) << 4); }
    const unsigned vb = AT_V + ((lane >> 4) & 1) * 32 + (lane & 3) * 8 + (4 * hi + ((lane & 15) >> 2)) * 64;
    LAS float* asc = (LAS float*)(lds + AT_ASC) + wid * 32;
    float m_ref = 0.f, l = 0.f;
    f32x16 negm;
#pragma unroll
    for (int r = 0; r < 16; ++r) negm[r] = 0.f;
#pragma unroll
    for (int db = 0; db < NDB; ++db)
#pragma unroll
        for (int r = 0; r < 16; ++r) o[db][r] = 0.f;
    const int qw0 = 32 * wid, qrow_l = qw0 + r32;
    bf16x8 pa[4];
    bool resc = false;
#define P_CINIT(t) do { \
        if (ALIBI) { const int kpos0 = (t) == 0 ? 0 : 16 + 64 * ((t) - 1), qpos0 = meta ? 0 : 16 + qreal0; const float tb = sl2x * (float)(kpos0 - qpos0 + 4 * hix) - m_ref; \
            _Pragma("unroll") for (int r = 0; r < 16; ++r) { c0[r] = tb + sl2x * (float)((r & 3) + 8 * (r >> 2)); c1[r] = c0[r] + 32.0f * sl2x; } } \
        else { c0 = negm; c1 = negm; } } while (0)
#define P_KREAD(kb) do { _Pragma("unroll") for (int ds = 0; ds < NDS; ++ds) { kf0[ds] = *(const LAS bf16x8*)(lds + kaddr[ds] + (kb) * AT_KBUF); kf1[ds] = *(const LAS bf16x8*)(lds + kaddr[ds] + (kb) * AT_KBUF + 512); } } while (0)
#define P_QK() do { __builtin_amdgcn_s_setprio(1); _Pragma("unroll") for (int ds = 0; ds < NDS; ++ds) { c0 = MFMA32(kf0[ds], qf[ds], c0); c1 = MFMA32(kf1[ds], qf[ds], c1); } __builtin_amdgcn_s_setprio(0); } while (0)
#define P_VREAD(vsp, dg) do { _Pragma("unroll") for (int d2 = 0; d2 < 2; ++d2) _Pragma("unroll") for (int ks = 0; ks < 4; ++ks) { \
            const LAS unsigned char* vp_ = lds + vb + (vsp) + ((dg) + d2) * 4096 + ks * 1024; \
            vlo[d2][ks] = __builtin_amdgcn_ds_read_tr16_b64_v4i16((LAS v4i16_t*)vp_); vhh[d2][ks] = __builtin_amdgcn_ds_read_tr16_b64_v4i16((LAS v4i16_t*)(vp_ + 512)); } } while (0)
#define P_PV(dg, ksa) do { __builtin_amdgcn_s_setprio(1); _Pragma("unroll") for (int ks = (ksa); ks < (ksa) + 2; ++ks) _Pragma("unroll") for (int d2 = 0; d2 < 2; ++d2) { \
            const bf16x8 vf_ = __builtin_shufflevector(vlo[d2][ks], vhh[d2][ks], 0, 1, 2, 3, 4, 5, 6, 7); o[(dg) + d2] = MFMA32(pa[ks], vf_, o[(dg) + d2]); } __builtin_amdgcn_s_setprio(0); } while (0)
#define P_MASKMAX(t) do { \
        int lim; if ((t) == 0) lim = meta ? (qrow_l < 15 ? qrow_l : 15) : 15; else lim = qreal0 + qrow_l - 64 * ((t) - 1); \
        if (__any(lim < 63)) { \
            _Pragma("unroll") for (int r = 0; r < 16; ++r) { const int kidx = crow(r, hix); if (kidx > lim) c0[r] = -INFINITY; if (kidx + 32 > lim) c1[r] = -INFINITY; } } \
        float mx = fmaxf(c0[0], c1[0]); \
        _Pragma("unroll") for (int r = 1; r < 16; ++r) mx = fmaxf(fmaxf(mx, c0[r]), c1[r]); \
        mx = half_max(mx); \
        if ((t) == 0 || __any(mx > 90.0f)) { \
            const float dl = (t) == 0 ? mx : fmaxf(mx, 0.f); \
            m_ref += dl; \
            _Pragma("unroll") for (int r = 0; r < 16; ++r) { c0[r] -= dl; c1[r] -= dl; negm[r] = -m_ref; } \
            if ((t) != 0) { const float alpha = __builtin_amdgcn_exp2f(-dl); l *= alpha; if (hi == 0) asc[r32] = alpha; resc = true; } \
        } } while (0)
#define P_EXP0() do { _Pragma("unroll") for (int r = 0; r < 16; ++r) c0[r] = __builtin_amdgcn_exp2f(c0[r]); } while (0)
#define P_EXP1SUM() do { float rs0 = 0.f, rs1 = 0.f; \
        _Pragma("unroll") for (int r = 0; r < 16; ++r) { c1[r] = __builtin_amdgcn_exp2f(c1[r]); rs0 += c0[r]; rs1 += c1[r]; } l += rs0 + rs1; } while (0)
#define P_PACK() do { _Pragma("unroll") for (int s = 0; s < 2; ++s) { u32x4 w0, w1; \
        _Pragma("unroll") for (int j = 0; j < 4; ++j) { w0[j] = cvt_pk(c0[8 * s + 2 * j], c0[8 * s + 2 * j + 1]); w1[j] = cvt_pk(c1[8 * s + 2 * j], c1[8 * s + 2 * j + 1]); } \
        pa[s] = __builtin_bit_cast(bf16x8, w0); pa[2 + s] = __builtin_bit_cast(bf16x8, w1); } } while (0)
#define P_RESC() do { if (resc) { resc = false; \
        _Pragma("unroll") for (int g = 0; g < 4; ++g) { const f32x4 a4 = *(const LAS f32x4*)(asc + 8 * g + 4 * hi); \
            _Pragma("unroll") for (int db = 0; db < NDB; ++db) _Pragma("unroll") for (int i = 0; i < 4; ++i) o[db][4 * g + i] *= a4[i]; } } } while (0)
#define AT_OPAQUE() float sl2x = sl2; int hix = hi; asm volatile("" : "+v"(sl2x), "+v"(hix))
    int skip = 0;
    if (ALIBI && !meta && NT > 6) {
        const bf16_t* krow = K1 + (size_t)(brow0 + qreal0 + 32 * wid + r32) * k1pitch + 8 * hi;
        float dot = 0.f, qn2 = 0.f;
#pragma unroll
        for (int ds = 0; ds < NDS; ++ds) { const bf16x8 kk = *(const bf16x8*)(krow + 16 * ds);
#pragma unroll
            for (int j = 0; j < 8; ++j) { const float qv = bf2f((unsigned short)qf[ds][j]), kv = bf2f((unsigned short)kk[j]); dot += qv * kv; qn2 += qv * qv; } }
        dot = half_sum(dot); qn2 = half_sum(qn2);
        float T = dot + sl2 * (float)(32 * wid + r32) - sqrtf(qn2) * kmax - 0.5f;
#pragma unroll
        for (int o2 = 1; o2 < 32; o2 <<= 1) T = fminf(T, shx(T, o2));
        LAS float* tm = (LAS float*)(lds + AT_ASC);
        if (lane == 0) tm[32 * wid] = T;
        AT_BAR();
        float Tmin = tm[0];
#pragma unroll
        for (int w = 1; w < 8; ++w) Tmin = fminf(Tmin, tm[32 * w]);
        const float X = ((Tmin - 48.0f) / sl2 + (float)(qreal0 + 1)) * (1.0f / 64.0f);
        int J = X > 2.0f ? (int)X - 1 : 0;
        J = J < NT - 5 ? J : NT - 5;
        skip = __builtin_amdgcn_readfirstlane(J > 0 ? J : 0);
        NT -= skip;
    }
#define TJ(t) ((t) == 0 ? 0 : (t) + skip)
    int vs_prev = 0, vs_cur = AT_VBUF, vs_next = 2 * AT_VBUF;
    AT_ISSUE(0, kregA, vregA); AT_COMMIT(0, 0, kregA, vregA);
    AT_BAR();
    {
        f32x16 c0, c1; bf16x8 kf0[NDS], kf1[NDS]; AT_OPAQUE();
        if (NT > 1) AT_ISSUE(TJ(1), kregA, vregA);
        P_CINIT(0); P_KREAD(0); SB(); P_QK(); SB(); P_MASKMAX(0); P_EXP0(); P_EXP1SUM(); P_PACK();
        if (NT > 1) AT_COMMIT(1, vs_cur, kregA, vregA);
        AT_BAR();
    }
#define WAVE_HAS(j) ((j) == 0 || 64 * ((j) - 1) <= qreal0 + qw0 + 31)
    const int NT1 = (meta || NT < 5) ? NT : NT - 3;
    for (int t = 1; t < NT1; ++t) {
        f32x16 c0, c1; bf16x8 kf0[NDS], kf1[NDS]; v4i16_t vlo[2][4], vhh[2][4]; AT_OPAQUE();
        const int kb = t & 1;
        if (t + 1 < NT) AT_ISSUE(TJ(t + 1), kregA, vregA);
        P_RESC();
        P_CINIT(TJ(t)); P_KREAD(kb); SB();
        P_QK(); SB(); P_VREAD(vs_prev, 0); SB(); P_PV(0, 0); SB();
        P_MASKMAX(TJ(t)); SB();
        P_PV(0, 2); SB(); if (NDB == 4) P_VREAD(vs_prev, 2); SB();
        P_EXP0(); SB();
        if (NDB == 4) P_PV(2, 0); SB();
        P_EXP1SUM(); SB();
        if (NDB == 4) P_PV(2, 2); SB();
        P_PACK();
        if (t + 1 < NT) AT_COMMIT(kb ^ 1, vs_next, kregA, vregA);
        AT_BAR();
        const int tmp_ = vs_prev; vs_prev = vs_cur; vs_cur = vs_next; vs_next = tmp_;
    }
    for (int t = NT1; t < NT; ++t) {
        const int kb = t & 1;
        if (t + 1 < NT) AT_ISSUE(TJ(t + 1), kregA, vregA);
        if (WAVE_HAS(TJ(t - 1))) {
            v4i16_t vlo[2][4], vhh[2][4];
            P_RESC();
            P_VREAD(vs_prev, 0); SB(); P_PV(0, 0); P_PV(0, 2); SB();
            if (NDB == 4) { P_VREAD(vs_prev, 2); SB(); P_PV(2, 0); P_PV(2, 2); SB(); }
        }
        if (WAVE_HAS(TJ(t))) {
            f32x16 c0, c1; bf16x8 kf0[NDS], kf1[NDS]; AT_OPAQUE();
            P_CINIT(TJ(t)); P_KREAD(kb); SB(); P_QK(); SB(); P_MASKMAX(TJ(t)); P_EXP0(); P_EXP1SUM(); P_PACK();
        }
        if (t + 1 < NT) AT_COMMIT(kb ^ 1, vs_next, kregA, vregA);
        AT_BAR();
        const int tmp_ = vs_prev; vs_prev = vs_cur; vs_cur = vs_next; vs_next = tmp_;
    }
    {
        if (WAVE_HAS(TJ(NT - 1))) {
            v4i16_t vlo[2][4], vhh[2][4];
            P_RESC();
            P_VREAD(vs_prev, 0); SB(); P_PV(0, 0); P_PV(0, 2); SB();
            if (NDB == 4) { P_VREAD(vs_prev, 2); SB(); P_PV(2, 0); P_PV(2, 2); SB(); }
        }
        AT_BAR();
    }
#undef WAVE_HAS
    l = half_sum(l);
    const float inv = 1.0f / l;
    if (hi == 0) asc[r32] = inv;
#pragma unroll
    for (int g = 0; g < 4; ++g) { const f32x4 a4 = *(const LAS f32x4*)(asc + 8 * g + 4 * hi);
#pragma unroll
        for (int db = 0; db < NDB; ++db)
#pragma unroll
            for (int i = 0; i < 4; ++i) o[db][4 * g + i] *= a4[i]; }
#undef AT_ISSUE
#undef AT_COMMIT
#undef AT_BAR
#undef SB
#undef P_CINIT
#undef P_KREAD
#undef P_QK
#undef P_VREAD
#undef P_PV
#undef P_MASKMAX
#undef P_EXP0
#undef P_EXP1SUM
#undef P_PACK
#undef P_RESC
#undef AT_OPAQUE
#undef TJ
}
template <int NDB> __device__ __forceinline__ void store_rows16(LAS unsigned char* lds, const f32x16 (&o)[NDB], const float (&scl)[16], bf16_t* dst  , int ld, int meta, int wid, int lane) {
    constexpr int PITCH = NDB * 64 + 16, CH = NDB * 4;
    static_assert(8 * 32 * PITCH <= AT_ASC, "output staging overlaps the softmax scratch");
    const int r32 = lane & 31, hi = lane >> 5;
    LAS unsigned char* st = lds + wid * (32 * PITCH);
#pragma unroll
    for (int r = 0; r < 16; ++r)
#pragma unroll
        for (int db = 0; db < NDB; ++db) *(LAS bf16_t*)(st + crow(r, hi) * PITCH + (db * 32 + r32) * 2) = (bf16_t)f2bf(o[db][r] * scl[r]);
#pragma unroll
    for (int k = 0; k < NDB * 2; ++k) { const int id = lane + 64 * k, row = id / CH, ch = id % CH;
        const u32x4 vv = *(const LAS u32x4*)(st + row * PITCH + ch * 16);
        if (!meta || 32 * wid + row < 16) *(u32x4*)(dst + (size_t)(32 * wid + row) * ld + ch * 8) = vv; }
}
__device__ __forceinline__ void attn_unit_mla(const Params& P, LAS unsigned char* lds, int b, int h, int qb, int meta, int g_wid) {
    const bf16_t* Q = (const bf16_t*)(KPAR->ws + WS_POOL + PO_Q); const bf16_t* KV = (const bf16_t*)(KPAR->ws + WS_POOL + PO_KV); const bf16_t* KR = (const bf16_t*)(KPAR->ws + WS_KR);
    bf16_t* AO = (bf16_t*)(KPAR->ws + WS_POOL + PO_AO);
    int tid_o = (g_wid << 6) | lane_id(); const int tid = tid_o, lane = tid & 63, wid = tid >> 6, r32 = lane & 31, hi = lane >> 5;
    const int row0 = meta ? MREAL : b * SEQ + 256 * qb, NT = meta ? 1 : 1 + 4 * (qb + 1);
    f32x16 o[2];
    attn_pass<96, 64, false>(lds, Q + (size_t)row0 * 768 + h * 96, 768, KV + h * 128, 1024, KR, 32, KV + h * 128 + 64, 1024, b * SEQ, NT, 256 * qb, meta, 0.f, 0.f, o, g_wid);
    float one[16];
#pragma unroll
    for (int r = 0; r < 16; ++r) one[r] = 1.0f;
    (void)r32; (void)hi;
    store_rows16<2>(lds, o, one, AO + (size_t)row0 * 512 + h * 64, 512, meta, wid, lane);
}
__device__ __forceinline__ void attn_unit_diff(const Params& P, LAS unsigned char* lds, int b, int h, int qb, int meta, int map, int l, float lam, float kmax, int g_wid) {
    const bf16_t* DQ = (const bf16_t*)(KPAR->ws + WS_POOL + PO_DQ); const bf16_t* DK = (const bf16_t*)(KPAR->ws + WS_POOL + PO_DK); const bf16_t* DVv = (const bf16_t*)(KPAR->ws + WS_POOL + PO_DV);
    const int row0 = meta ? MREAL : b * SEQ + 256 * qb, NT = meta ? 1 : 1 + 4 * (qb + 1);
    const float sl2 = LOG2E * (h == 0 ? 0.25f : (h == 1 ? 0.0625f : (h == 2 ? 0.015625f : 0.00390625f)));
    f32x16 o[4];
    attn_pass<64, 128, true>(lds, DQ + (size_t)row0 * 512 + h * 128 + 64 * map, 512, DK + h * 128 + 64 * map, 512, nullptr, 0, DVv + h * 128, 512, b * SEQ, NT, 256 * qb, meta, sl2, kmax, o, g_wid);
    const int unit = meta ? 256 + h : ((b * 4 + h) * 32 + qb);
    unsigned* cw = (unsigned*)(KPAR->ws + WS_CTL) + 8192 + l * 1024 + unit * 2;
    const int tid = (g_wid << 6) | lane_id(), lane = tid & 63, wid = tid >> 6, r32 = lane & 31, hi = lane >> 5;
    float* st4 = (float*)(KPAR->ws + WS_POOL + PO_S) + (meta ? (size_t)256 * 32768 + (size_t)h * 4096 : (size_t)unit * 32768) + (size_t)tid * 64;
    const bool parks = !meta || wid == 0;
    static_assert((size_t)256 * 131072 + 4 * 16384 <= R1K, "parking slots exceed the S region");
    if (tid == 0) *(LAS unsigned*)(lds + AT_QW + 64) = __hip_atomic_fetch_add(cw, 1u, __ATOMIC_RELAXED, __HIP_MEMORY_SCOPE_AGENT);
    __syncthreads();
    const unsigned first = *(LAS unsigned*)(lds + AT_QW + 64) == 0u;
    if (first) {
#pragma unroll
        for (int db = 0; db < 4; ++db)
#pragma unroll
            for (int g = 0; g < 4; ++g) if (parks) ((f32x4*)st4)[db * 4 + g] = (f32x4){o[db][4 * g], o[db][4 * g + 1], o[db][4 * g + 2], o[db][4 * g + 3]};
        asm volatile("s_waitcnt vmcnt(0)" ::: "memory");
        __syncthreads();
        if (tid == 0) { __builtin_amdgcn_fence(__ATOMIC_RELEASE, "agent"); asm volatile("s_waitcnt vmcnt(0)" ::: "memory");
                        __hip_atomic_store(cw + 1, 1u, __ATOMIC_RELAXED, __HIP_MEMORY_SCOPE_AGENT); }
        return;
    }
    if (tid == 0) { while (__hip_atomic_load(cw + 1, __ATOMIC_RELAXED, __HIP_MEMORY_SCOPE_AGENT) == 0u) __builtin_amdgcn_s_sleep(2);
                    __builtin_amdgcn_fence(__ATOMIC_ACQUIRE, "agent"); asm volatile("s_waitcnt vmcnt(0)" ::: "memory"); }
    __syncthreads();
    bf16_t* DN = (bf16_t*)(KPAR->ws + WS_POOL + PO_DN);
    const float ca = map == 0 ? 1.0f : -lam, cb = map == 0 ? -lam : 1.0f;
#pragma unroll
    for (int db = 0; db < 4; ++db)
#pragma unroll
        for (int g = 0; g < 4; ++g) { f32x4 s4 = (f32x4){0.f, 0.f, 0.f, 0.f}; if (parks) s4 = __builtin_nontemporal_load((const f32x4*)st4 + db * 4 + g);
#pragma unroll
            for (int i = 0; i < 4; ++i) o[db][4 * g + i] = map == 0 ? (o[db][4 * g + i] - lam * s4[i]) : (s4[i] - lam * o[db][4 * g + i]); }
    (void)ca; (void)cb;
    float rs[16];
#pragma unroll
    for (int r = 0; r < 16; ++r) {
        float ss = (o[0][r] * o[0][r] + o[1][r] * o[1][r]) + (o[2][r] * o[2][r] + o[3][r] * o[3][r]);
        ss += shx(ss, 1); ss += shx(ss, 2); ss += shx(ss, 4); ss += shx(ss, 8); ss += shx(ss, 16);
        rs[r] = rsqrtf(ss * (1.0f / 128.0f) + EPS);
    }
    (void)r32; (void)hi;
    store_rows16<4>(lds, o, rs, DN + (size_t)row0 * 512 + h * 128, 512, meta, wid, lane);
}
__device__ __forceinline__ void attn_phase(const Params& P, LAS unsigned char* lds, int lc, int g_wid) {
    const int l = lc & 1;
    int tid_o = (g_wid << 6) | lane_id(); const int tid = tid_o, lane = tid & 63;
    const float s1 = wave_sum(KPAR->in[9][l * 64 + lane] * KPAR->in[10][l * 64 + lane]), s2 = wave_sum(KPAR->in[11][l * 64 + lane] * KPAR->in[12][l * 64 + lane]);
    const float lam = expf(s1) - expf(s2) + (l == 0 ? 0.2f : 0.35550907f);
    const float kmax = sqrtf(2.0f * __uint_as_float(__hip_atomic_load((unsigned*)(KPAR->ws + WS_CTL) + 3000 + 64 * l, __ATOMIC_RELAXED, __HIP_MEMORY_SCOPE_AGENT))) * 1.01f;
    const int xcc = (int)((unsigned)__builtin_amdgcn_s_getreg((3 << 11) | 20) & 7u);
    for (int qi = 0; qi < 8; ++qi) {
        const int q = (xcc + qi) & 7;
        unsigned* ctr = (unsigned*)(KPAR->ws + WS_CTL) + 64 * (lc * 8 + q);
        for (;;) {
            if (tid == 0) *(LAS unsigned*)(lds + AT_QW) = atomicAdd(ctr, 1u);
            __syncthreads();
            const int u = (int)*(LAS unsigned*)(lds + AT_QW);
            __syncthreads();
            if (u >= (l == 0 ? 130 : 128)) break;
            if (u < 128) { const int qb = 31 - (u >> 2), j = u & 3;
                if (j < 2) attn_unit_diff(P, lds, q >> 2, (qb & 1) ? 3 - (q & 3) : (q & 3), qb, 0, j, l, lam, kmax, g_wid);     else { const int s = q + 8 * (j - 2); attn_unit_mla(P, lds, s >> 3, s & 7, qb, 0, g_wid); }
            } else { const int m = q + 8 * (u - 128);
                if (m < 8) attn_unit_diff(P, lds, 0, m >> 1, 0, 1, m & 1, l, lam, kmax, g_wid); else attn_unit_mla(P, lds, 0, m - 8, 0, 1, g_wid); }
        }
    }
}
#define XB_TMO      128
#define XB_XCNT(j)  (256  + 64 * (j))
#define XB_XSUB(j)  (1280 + 64 * (j))
#define XB_XGEN(j)  (2304 + 64 * (j))
#define XB_TOP      3328
#define XB_TOPGEN   3392
#define XCD_BAR_WORDS 3456
#define XB_SPIN_CAP (1u << 18)

__device__ __forceinline__ unsigned xb_ld(unsigned* p)              { return __hip_atomic_load(p, __ATOMIC_RELAXED, __HIP_MEMORY_SCOPE_AGENT); }
__device__ __forceinline__ unsigned xb_add(unsigned* p, unsigned v) { return __hip_atomic_fetch_add(p, v, __ATOMIC_RELAXED, __HIP_MEMORY_SCOPE_AGENT); }
__device__ __forceinline__ unsigned xb_xcc_id() { return (unsigned)__builtin_amdgcn_s_getreg((3 << 11) | 20) & 0xFu; }
#define XB_SPIN(cond, bar) do { unsigned _sp = 0; while (cond) { __builtin_amdgcn_s_sleep(1); \
    if ((++_sp & 255u) == 0u) { if (xb_ld(&(bar)[XB_TMO])) break; if (_sp > XB_SPIN_CAP) { atomicAdd(&(bar)[XB_TMO], 1u); break; } } } } while (0)

struct XcdBarrier {
    unsigned* bar; unsigned x;
    volatile LAS unsigned* st;
};

__device__ __forceinline__ XcdBarrier xcd_barrier_post(unsigned* bar, volatile LAS unsigned* st, bool leader) {
    XcdBarrier b; b.bar = bar; b.x = xb_xcc_id(); b.st = st;
    if (leader) (void)xb_add(&bar[XB_XCNT(b.x)], 1u);
    return b;
}
__device__ __forceinline__ void xcd_barrier_complete(unsigned* bar, unsigned x, unsigned& nloc, unsigned& nx) {
    const unsigned G = gridDim.x * gridDim.y * gridDim.z;
    unsigned sum, cnt, mine, sp = 0u;
    for (;;) {
        sum = 0u; cnt = 0u; mine = 0u;
#pragma unroll
        for (unsigned j = 0; j < 16; ++j) { const unsigned c = xb_ld(&bar[XB_XCNT(j)]); sum += c; cnt += (c > 0u) ? 1u : 0u; mine = (j == x) ? c : mine; }
        if (sum == G) break;
        __builtin_amdgcn_s_sleep(1);
        if ((++sp & 255u) == 0u) { if (xb_ld(&bar[XB_TMO])) break; if (sp > XB_SPIN_CAP) { atomicAdd(&bar[XB_TMO], 1u); break; } }
    }
    nloc = mine > 0u ? mine : 1u; nx = cnt > 0u ? cnt : 1u;
}

__device__ __forceinline__ void xcd_barrier(const XcdBarrier& b, int g_wid) {
    asm volatile("s_waitcnt vmcnt(0)" ::: "memory");
    __syncthreads();
    if (g_wid == 0 && lane_id() == 0) {
        unsigned* bar = b.bar;
        __builtin_amdgcn_s_waitcnt(0);
        unsigned nloc = b.st[0], nx = b.st[1];
        if (nloc == 0u) { xcd_barrier_complete(bar, b.x, nloc, nx); b.st[0] = nloc; b.st[1] = nx; }
        const unsigned old = xb_add(&bar[XB_XSUB(b.x)], 1u);
        const unsigned gen = old / nloc;
        if (old + 1u == (gen + 1u) * nloc) {
            __builtin_amdgcn_fence(__ATOMIC_RELEASE, "agent");
            asm volatile("s_waitcnt vmcnt(0)" ::: "memory");
            const unsigned og = xb_add(&bar[XB_TOP], 1u);
            const unsigned tg = og / nx;
            if (og + 1u == (tg + 1u) * nx) xb_add(&bar[XB_TOPGEN], 1u);
            else XB_SPIN(xb_ld(&bar[XB_TOPGEN]) == tg, bar);
            __builtin_amdgcn_fence(__ATOMIC_ACQUIRE, "agent");
            xb_add(&bar[XB_XGEN(b.x)], 1u);
            asm volatile("s_waitcnt vmcnt(0)" ::: "memory");
        } else {
            XB_SPIN(xb_ld(&bar[XB_XGEN(b.x)]) == gen, bar);
            __builtin_amdgcn_fence(__ATOMIC_ACQUIRE, "agent");
            asm volatile("s_waitcnt vmcnt(0)" ::: "memory");
        }
    }
    __syncthreads();
}

constexpr int LDS_BYTES = 131072 + 1024;
__global__ void __launch_bounds__(512, 2) fwd_megakernel(Params P) {
    extern __shared__ __attribute__((aligned(16))) unsigned char lds_raw[];
    LAS unsigned char* lds = (LAS unsigned char*)lds_raw;
    const int g_wid = __builtin_amdgcn_readfirstlane(threadIdx.x >> 6);
    volatile LAS unsigned* xb_st = (volatile LAS unsigned*)(lds + 131072 + 64);
    if (g_wid == 0 && lane_id() < 2) xb_st[lane_id()] = 0u;
    __syncthreads();
    const XcdBarrier xbar = xcd_barrier_post((unsigned*)(KPAR->ws + WS_CTL) + 4096, xb_st, g_wid == 0 && lane_id() == 0);
#define GRID_SYNC() xcd_barrier(xbar, g_wid)
#define WSP unsigned char* ws = KPAR->ws; asm volatile("" : "+s"(ws)); unsigned char* pool = ws + WS_POOL; (void)pool
#define PW ((bf16_t*)(ws + WS_W))
#define PXB ((bf16_t*)(ws + WS_XB))
#define PSSQ ((float*)(ws + WS_SSQ))
#define PSSQQ ((float*)(ws + WS_SSQQ))
#define PSSQKV ((float*)(ws + WS_SSQKV))
#define PXMETA ((float*)(ws + WS_XMETA))
#define PROPE ((const f32x2*)(ws + WS_ROPE))
#define PKR ((bf16_t*)(ws + WS_KR))
#define PP(off) ((bf16_t*)(pool + (off)))
#ifndef PHM
#define PHM 0xffff
#endif
#if PHM & 1
    prologue_x(P, g_wid); convert_weights(P, 0, lds, g_wid);
#if defined(PROBE_DUP) && (PROBE_DUP & 1)
    convert_weights(P, 0, lds, g_wid);
#endif
#endif
    if (KPAR->ws == nullptr) cg::this_grid().sync();
    GRID_SYNC();
    for (int l = 0; l < 2; ++l) {
#if PHM & 1
        if (l == 1) { convert_weights(P, 1, lds, g_wid); GRID_SYNC(); }
#endif
        const bool m_all = (l == 0);
#if PHM & 2
        {
            WSP; gemm_all<REWin>(lds, PXB, PW + WO_IN, 2048, 1024, REWin{PSSQ, (unsigned*)(ws + WS_CTL) + 3000 + 64 * l, PP(PO_QA), PP(PO_KVA), PKR, PP(PO_DQ), PP(PO_DK), PP(PO_DV), PSSQQ, PSSQKV, PROPE}, true, g_wid);
        }
        GRID_SYNC();
#if defined(PROBE_DUP) && (PROBE_DUP & 2)
        {
            WSP; gemm_all<REWin>(lds, PXB, PW + WO_IN, 2048, 1024, REWin{PSSQ, (unsigned*)(ws + WS_CTL) + 3000 + 64 * l, PP(PO_QA), PP(PO_KVA), PKR, PP(PO_DQ), PP(PO_DK), PP(PO_DV), PSSQQ, PSSQKV, PROPE}, true, g_wid);
        }
        GRID_SYNC();
#endif
#endif
#if PHM & 4
        {
            WSP; gemm_all<REQup>(lds, PP(PO_QA), PW + WO_Q, 768, 256, REQup{PSSQQ, PP(PO_Q), PROPE}, m_all, g_wid);
        }
        {   WSP; gemm_all<REKVup>(lds, PP(PO_KVA), PW + WO_KV, 1024, 128, REKVup{PSSQKV, PP(PO_KV)}, true, g_wid); }
        GRID_SYNC();
#if defined(PROBE_DUP) && (PROBE_DUP & 4)
        {
            WSP; gemm_all<REQup>(lds, PP(PO_QA), PW + WO_Q, 768, 256, REQup{PSSQQ, PP(PO_Q), PROPE}, m_all, g_wid);
        }
        {   WSP; gemm_all<REKVup>(lds, PP(PO_KVA), PW + WO_KV, 1024, 128, REKVup{PSSQKV, PP(PO_KV)}, true, g_wid); }
        GRID_SYNC();
#endif
#endif
#if PHM & 8
        attn_phase(P, lds, l, g_wid);
#ifdef PROBE_ATTN2
        GRID_SYNC(); attn_phase(P, lds, l + 2, g_wid);
#endif
        GRID_SYNC();
#endif
#if PHM & 16
        {   WSP; gemm_all<REStore>(lds, PP(PO_AO), PW + WO_A, 1024, 512, REStore{PP(PO_S)}, m_all, g_wid); }
        {   WSP; gemm_all<REGate>(lds, PXB, PW + WO_GA, 1024, 1024, REGate{PSSQ, KPAR->in[4] + (size_t)l * 2048, PP(PO_S), nullptr, 0}, m_all, g_wid); }
        {   WSP; gemm_all<REStore>(lds, PP(PO_DN), PW + WO_B, 1024, 512, REStore{PP(PO_YQ)}, m_all, g_wid); }
        {   WSP; gemm_all<REGate>(lds, PXB, PW + WO_GB, 1024, 1024, REGate{PSSQ, KPAR->in[4] + (size_t)l * 2048 + 1024, PP(PO_S), PP(PO_YQ), 1}, m_all, g_wid); }
        GRID_SYNC();
#if defined(PROBE_DUP) && (PROBE_DUP & 16)
        {   WSP; gemm_all<REStore>(lds, PP(PO_AO), PW + WO_A, 1024, 512, REStore{PP(PO_S)}, m_all, g_wid); }
        {   WSP; gemm_all<REGate>(lds, PXB, PW + WO_GA, 1024, 1024, REGate{PSSQ, KPAR->in[4] + (size_t)l * 2048, PP(PO_S), nullptr, 0}, m_all, g_wid); }
        {   WSP; gemm_all<REStore>(lds, PP(PO_DN), PW + WO_B, 1024, 512, REStore{PP(PO_YQ)}, m_all, g_wid); }
        {   WSP; gemm_all<REGate>(lds, PXB, PW + WO_GB, 1024, 1024, REGate{PSSQ, KPAR->in[4] + (size_t)l * 2048 + 1024, PP(PO_S), PP(PO_YQ), 1}, m_all, g_wid); }
        GRID_SYNC();
#endif
#endif
#if PHM & 32
        {
            WSP; float* out = KPAR->out; gemm_all<REResid>(lds, PP(PO_S), PW + WO_O, 1024, 1024, REResid{l == 0 ? KPAR->in[0] : out, l == 0 ? KPAR->in[1] : PXMETA, out, PXMETA, PXB, PSSQ}, m_all, g_wid);
        }
        GRID_SYNC();
#endif
#if PHM & 64
        {
            WSP; gemm_all<REUp>(lds, PXB, PW + WO_UP, 4096, 1024, REUp{PSSQ, PP(PO_H)}, m_all, g_wid);
        }
        GRID_SYNC();
#if defined(PROBE_DUP) && (PROBE_DUP & 64)
        {
            WSP; gemm_all<REUp>(lds, PXB, PW + WO_UP, 4096, 1024, REUp{PSSQ, PP(PO_H)}, m_all, g_wid);
        }
        GRID_SYNC();
#endif
#endif
#if PHM & 128
        {
            WSP; float* out = KPAR->out; gemm_all<REResid>(lds, PP(PO_H), PW + WO_DN, 1024, 4096, REResid{out, PXMETA, out, PXMETA, l == 1 ? (bf16_t*)nullptr : PXB, PSSQ}, m_all, g_wid);
        }
        GRID_SYNC();
#endif
    }
    { int tid_o = (g_wid << 6) | lane_id(); const int tid = tid_o, wid = tid >> 6, lane = tid & 63; const float* g = KPAR->in[20]; WSP; float* ssq = PSSQ; float* out = KPAR->out;
      for (int row = blockIdx.x * 8 + wid; row < MREAL; row += gridDim.x * 8) {
          const float rstd = rsqrtf(sum16p(ssq + (size_t)row * 16) * (1.0f / 1024.0f) + EPS);
          f32x4* o4 = (f32x4*)(out + (size_t)row * 1024);
#pragma unroll
          for (int j = 0; j < 4; ++j) o4[64 * j + lane] = o4[64 * j + lane] * rstd * ((const f32x4*)g)[64 * j + lane];
      } }
}

extern "C" void kernel_launch(void* const* d_in, const int* in_sizes, int n_in, void* d_out, int out_size, void* d_ws, size_t ws_size, hipStream_t stream) {
    static int grid = 0;
    if (grid == 0) {
        if (n_in != 21 || ws_size < WS_END) { fprintf(stderr, "kernel_launch: unexpected inputs (n_in %d, ws %zu < %zu)\n", n_in, ws_size, (size_t)WS_END); grid = -1; return; }
        int dev = 0, cus = 0, per_cu = 0;
        (void)hipGetDevice(&dev); (void)hipDeviceGetAttribute(&cus, hipDeviceAttributeMultiprocessorCount, dev);
        (void)hipFuncSetAttribute((const void*)fwd_megakernel, hipFuncAttributeMaxDynamicSharedMemorySize, LDS_BYTES);
        (void)hipOccupancyMaxActiveBlocksPerMultiprocessor(&per_cu, (const void*)fwd_megakernel, 512, LDS_BYTES);
        if (per_cu < 1) per_cu = 1;
        grid = cus * per_cu; if (grid > 256) grid = 256;
        (void)hipGetLastError();
    }
    if (grid < 0) return;
    (void)hipMemsetAsync((char*)d_ws + WS_CTL, 0, CTL_BYTES, stream);
    Params p{};
    for (int i = 0; i < 21; ++i) p.in[i] = (const float*)d_in[i];
    p.out = (float*)d_out; p.ws = (unsigned char*)d_ws;
    void* args[] = {&p};
    hipError_t e = hipLaunchCooperativeKernel((const void*)fwd_megakernel, dim3(grid), dim3(512), args, LDS_BYTES, stream);
    if (e != hipSuccess) fprintf(stderr, "cooperative launch failed: %s (grid %d)\n", hipGetErrorString(e), grid);
}
```

```cpp
#include <hip/hip_runtime.h>
#include <hip/hip_cooperative_groups.h>
#include <cstdio>
#include <cstdint>
namespace cg = cooperative_groups;
__device__ __forceinline__ int lane_id() { int l; asm volatile("v_mbcnt_lo_u32_b32 %0, -1, 0\n\tv_mbcnt_hi_u32_b32 %0, -1, %0" : "=v"(l)); return l; }

namespace pg8 {
#define PG8_LAS __attribute__((address_space(3)))
typedef unsigned short bf16_t;
typedef short bf16x8 __attribute__((ext_vector_type(8)));
typedef float f32x4 __attribute__((ext_vector_type(4)));
typedef unsigned u32x4 __attribute__((ext_vector_type(4)));
constexpr int BM = 256, BK = 64, HALF = 128, HTB = HALF * BK * 2  , STAGE_BYTES = 8 * HTB, NXCD = 8, WGM = 8;

__host__ __device__ __forceinline__ int lds_byte(int r, int c) { const int st = (r >> 4) * 2 + (c >> 5), rr = r & 15, cc = c & 31, ob = rr * 64 + cc * 2; return st * 1024 + (ob ^ (((ob >> 9) & 1) << 5)); }
__host__ __device__ __forceinline__ void stage_rc(int b, int& R, int& C) { const int st = b / 1024, sb = b % 1024, swz = sb ^ (((sb >> 9) & 1) << 5); R = (st >> 1) * 16 + swz / 64; C = (st & 1) * 32 + (swz % 64) / 2; }
__host__ __device__ __forceinline__ int perm32(int rho) { const int n = rho >> 4, i = rho & 15; return 8 * (i >> 2) + 4 * n + (i & 3); }

struct Unit { int pm, pn; };
struct Gemm { const bf16_t* A; const bf16_t* Bt; int M, N, K; };

struct StaticOrder {
    int nM, nN, nwg, G, c;
    __host__ __device__ void init(int M, int N, int G_, int c_) { nM = M / BM; nN = N / BM; nwg = nM * nN; G = G_; c = c_; }
    __host__ __device__ bool next(int i, Unit& u) const {
        const long L = (long)i * G + c; if (L >= nwg) return false;
        int wgid = (int)L; { const int q = nwg / NXCD, r = nwg % NXCD, xcd = wgid % NXCD, off = wgid / NXCD; wgid = (xcd < r ? xcd * (q + 1) : r * (q + 1) + (xcd - r) * q) + off; }
        const int nig = WGM * nN, gid = wgid / nig, fm = gid * WGM, gsz = (nM - fm) < WGM ? (nM - fm) : WGM;
        u.pm = fm + ((wgid % nig) % gsz); u.pn = (wgid % nig) / gsz; return true;
    }
    __device__ __forceinline__ void a_ready(const Unit&) const {}
    __device__ __forceinline__ void done(const Unit&) const {}
};

__device__ __forceinline__ unsigned cvt_pk_bf16(float lo, float hi) { unsigned r; asm volatile("v_cvt_pk_bf16_f32 %0, %1, %2" : "=v"(r) : "v"(lo), "v"(hi)); return r; }
template <class Epi, class Sched, bool ALIGN_EPI = false, bool SP2 = false>
__device__ __forceinline__ void gemm_phase(PG8_LAS unsigned char* lds, const Gemm g, const Sched& S, const Epi& E, int g_wid) {
    int tid_o = (g_wid << 6) | lane_id(); const int tid = tid_o, wid = __builtin_amdgcn_readfirstlane(tid >> 6), lane = tid & 63, wr = wid >> 2, wc = wid & 3, fr = lane & 15, fq = lane >> 4;
    const int K = g.K, nt = K / BK;
    unsigned voffA[2], voffB[2];
#pragma unroll
    for (int i = 0; i < 2; ++i) { int R, C; stage_rc(tid * 16 + i * 8192, R, C); const int Rb = Epi::PERM ? ((R & ~31) + perm32(R & 31)) : R;
        voffA[i] = (unsigned)(R * K + C) * 2u; voffB[i] = (unsigned)(Rb * K + C) * 2u; }
    const size_t kstep = (size_t)(BK * 2);
    const size_t hstep = (size_t)HALF * K * 2;
    const size_t tstep = 2 * hstep;
    const unsigned ldsw = (unsigned)wid * 1024u;
    const int aoff = lds_byte(wr * 64 + fr, fq * 8), boff = lds_byte(wc * 32 + fr, fq * 8);
#define PG8_SA(b, h) (((b) * 2 + (h)) * HTB)
#define PG8_SB(b, h) ((4 + (b) * 2 + (h)) * HTB)
#define PG8_STAGE(bufoff, gbase, voff) do { _Pragma("unroll") for (int _i = 0; _i < 2; ++_i) \
        __builtin_amdgcn_global_load_lds((const unsigned*)((const char*)(gbase) + (voff)[_i]), (PG8_LAS unsigned*)(lds + (bufoff) + ldsw + _i * 8192), 16, 0, 0); } while (0)
#define PG8_LDA(dst, b, h) do { _Pragma("unroll") for (int m = 0; m < 4; ++m) _Pragma("unroll") for (int k = 0; k < 2; ++k) dst[m][k] = *(const PG8_LAS bf16x8*)(lds + PG8_SA(b, h) + aoff + m * 2048 + k * 1024); } while (0)
#define PG8_LDB(dst, b, h) do { _Pragma("unroll") for (int n = 0; n < 2; ++n) _Pragma("unroll") for (int k = 0; k < 2; ++k) dst[n][k] = *(const PG8_LAS bf16x8*)(lds + PG8_SB(b, h) + boff + n * 2048 + k * 1024); } while (0)
#define PG8_MMA(ai, bj, At, Bt) do { __builtin_amdgcn_s_setprio(1); _Pragma("unroll") for (int m = 0; m < 4; ++m) _Pragma("unroll") for (int n = 0; n < 2; ++n) _Pragma("unroll") for (int k = 0; k < 2; ++k) \
        acc[ai][bj][m][n] = __builtin_amdgcn_mfma_f32_16x16x32_bf16(Bt[n][k], At[m][k], acc[ai][bj][m][n], 0, 0, 0); __builtin_amdgcn_s_setprio(0); } while (0)
#define PG8_WAIT_V(n) asm volatile("s_waitcnt vmcnt(" #n ")" ::: "memory")
#define PG8_WAIT_L(n) asm volatile("s_waitcnt lgkmcnt(" #n ")" ::: "memory")
#define PG8_BAR __builtin_amdgcn_s_barrier()
#define PG8_SCHED __builtin_amdgcn_sched_barrier(0)
    Unit cur, nxt; int ui = 0;
    if (!S.next(0, cur)) return;
    f32x4 acc[2][2][4][2];
#pragma unroll
    for (int a = 0; a < 2; ++a)
#pragma unroll
        for (int b = 0; b < 2; ++b)
#pragma unroll
            for (int m = 0; m < 4; ++m)
#pragma unroll
                for (int n = 0; n < 2; ++n) acc[a][b][m][n] = (f32x4){0.f, 0.f, 0.f, 0.f};
    bf16x8 At[4][2], B0[2][2], B1[2][2];
    const char* cA = (const char*)g.A + (size_t)cur.pm * tstep; const char* cB = (const char*)g.Bt + (size_t)cur.pn * tstep;
    S.a_ready(cur);
    if constexpr (SP2) {
        PG8_STAGE(PG8_SB(0, 0), cB, voffB); PG8_STAGE(PG8_SB(0, 1), cB + hstep, voffB); PG8_STAGE(PG8_SA(0, 0), cA, voffA); PG8_STAGE(PG8_SA(0, 1), cA + hstep, voffA);
        if (wr == 1) PG8_BAR;
        PG8_WAIT_V(2); PG8_BAR;
        PG8_STAGE(PG8_SB(1, 0), cB + kstep, voffB); PG8_STAGE(PG8_SA(1, 0), cA + kstep, voffA); PG8_STAGE(PG8_SB(1, 1), cB + hstep + kstep, voffB);
        PG8_WAIT_V(6); PG8_BAR;
    } else {
        PG8_STAGE(PG8_SB(0, 0), cB, voffB); PG8_STAGE(PG8_SA(0, 0), cA, voffA); PG8_STAGE(PG8_SB(0, 1), cB + hstep, voffB); PG8_STAGE(PG8_SA(0, 1), cA + hstep, voffA);
        if (wr == 1) PG8_BAR;
        PG8_WAIT_V(4); PG8_BAR;
        PG8_STAGE(PG8_SB(1, 0), cB + kstep, voffB); PG8_STAGE(PG8_SA(1, 0), cA + kstep, voffA); PG8_STAGE(PG8_SB(1, 1), cB + hstep + kstep, voffB);
        PG8_WAIT_V(6); PG8_BAR;
    }
    for (;;) {
        const bool has_next = S.next(ui + 1, nxt);
        const char* nA = has_next ? (const char*)g.A + (size_t)nxt.pm * tstep : cA; const char* nB = has_next ? (const char*)g.Bt + (size_t)nxt.pn * tstep : cB;
        for (int t = 0; t < nt; t += 2) {
            const bool last = (t == nt - 2);
            const char* a1 = cA + (size_t)(t + 1) * kstep;
            const char* a2 = last ? nA : cA + (size_t)(t + 2) * kstep; const char* b2 = last ? nB : cB + (size_t)(t + 2) * kstep;
            const char* a3 = a2 + kstep; const char* b3 = b2 + kstep;
            if (last && has_next) S.a_ready(nxt);
            if constexpr (SP2) {
            PG8_LDB(B0, 0, 0); PG8_LDB(B1, 0, 1); PG8_SCHED; PG8_LDA(At, 0, 0); PG8_STAGE(PG8_SA(1, 1), a1 + hstep, voffA);
            PG8_WAIT_V(8); PG8_WAIT_L(0); PG8_BAR; PG8_MMA(0, 0, At, B0); PG8_MMA(0, 1, At, B1); PG8_BAR; PG8_SCHED;
            PG8_LDA(At, 0, 1); PG8_STAGE(PG8_SB(0, 0), b2, voffB); PG8_STAGE(PG8_SB(0, 1), b2 + hstep, voffB); PG8_STAGE(PG8_SA(0, 0), a2, voffA);
            PG8_WAIT_V(8); PG8_WAIT_L(0); PG8_BAR; PG8_MMA(1, 0, At, B0); PG8_MMA(1, 1, At, B1); PG8_BAR; PG8_SCHED;
            PG8_LDB(B0, 1, 0); PG8_LDB(B1, 1, 1); PG8_SCHED; PG8_LDA(At, 1, 0); PG8_STAGE(PG8_SA(0, 1), a2 + hstep, voffA);
            PG8_WAIT_V(8); PG8_WAIT_L(0); PG8_BAR; PG8_MMA(0, 0, At, B0); PG8_MMA(0, 1, At, B1); PG8_BAR; PG8_SCHED;
            PG8_LDA(At, 1, 1); PG8_STAGE(PG8_SB(1, 0), b3, voffB); PG8_STAGE(PG8_SB(1, 1), b3 + hstep, voffB); PG8_STAGE(PG8_SA(1, 0), a3, voffA);
            PG8_WAIT_V(8); PG8_WAIT_L(0); PG8_BAR; PG8_MMA(1, 0, At, B0); PG8_MMA(1, 1, At, B1); PG8_BAR; PG8_SCHED;
            } else {
            PG8_LDB(B0, 0, 0); PG8_SCHED; PG8_LDA(At, 0, 0); PG8_STAGE(PG8_SA(1, 1), a1 + hstep, voffA);
            PG8_WAIT_L(8); PG8_BAR; PG8_WAIT_L(0); PG8_MMA(0, 0, At, B0); PG8_BAR; PG8_SCHED;
            PG8_LDB(B1, 0, 1); PG8_STAGE(PG8_SB(0, 0), b2, voffB);
            PG8_BAR; PG8_WAIT_L(0); PG8_MMA(0, 1, At, B1); PG8_BAR;
            PG8_LDA(At, 0, 1); PG8_STAGE(PG8_SA(0, 0), a2, voffA);
            PG8_BAR; PG8_WAIT_L(0); PG8_MMA(1, 0, At, B0); PG8_BAR; PG8_SCHED;
            PG8_STAGE(PG8_SB(0, 1), b2 + hstep, voffB);
            PG8_WAIT_V(6); PG8_BAR; PG8_MMA(1, 1, At, B1); PG8_BAR;
            PG8_LDB(B0, 1, 0); PG8_SCHED; PG8_LDA(At, 1, 0); PG8_STAGE(PG8_SA(0, 1), a2 + hstep, voffA);
            PG8_WAIT_L(8); PG8_BAR; PG8_WAIT_L(0); PG8_MMA(0, 0, At, B0); PG8_BAR; PG8_SCHED;
            PG8_LDB(B1, 1, 1); PG8_STAGE(PG8_SB(1, 0), b3, voffB);
            PG8_BAR; PG8_WAIT_L(0); PG8_MMA(0, 1, At, B1); PG8_BAR;
            PG8_LDA(At, 1, 1); PG8_STAGE(PG8_SA(1, 0), a3, voffA);
            PG8_BAR; PG8_WAIT_L(0); PG8_MMA(1, 0, At, B0); PG8_BAR; PG8_SCHED;
            PG8_STAGE(PG8_SB(1, 1), b3 + hstep, voffB);
            PG8_WAIT_V(6); PG8_BAR; PG8_MMA(1, 1, At, B1); PG8_BAR;
            }
        }
        if constexpr (ALIGN_EPI) { if (wr == 0) PG8_BAR; }
        if constexpr (!Epi::AFTER_DRAIN) { const int le_ = lane_id(); E(acc, cur, wr, wc, le_ & 15, le_ >> 4); S.done(cur); }
        if (!has_next) break;
#pragma unroll
        for (int a = 0; a < 2; ++a)
#pragma unroll
            for (int b = 0; b < 2; ++b)
#pragma unroll
                for (int m = 0; m < 4; ++m)
#pragma unroll
                    for (int n = 0; n < 2; ++n) acc[a][b][m][n] = (f32x4){0.f, 0.f, 0.f, 0.f};
        cur = nxt; cA = nA; cB = nB; ++ui;
        if constexpr (ALIGN_EPI) { if (wr == 1) PG8_BAR; }
    }
    PG8_WAIT_V(0);
    if constexpr (!ALIGN_EPI) { if (wr == 0) PG8_BAR; }
    PG8_BAR;
    if constexpr (Epi::AFTER_DRAIN) { E.fused(acc, cur, wr, wc, fr, fq, lds, wid, lane); S.done(cur); }
#undef PG8_SA
#undef PG8_SB
#undef PG8_STAGE
#undef PG8_LDA
#undef PG8_LDB
#undef PG8_MMA
#undef PG8_WAIT_V
#undef PG8_WAIT_L
#undef PG8_BAR
#undef PG8_SCHED
}
}
using pg8::bf16_t; using pg8::bf16x8; using pg8::f32x4; using pg8::u32x4;
#define LAS __attribute__((address_space(3)))
typedef float f32x16 __attribute__((ext_vector_type(16)));
typedef float f32x2 __attribute__((ext_vector_type(2)));
typedef unsigned u32x2 __attribute__((ext_vector_type(2)));
typedef short v4i16_t __attribute__((ext_vector_type(4)));

constexpr int SEQ = 8192, MREAL = 16384, MALLOC = 16448, DM = 1024, NTHR = 512;
constexpr float EPS = 1e-6f, LOG2E = 1.4426950408889634f;
constexpr size_t R1K = (size_t)MALLOC * 1024 * 2;
constexpr size_t al64k(size_t x) { return (x + 65535) & ~(size_t)65535; }
constexpr size_t WS_CTL = 0, CTL_BYTES = 65536;
constexpr size_t WS_ROPE = CTL_BYTES;
constexpr size_t WS_SSQ = al64k(WS_ROPE + (size_t)8208 * 16 * 8);
constexpr size_t WS_SSQQ = al64k(WS_SSQ + (size_t)MALLOC * 16 * 4);
constexpr size_t WS_SSQKV = al64k(WS_SSQQ + (size_t)MALLOC * 4 * 4);
constexpr size_t WS_XMETA = al64k(WS_SSQKV + (size_t)MALLOC * 4 * 4);
constexpr size_t WS_KR = al64k(WS_XMETA + 65536);
constexpr size_t WS_W = al64k(WS_KR + (size_t)MALLOC * 32 * 2);
constexpr size_t WO_IN = 0, WO_GA = 2097152, WO_GB = 3145728, WO_Q = 4194304, WO_KV = 4390912, WO_A = 4521984, WO_B = 5046272, WO_O = 5570560, WO_UP = 6619136, WO_DN = 10813440, W_ELEMS = 15007744;
constexpr size_t WS_XB = al64k(WS_W + W_ELEMS * 2);
constexpr size_t WS_POOL = al64k(WS_XB + R1K);
constexpr size_t PO_S = 0;
constexpr size_t PO_QA = PO_S, PO_KVA = PO_S + (size_t)MALLOC * 256 * 2;
constexpr size_t PO_AO = R1K, PO_DN = R1K + R1K / 2;
constexpr size_t PO_DQ = 2 * R1K, PO_DK = 2 * R1K + R1K / 2, PO_DV = 3 * R1K, PO_Q = 3 * R1K + R1K / 2, PO_KV = 4 * R1K + R1K / 4;
constexpr size_t PO_YQ = 2 * R1K;
constexpr size_t PO_H = 0;
constexpr size_t WS_END = WS_POOL + 5 * R1K + R1K / 4;
static_assert(WS_END <= (size_t)256 * 1024 * 1024, "workspace map exceeds 256 MiB");

struct Params {
    const float* in[21]; float* out; unsigned char* ws;
};

typedef const Params __attribute__((address_space(4)))* kparams_t;
__device__ __forceinline__ kparams_t kparams() { kparams_t p = (kparams_t)__builtin_amdgcn_kernarg_segment_ptr(); asm volatile("" : "+s"(p)); return p; }
#define KPAR kparams()
__device__ __forceinline__ unsigned cvt_pk(float lo, float hi) { return pg8::cvt_pk_bf16(lo, hi); }
__device__ __forceinline__ u32x2 pk4(f32x4 v) { u32x2 r; r.x = cvt_pk(v[0], v[1]); r.y = cvt_pk(v[2], v[3]); return r; }
__device__ __forceinline__ float bf2f(unsigned short b) { return __uint_as_float((unsigned)b << 16); }
__device__ __forceinline__ f32x4 ld_bf4(const bf16_t* p) { const u32x2 w = *(const u32x2*)p; return (f32x4){__uint_as_float(w.x << 16), __uint_as_float(w.x & 0xffff0000u), __uint_as_float(w.y << 16), __uint_as_float(w.y & 0xffff0000u)}; }
__device__ __forceinline__ u32x4 pk8(f32x4 a, f32x4 b) { const u32x2 x = pk4(a), y = pk4(b); return (u32x4){x.x, x.y, y.x, y.y}; }
__device__ __forceinline__ void ld_bf8(const bf16_t* p, f32x4& a, f32x4& b) { const u32x4 w = *(const u32x4*)p;
    a = (f32x4){__uint_as_float(w.x << 16), __uint_as_float(w.x & 0xffff0000u), __uint_as_float(w.y << 16), __uint_as_float(w.y & 0xffff0000u)};
    b = (f32x4){__uint_as_float(w.z << 16), __uint_as_float(w.z & 0xffff0000u), __uint_as_float(w.w << 16), __uint_as_float(w.w & 0xffff0000u)}; }
__device__ __forceinline__ float sum4v(f32x4 a) { return (a[0] + a[1]) + (a[2] + a[3]); }
__device__ __forceinline__ float sumsq4(f32x4 a) { return (a[0] * a[0] + a[1] * a[1]) + (a[2] * a[2] + a[3] * a[3]); }
__device__ __forceinline__ float sum16p(const float* p) { const f32x4* q = (const f32x4*)p; return (sum4v(q[0]) + sum4v(q[1])) + (sum4v(q[2]) + sum4v(q[3])); }
__device__ __forceinline__ float sum4p(const float* p) { return sum4v(*(const f32x4*)p); }
__device__ __forceinline__ float shx(float v, int mask) { const int l = lane_id(); return __int_as_float(__builtin_amdgcn_ds_bpermute((l ^ mask) << 2, __float_as_int(v))); }
__device__ __forceinline__ float half_max(float v) { const auto rr = __builtin_amdgcn_permlane32_swap(__float_as_uint(v), __float_as_uint(v), false, false); return fmaxf(__uint_as_float(rr[0]), __uint_as_float(rr[1])); }
__device__ __forceinline__ float half_sum(float v) { const auto rr = __builtin_amdgcn_permlane32_swap(__float_as_uint(v), __float_as_uint(v), false, false); return __uint_as_float(rr[0]) + __uint_as_float(rr[1]); }
#define DPP_F(v, ctrl) __uint_as_float((unsigned)__builtin_amdgcn_update_dpp(0, (int)__float_as_uint(v), (ctrl), 0xf, 0xf, false))
__device__ __forceinline__ float row16_sum(float v) { v += DPP_F(v, 0xB1); v += DPP_F(v, 0x4E); v += DPP_F(v, 0x141); v += DPP_F(v, 0x140); return v; }
__device__ __forceinline__ float row16_min(float v) { v = fminf(v, DPP_F(v, 0xB1)); v = fminf(v, DPP_F(v, 0x4E)); v = fminf(v, DPP_F(v, 0x141)); v = fminf(v, DPP_F(v, 0x140)); return v; }
__device__ __forceinline__ float swap16_sum(float v) { const auto rr = __builtin_amdgcn_permlane16_swap(__float_as_uint(v), __float_as_uint(v), false, false); return __uint_as_float(rr[0]) + __uint_as_float(rr[1]); }
__device__ __forceinline__ float swap16_min(float v) { const auto rr = __builtin_amdgcn_permlane16_swap(__float_as_uint(v), __float_as_uint(v), false, false); return fminf(__uint_as_float(rr[0]), __uint_as_float(rr[1])); }
__device__ __forceinline__ float half32_sum(float v) { return swap16_sum(row16_sum(v)); }
__device__ __forceinline__ float wave_sum(float v) {
    return half_sum(half32_sum(v));
}
__device__ __forceinline__ float fq_sum(float s) {
    { const auto rr = __builtin_amdgcn_permlane16_swap(__float_as_uint(s), __float_as_uint(s), false, false); s = __uint_as_float(rr[0]) + __uint_as_float(rr[1]); }
    { const auto rr = __builtin_amdgcn_permlane32_swap(__float_as_uint(s), __float_as_uint(s), false, false); s = __uint_as_float(rr[0]) + __uint_as_float(rr[1]); }
    return s; }
__device__ __forceinline__ int tok_pos(int row) { return row < MREAL ? 16 + (row & (SEQ - 1)) : row - MREAL; }
__device__ __forceinline__ float sigmoidf_(float z) { return __builtin_amdgcn_rcpf(1.0f + __builtin_amdgcn_exp2f(-LOG2E * z)); }

struct REWin {
    static constexpr bool PERM = false; static constexpr int NP = 16, FENCE = 0, KMAX = 1; const float* ssq; unsigned* kmax_word; __device__ __forceinline__ const float* nsrc() const { return ssq; } bf16_t *QA, *KVA, *KR, *DQ, *DK, *DVv; float *ssqq, *ssqkv; const f32x2* rope;
    __device__ __forceinline__ void row(int row, int pn, int wc, int fq, f32x4 (&v)[2][2], float rstd) const {
#pragma unroll
        for (int bj = 0; bj < 2; ++bj)
#pragma unroll
            for (int n = 0; n < 2; ++n) v[bj][n] = v[bj][n] * rstd;
        const int cw = 32 * wc + 4 * fq;
        if (pn == 0) {
            float s = 0.f;
#pragma unroll
            for (int bj = 0; bj < 2; ++bj)
#pragma unroll
                for (int n = 0; n < 2; ++n) { *(u32x2*)(QA + (size_t)row * 256 + 128 * bj + cw + 16 * n) = pk4(v[bj][n]); s += sumsq4(v[bj][n]); }
            s = fq_sum(s); if (fq == 0) ssqq[(size_t)row * 4 + wc] = s;
        } else if (pn == 1) {
            float s = 0.f;
#pragma unroll
            for (int n = 0; n < 2; ++n) { *(u32x2*)(KVA + (size_t)row * 128 + cw + 16 * n) = pk4(v[0][n]); s += sumsq4(v[0][n]); }
            s = fq_sum(s); if (fq == 0) ssqkv[(size_t)row * 4 + wc] = s;
            if (wc == 0) {
                const f32x2* t = rope + (size_t)tok_pos(row) * 16 + 4 * fq; f32x4 a, b;
#pragma unroll
                for (int i = 0; i < 4; ++i) { const f32x2 cs = t[i]; a[i] = v[1][0][i] * cs.x - v[1][1][i] * cs.y; b[i] = v[1][0][i] * cs.y + v[1][1][i] * cs.x; }
                *(u32x2*)(KR + (size_t)row * 32 + 4 * fq) = pk4(a); *(u32x2*)(KR + (size_t)row * 32 + 16 + 4 * fq) = pk4(b);
            }
        } else {
            bf16_t* dst = DQ + (size_t)((pn - 2) >> 1) * ((size_t)MALLOC * 512); const float sc = pn < 4 ? 0.125f * LOG2E : 1.0f; const int c0 = (pn & 1) * 256;
#pragma unroll
            for (int bj = 0; bj < 2; ++bj)
#pragma unroll
                for (int n = 0; n < 2; ++n) *(u32x2*)(dst + (size_t)row * 512 + c0 + 128 * bj + cw + 16 * n) = pk4(v[bj][n] * sc);
        }
    }
};
struct REQup {
    static constexpr bool PERM = false; static constexpr int NP = 4, FENCE = 0, KMAX = 0; const float* ssqq; bf16_t* Q; const f32x2* rope; __device__ __forceinline__ const float* nsrc() const { return ssqq; }
    __device__ __forceinline__ void row(int row, int pn, int wc, int fq, f32x4 (&v)[2][2], float rstd) const {
        const float sc = rstd * (0.10206207261596577f * LOG2E);
#pragma unroll
        for (int bj = 0; bj < 2; ++bj) {
            const int g32 = 256 * pn + 128 * bj + 32 * wc; f32x4 a = v[bj][0] * sc, b = v[bj][1] * sc;
            if ((g32 % 96) == 64) {
                const f32x2* t = rope + (size_t)tok_pos(row) * 16 + 4 * fq; f32x4 a2, b2;
#pragma unroll
                for (int i = 0; i < 4; ++i) { const f32x2 cs = t[i]; a2[i] = a[i] * cs.x - b[i] * cs.y; b2[i] = a[i] * cs.y + b[i] * cs.x; }
                a = a2; b = b2;
            }
            *(u32x2*)(Q + (size_t)row * 768 + g32 + 4 * fq) = pk4(a); *(u32x2*)(Q + (size_t)row * 768 + g32 + 16 + 4 * fq) = pk4(b);
        }
    }
};
struct REKVup {
    static constexpr bool PERM = true; static constexpr int NP = 4, FENCE = 0, KMAX = 0; const float* ssqkv; bf16_t* KV; __device__ __forceinline__ const float* nsrc() const { return ssqkv; }
    __device__ __forceinline__ void row(int row, int pn, int wc, int fq, f32x4 (&v)[2][2], float rstd) const {
        const float sc = rstd;
#pragma unroll
        for (int bj = 0; bj < 2; ++bj) *(u32x4*)(KV + (size_t)row * 1024 + 256 * pn + 128 * bj + 32 * wc + 8 * fq) = pk8(v[bj][0] * sc, v[bj][1] * sc);
    }
};
struct REStore {
    static constexpr bool PERM = true; static constexpr int NP = 0, FENCE = 0, KMAX = 0; bf16_t* O; __device__ __forceinline__ const float* nsrc() const { return nullptr; }
    __device__ __forceinline__ void row(int row, int pn, int wc, int fq, f32x4 (&v)[2][2], float rstd) const {
#pragma unroll
        for (int bj = 0; bj < 2; ++bj) *(u32x4*)(O + (size_t)row * 1024 + 256 * pn + 128 * bj + 32 * wc + 8 * fq) = pk8(v[bj][0], v[bj][1]);
    }
};
struct REGate {
    static constexpr bool PERM = true; static constexpr int NP = 16, FENCE = 1, KMAX = 0; const float* ssq; const float* bias; bf16_t* Y; const bf16_t* T; int add; __device__ __forceinline__ const float* nsrc() const { return ssq; }
    __device__ __forceinline__ void row(int row, int pn, int wc, int fq, f32x4 (&v)[2][2], float rstd) const {
#pragma unroll
        for (int bj = 0; bj < 2; ++bj) {
            const int col = 256 * pn + 128 * bj + 32 * wc + 8 * fq; const f32x4 b0 = *(const f32x4*)(bias + col), b1 = *(const f32x4*)(bias + col + 4);
            f32x4 g0, g1;
#pragma unroll
            for (int i = 0; i < 4; ++i) { g0[i] = sigmoidf_(v[bj][0][i] * rstd + b0[i]); g1[i] = sigmoidf_(v[bj][1][i] * rstd + b1[i]); }
            bf16_t* yp = Y + (size_t)row * 1024 + col; f32x4 y0, y1; ld_bf8(yp, y0, y1);
            f32x4 r0, r1; if (add) { f32x4 t0, t1; ld_bf8(T + (size_t)row * 1024 + col, t0, t1); r0 = y0 + g0 * t0; r1 = y1 + g1 * t1; } else { r0 = g0 * y0; r1 = g1 * y1; }
            *(u32x4*)yp = pk8(r0, r1);
        }
    }
};
struct REResid {
    static constexpr bool PERM = true; static constexpr int NP = 0, FENCE = 1, KMAX = 0; const float* base_main; const float* base_meta; float* out_main; float* out_meta; bf16_t* XB; float* ssq; __device__ __forceinline__ const float* nsrc() const { return nullptr; }
    __device__ __forceinline__ void row(int row, int pn, int wc, int fq, f32x4 (&v)[2][2], float rstd) const {
        const float* bp = row < MREAL ? base_main + (size_t)row * 1024 : base_meta + (size_t)(row - MREAL) * 1024;
        float* op = row < MREAL ? out_main + (size_t)row * 1024 : out_meta + (size_t)(row - MREAL) * 1024;
        float s = 0.f;
#pragma unroll
        for (int bj = 0; bj < 2; ++bj) {
            const int col = 256 * pn + 128 * bj + 32 * wc + 8 * fq;
            const f32x4 x0 = *(const f32x4*)(bp + col) + v[bj][0], x1 = *(const f32x4*)(bp + col + 4) + v[bj][1];
            *(f32x4*)(op + col) = x0; *(f32x4*)(op + col + 4) = x1; if (XB) *(u32x4*)(XB + (size_t)row * 1024 + col) = pk8(x0, x1); s += sumsq4(x0) + sumsq4(x1);
        }
        s = fq_sum(s); if (fq == 0) ssq[(size_t)row * 16 + pn * 4 + wc] = s;
    }
};
struct REUp {
    static constexpr bool PERM = true; static constexpr int NP = 16, FENCE = 0, KMAX = 0; const float* ssq; bf16_t* H; __device__ __forceinline__ const float* nsrc() const { return ssq; }
    __device__ __forceinline__ void row(int row, int pn, int wc, int fq, f32x4 (&v)[2][2], float rstd) const {
#pragma unroll
        for (int bj = 0; bj < 2; ++bj) { f32x4 t0 = v[bj][0] * rstd, t1 = v[bj][1] * rstd;
#pragma unroll
            for (int i = 0; i < 4; ++i) { const float r0 = fmaxf(t0[i], 0.f), r1 = fmaxf(t1[i], 0.f); t0[i] = r0 * r0; t1[i] = r1 * r1; }
            *(u32x4*)(H + (size_t)row * 4096 + 256 * pn + 128 * bj + 32 * wc + 8 * fq) = pk8(t0, t1); }
    }
};
template <int NP> __device__ __forceinline__ float row_part(const float* p, int row, int fq) {
    if (NP == 16) return sum4v(*(const f32x4*)(p + (size_t)row * 16 + 4 * fq));
    if (NP == 4) return p[(size_t)row * 4 + fq];
    return 0.f;
}
template <int NP> __device__ __forceinline__ float row_rstd(float part) {
    if (NP == 0) return 1.0f;
    const float tot = fq_sum(part);
    return rsqrtf(tot * (NP == 16 ? (1.0f / 1024.0f) : 1.0f) + EPS);
}
template <class RE> struct EpiRows {
    static constexpr bool PERM = RE::PERM, AFTER_DRAIN = false; RE e; float inv_n;
    __device__ __forceinline__ void operator()(const f32x4 (&acc)[2][2][4][2], const pg8::Unit& u, int wr, int wc, int fr, int fq) const {
        float rs[2][4];
        if (RE::NP != 0) {
            const float* ns = e.nsrc(); float part[2][4];
#pragma unroll
            for (int ai = 0; ai < 2; ++ai)
#pragma unroll
                for (int m = 0; m < 4; ++m) part[ai][m] = row_part<RE::NP>(ns, u.pm * 256 + ai * 128 + wr * 64 + m * 16 + fr, fq);
#pragma unroll
            for (int ai = 0; ai < 2; ++ai)
#pragma unroll
                for (int m = 0; m < 4; ++m) rs[ai][m] = rsqrtf(fq_sum(part[ai][m]) * inv_n + EPS);
        }
#pragma unroll
        for (int ai = 0; ai < 2; ++ai)
#pragma unroll
            for (int m = 0; m < 4; ++m) { f32x4 v[2][2] = {{acc[ai][0][m][0], acc[ai][0][m][1]}, {acc[ai][1][m][0], acc[ai][1][m][1]}};
                e.row(u.pm * 256 + ai * 128 + wr * 64 + m * 16 + fr, u.pn, wc, fq, v, RE::NP != 0 ? rs[ai][m] : 1.0f);
                if (RE::FENCE && (m & 1)) asm volatile("" ::: "memory"); }
        if constexpr (RE::KMAX != 0) { if (u.pn == 4 || u.pn == 5) {
            float kmx = 0.f;
#pragma unroll
            for (int ai = 0; ai < 2; ++ai)
#pragma unroll
                for (int m = 0; m < 4; ++m)
#pragma unroll
                    for (int bj = 0; bj < 2; ++bj) kmx = fmaxf(kmx, fq_sum(sumsq4(acc[ai][bj][m][0]) + sumsq4(acc[ai][bj][m][1])) * rs[ai][m] * rs[ai][m]);
#pragma unroll
            for (int o = 1; o < 16; o <<= 1) kmx = fmaxf(kmx, shx(kmx, o));
            if (lane_id() == 0) atomicMax(e.kmax_word, __float_as_uint(kmx)); } }
    }
};
template <class RE> __device__ __forceinline__ void meta_gemm(LAS unsigned char* lds, const bf16_t* A, const bf16_t* Bt, int N, int K, const RE& e, float inv_n, int g_wid) {
    int tid_o = (g_wid << 6) | lane_id(); const int tid = tid_o, wid = tid >> 6, lane = tid & 63, fr = lane & 15, fq = lane >> 4;
    const bf16_t* A16 = A + (size_t)MREAL * K;
    for (int u = blockIdx.x; u < N / 64; u += gridDim.x) {
        const int pn = u >> 2, wc = u & 3;
        f32x4 acc[2][2];
#pragma unroll
        for (int bj = 0; bj < 2; ++bj)
#pragma unroll
            for (int n = 0; n < 2; ++n) acc[bj][n] = (f32x4){0.f, 0.f, 0.f, 0.f};
        const int nst = K >= 256 ? K / 256 : 1, nwv = K >= 256 ? 8 : K / 32;
#pragma unroll 4
        for (int s = 0; s < (wid < nwv ? nst : 0); ++s) {
            const int k0 = (wid * nst + s) * 32 + 8 * fq;
            const bf16x8 a = *(const bf16x8*)(A16 + (size_t)fr * K + k0);
#pragma unroll
            for (int bj = 0; bj < 2; ++bj)
#pragma unroll
                for (int n = 0; n < 2; ++n) { const bf16x8 b = *(const bf16x8*)(Bt + (size_t)(256 * pn + 128 * bj + 32 * wc + (RE::PERM ? 8 * (fr >> 2) + 4 * n + (fr & 3) : 16 * n + fr)) * K + k0);
                    acc[bj][n] = __builtin_amdgcn_mfma_f32_16x16x32_bf16(b, a, acc[bj][n], 0, 0, 0); }
        }
        LAS f32x4* red = (LAS f32x4*)lds;
#pragma unroll
        for (int bj = 0; bj < 2; ++bj)
#pragma unroll
            for (int n = 0; n < 2; ++n) red[(wid * 4 + bj * 2 + n) * 64 + lane] = acc[bj][n];
        __syncthreads();
        if (wid == 0) {
            f32x4 v[2][2];
#pragma unroll
            for (int bj = 0; bj < 2; ++bj)
#pragma unroll
                for (int n = 0; n < 2; ++n) { f32x4 s = red[(bj * 2 + n) * 64 + lane];
#pragma unroll
                    for (int w = 1; w < 8; ++w) s = s + red[(w * 4 + bj * 2 + n) * 64 + lane];
                    v[bj][n] = s; }
            float rstd = 1.0f;
            if (RE::NP != 0) rstd = rsqrtf(fq_sum(row_part<RE::NP>(e.nsrc(), MREAL + fr, fq)) * inv_n + EPS);
            e.row(MREAL + fr, pn, wc, fq, v, rstd);
            if constexpr (RE::KMAX != 0) { if (pn == 4 || pn == 5) { float kmx = 0.f;
#pragma unroll
                for (int bj = 0; bj < 2; ++bj) kmx = fmaxf(kmx, fq_sum(sumsq4(v[bj][0]) + sumsq4(v[bj][1])));
#pragma unroll
                for (int o = 1; o < 16; o <<= 1) kmx = fmaxf(kmx, shx(kmx, o));
                if (lane == 0) atomicMax(e.kmax_word, __float_as_uint(kmx)); } }
        }
        __syncthreads();
    }
}
template <class RE> __device__ __forceinline__ void gemm_all(LAS unsigned char* lds, const bf16_t* A, const bf16_t* Bt, int N, int K, const RE& e, bool do_meta, int g_wid) {
    asm volatile("" : "+s"(A), "+s"(Bt));
    if (do_meta) meta_gemm<RE>(lds, A, Bt, N, K, e, 1.0f / (float)K, g_wid);
    pg8::Gemm g{A, Bt, MREAL, N, K}; pg8::StaticOrder S; S.init(MREAL, N, (int)gridDim.x, (int)blockIdx.x);
    EpiRows<RE> E{e, 1.0f / (float)K};
    pg8::gemm_phase<EpiRows<RE>, pg8::StaticOrder, true, true>(lds, g, S, E, g_wid);
}

__device__ __forceinline__ unsigned f2bf(float f) { unsigned u = __float_as_uint(f); return (u + 0x7fffu + ((u >> 16) & 1u)) >> 16; }
__device__ __forceinline__ unsigned pk2(float lo, float hi) { return f2bf(lo) | (f2bf(hi) << 16); }
__device__ __forceinline__ void transpose_item(const float* W, int ldw, int K, int col0, int ncolblk, bf16_t* WT, int row0, const float* gain, int gmask, float gscale, LAS float* scr, int item, int lane) {
    const int kb = item / ncolblk, nb = item % ncolblk, k0 = 64 * kb, n0 = 32 * nb;
#pragma unroll
    for (int i = 0; i < 8; ++i) { const int kk = 8 * i + (lane >> 3), c4 = (lane & 7) * 4; const float g = gain ? gain[(k0 + kk) & gmask] * gscale : 1.0f;
        const f32x4 w4 = *(const f32x4*)(W + (size_t)(k0 + kk) * ldw + col0 + n0 + c4);
        LAS float* d = scr + kk * 33 + c4; d[0] = w4[0] * g; d[1] = w4[1] * g; d[2] = w4[2] * g; d[3] = w4[3] * g; }
    asm volatile("s_waitcnt lgkmcnt(0)" ::: "memory");
    const int c = lane & 7;
#pragma unroll
    for (int j = 0; j < 4; ++j) { const int n = (lane >> 3) + 8 * j; const LAS float* s = scr + (8 * c) * 33 + n;
        u32x4 o; o.x = pk2(s[0 * 33], s[1 * 33]); o.y = pk2(s[2 * 33], s[3 * 33]); o.z = pk2(s[4 * 33], s[5 * 33]); o.w = pk2(s[6 * 33], s[7 * 33]);
        *(u32x4*)(WT + (size_t)(row0 + n0 + n) * K + k0 + 8 * c) = o; }
    asm volatile("s_waitcnt lgkmcnt(0)" ::: "memory");
}
__device__ __forceinline__ void convert_weights(const Params& P, int l, LAS unsigned char* lds, int g_wid) {
    int tid_o = (g_wid << 6) | lane_id(); const int tid = tid_o, wid = tid >> 6, lane = tid & 63;
    LAS float* scr = (LAS float*)(lds + wid * 16384);
    bf16_t* W = (bf16_t*)(KPAR->ws + WS_W);
    const float* w_in = KPAR->in[3] + (size_t)l * 1024 * 4000; const float* attn_norm = KPAR->in[2] + l * 1024;
    const float* w_q = KPAR->in[6] + (size_t)l * 256 * 768; const float* qn = KPAR->in[5] + l * 256;
    const float* w_kv = KPAR->in[8] + (size_t)l * 128 * 1024; const float* kvn = KPAR->in[7] + l * 128;
    const float* w_a = KPAR->in[14] + (size_t)l * 512 * 1024; const float* w_b = KPAR->in[15] + (size_t)l * 512 * 1024; const float* subln = KPAR->in[13] + l * 128;
    const float* w_o = KPAR->in[16] + (size_t)l * 1024 * 1024; const float* mlpn = KPAR->in[17] + l * 1024;
    const float* w_up = KPAR->in[18] + (size_t)l * 1024 * 4096; const float* w_dn = KPAR->in[19] + (size_t)l * 4096 * 1024;
    const float lam_scale = 1.0f - (l == 0 ? 0.2f : 0.35550907f);
    const int gw = blockIdx.x * 8 + wid, NGW = gridDim.x * 8;
    constexpr int NITEMS = 208 + 768 + 512 + 512 + 96 + 64 + 256 + 256 + 512 + 2048 + 2048;
    for (int it = gw; it < NITEMS; it += NGW) {
        int r = it;
        if (r < 208) { transpose_item(w_in, 4000, 1024, 0, 13, W + WO_IN, 0, attn_norm, 1023, 1.f, scr, r, lane); continue; } r -= 208;
        if (r < 768) { transpose_item(w_in, 4000, 1024, 416, 48, W + WO_IN, 512, attn_norm, 1023, 1.f, scr, r, lane); continue; } r -= 768;
        if (r < 512) { transpose_item(w_in, 4000, 1024, 1952, 32, W + WO_GA, 0, attn_norm, 1023, 1.f, scr, r, lane); continue; } r -= 512;
        if (r < 512) { transpose_item(w_in, 4000, 1024, 2976, 32, W + WO_GB, 0, attn_norm, 1023, 1.f, scr, r, lane); continue; } r -= 512;
        if (r < 96) { transpose_item(w_q, 768, 256, 0, 24, W + WO_Q, 0, qn, 255, 1.f, scr, r, lane); continue; } r -= 96;
        if (r < 64) { transpose_item(w_kv, 1024, 128, 0, 32, W + WO_KV, 0, kvn, 127, 1.f, scr, r, lane); continue; } r -= 64;
        if (r < 256) { transpose_item(w_a, 1024, 512, 0, 32, W + WO_A, 0, nullptr, 0, 1.f, scr, r, lane); continue; } r -= 256;
        if (r < 256) { transpose_item(w_b, 1024, 512, 0, 32, W + WO_B, 0, subln, 127, lam_scale, scr, r, lane); continue; } r -= 256;
        if (r < 512) { transpose_item(w_o, 1024, 1024, 0, 32, W + WO_O, 0, nullptr, 0, 1.f, scr, r, lane); continue; } r -= 512;
        if (r < 2048) { transpose_item(w_up, 4096, 1024, 0, 128, W + WO_UP, 0, mlpn, 1023, 1.f, scr, r, lane); continue; } r -= 2048;
        transpose_item(w_dn, 1024, 4096, 0, 32, W + WO_DN, 0, nullptr, 0, 1.f, scr, r, lane);
    }
}
__device__ __forceinline__ void prologue_x(const Params& P, int g_wid) {
    int tid_o = (g_wid << 6) | lane_id(); const int tid = tid_o, wid = tid >> 6, lane = tid & 63;
    const int gw = blockIdx.x * 8 + wid, NGW = gridDim.x * 8;
    bf16_t* XB = (bf16_t*)(KPAR->ws + WS_XB); float* ssq = (float*)(KPAR->ws + WS_SSQ);
    for (int row = gw; row < MREAL + 16; row += NGW) {
        const float* src = row < MREAL ? KPAR->in[0] + (size_t)row * 1024 : KPAR->in[1] + (size_t)(row - MREAL) * 1024;
        float s = 0.f;
#pragma unroll
        for (int j = 0; j < 2; ++j) { const f32x4 v0 = ((const f32x4*)src)[128 * j + 2 * lane], v1 = ((const f32x4*)src)[128 * j + 2 * lane + 1]; s += sumsq4(v0) + sumsq4(v1); ((u32x4*)(XB + (size_t)row * 1024))[64 * j + lane] = pk8(v0, v1); }
        s = wave_sum(s);
        if (lane < 16) ssq[(size_t)row * 16 + lane] = lane == 0 ? s : 0.f;
    }
    { bf16_t* W = (bf16_t*)(KPAR->ws + WS_W);
      for (int i = blockIdx.x * NTHR + tid; i < 96 * 1024 / 8; i += gridDim.x * NTHR) ((u32x4*)(W + WO_IN + 416 * 1024))[i] = (u32x4){0u, 0u, 0u, 0u}; }
    f32x2* rope = (f32x2*)(KPAR->ws + WS_ROPE);
    for (int e = blockIdx.x * NTHR + tid; e < 8208 * 16; e += gridDim.x * NTHR) {
        const int pos = e >> 4, i = e & 15, i4 = i & 3, i16 = i >> 2;
        const float c4 = i4 == 0 ? 1.0f : (i4 == 1 ? 0.56234132519f : (i4 == 2 ? 0.31622776602f : 0.17782794100f));
        const float s16 = i16 == 0 ? 1.0f : (i16 == 1 ? 0.1f : (i16 == 2 ? 0.01f : 0.001f));
        const float inv = c4 * s16; const float ang = (float)pos * inv;
        const double x = (double)ang; const double nq = __builtin_rint(x * 0.63661977236758134308); const double r = __builtin_fma(-nq, 1.57079632679489661923, x);
        const double r2 = r * r;
        const double sn = r * (1.0 + r2 * (-1.0 / 6 + r2 * (1.0 / 120 + r2 * (-1.0 / 5040 + r2 * (1.0 / 362880 + r2 * (-1.0 / 39916800 + r2 * (1.0 / 6227020800.0)))))));
        const double cs = 1.0 + r2 * (-0.5 + r2 * (1.0 / 24 + r2 * (-1.0 / 720 + r2 * (1.0 / 40320 + r2 * (-1.0 / 3628800 + r2 * (1.0 / 479001600.0 + r2 * (-1.0 / 87178291200.0)))))));
        const int q = ((int)nq) & 3;
        const double c = q == 0 ? cs : (q == 1 ? -sn : (q == 2 ? -cs : sn));
        const double s = q == 0 ? sn : (q == 1 ? cs : (q == 2 ? -sn : -cs));
        rope[e] = (f32x2){(float)c, (float)s};
    }
}
constexpr int AT_KBUF = 12288, AT_VBUF = 16384, AT_K = 0, AT_V = 2 * AT_KBUF, AT_ASC = AT_V + 3 * AT_VBUF, AT_QW = AT_ASC + 1024;
__device__ __forceinline__ int crow(int r, int hi) { return (r & 3) + 8 * (r >> 2) + 4 * hi; }
#define MFMA32(a, b, c) __builtin_amdgcn_mfma_f32_32x32x16_bf16((a), (b), (c), 0, 0, 0)
template <int DQK, int DV, bool ALIBI>
__device__ __forceinline__ void attn_pass(LAS unsigned char* lds, const bf16_t* Qp, int qpitch, const bf16_t* K1, int k1pitch, const bf16_t* K2, int k2pitch,
                                          const bf16_t* Vp, int vpitch, int brow0, int NT, int qreal0, int meta, float sl2, float kmax, f32x16 (&o)[DV / 32], int g_wid) {
    constexpr int NCH = DQK / 8, NDS = DQK / 16, NDB = DV / 32, VCH = DV / 8, KP = (64 * NCH + 511) / 512, VP = (64 * VCH) / 512;
    int tid_o = (g_wid << 6) | lane_id(); const int tid = tid_o, lane = tid & 63, wid = __builtin_amdgcn_readfirstlane(tid >> 6), r32 = lane & 31, hi = lane >> 5;
    bf16x8 qf[NDS];
    { const bf16_t* qrow = Qp + (size_t)(32 * wid + r32) * qpitch + 8 * hi;
#pragma unroll
      for (int ds = 0; ds < NDS; ++ds) qf[ds] = *(const bf16x8*)(qrow + 16 * ds); }
    const bf16_t* ksrc[KP]; int kpit[KP]; unsigned kdst[KP]; bool kval[KP];
#pragma unroll
    for (int i = 0; i < KP; ++i) { const int p = tid + 512 * i; kval[i] = p < 64 * NCH; const int pp = kval[i] ? p : 0; const int key = pp / NCH, c = pp % NCH;
        if (NCH <= 8 || c < 8) { ksrc[i] = K1 + (size_t)key * k1pitch + c * 8; kpit[i] = k1pitch; } else { ksrc[i] = K2 + (size_t)key * k2pitch + (c - 8) * 8; kpit[i] = k2pitch; }
        kdst[i] = AT_K + c * 1024 + ((key ^ c) << 4); }
    const bf16_t* vsrc[VP]; unsigned vdst[VP];
#pragma unroll
    for (int i = 0; i < VP; ++i) { const int p = tid + 512 * i; const int key = p / VCH, c = p % VCH; vsrc[i] = Vp + (size_t)key * vpitch + c * 8; vdst[i] = AT_V + (c >> 2) * 4096 + key * 64 + (c & 3) * 16; }
    u32x4 kregA[KP], vregA[VP];
#define AT_ISSUE(t, KR_, VR_) do { const size_t kb_ = (size_t)((t) == 0 ? MREAL : brow0 + 64 * ((t) - 1)); \
        _Pragma("unroll") for (int i = 0; i < KP; ++i) if (kval[i]) KR_[i] = *(const u32x4*)(ksrc[i] + kb_ * kpit[i]); \
        _Pragma("unroll") for (int i = 0; i < VP; ++i) VR_[i] = *(const u32x4*)(vsrc[i] + kb_ * vpitch); } while (0)
#define AT_COMMIT(kbuf, vslot, KR_, VR_) do { \
        _Pragma("unroll") for (int i = 0; i < KP; ++i) if (kval[i]) *(LAS u32x4*)(lds + kdst[i] + (kbuf) * AT_KBUF) = KR_[i]; \
        _Pragma("unroll") for (int i = 0; i < VP; ++i) *(LAS u32x4*)(lds + vdst[i] + (vslot)) = VR_[i]; } while (0)
#define AT_BAR() asm volatile("s_waitcnt lgkmcnt(0)\n\ts_barrier" ::: "memory")
#define SB() __builtin_amdgcn_sched_barrier(0)
    unsigned kaddr[NDS];
#pragma unroll
    for (int ds = 0; ds < NDS; ++ds) { const int cx = 2 * ds + hi; kaddr[ds] = AT_K + cx * 1024 + ((r32 ^ cx) << 4); }
    const unsigned vb = AT_V + ((lane >> 4) & 1) * 32 + (lane & 3) * 8 + (4 * hi + ((lane & 15) >> 2)) * 64;
    LAS float* asc = (LAS float*)(lds + AT_ASC) + wid * 32;
    float m_ref = 0.f, l = 0.f;
    f32x16 negm;
#pragma unroll
    for (int r = 0; r < 16; ++r) negm[r] = 0.f;
#pragma unroll
    for (int db = 0; db < NDB; ++db)
#pragma unroll
        for (int r = 0; r < 16; ++r) o[db][r] = 0.f;
    const int qw0 = 32 * wid, qrow_l = qw0 + r32;
    bf16x8 pa[4];
    bool resc = false;
#define P_CINIT(t) do { \
        if (ALIBI) { const int kpos0 = (t) == 0 ? 0 : 16 + 64 * ((t) - 1), qpos0 = meta ? 0 : 16 + qreal0; const float tb = sl2x * (float)(kpos0 - qpos0 + 4 * hix) - m_ref; \
            _Pragma("unroll") for (int r = 0; r < 16; ++r) { c0[r] = tb + sl2x * (float)((r & 3) + 8 * (r >> 2)); c1[r] = c0[r] + 32.0f * sl2x; } } \
        else { c0 = negm; c1 = negm; } } while (0)
#define P_KREAD(kb) do { _Pragma("unroll") for (int ds = 0; ds < NDS; ++ds) { kf0[ds] = *(const LAS bf16x8*)(lds + kaddr[ds] + (kb) * AT_KBUF); kf1[ds] = *(const LAS bf16x8*)(lds + kaddr[ds] + (kb) * AT_KBUF + 512); } } while (0)
#define P_QK() do { __builtin_amdgcn_s_setprio(1); _Pragma("unroll") for (int ds = 0; ds < NDS; ++ds) { c0 = MFMA32(kf0[ds], qf[ds], c0); c1 = MFMA32(kf1[ds], qf[ds], c1); } __builtin_amdgcn_s_setprio(0); } while (0)
#define P_VREAD(vsp, dg) do { _Pragma("unroll") for (int d2 = 0; d2 < 2; ++d2) _Pragma("unroll") for (int ks = 0; ks < 4; ++ks) { \
            const LAS unsigned char* vp_ = lds + vb + (vsp) + ((dg) + d2) * 4096 + ks * 1024; \
            vlo[d2][ks] = __builtin_amdgcn_ds_read_tr16_b64_v4i16((LAS v4i16_t*)vp_); vhh[d2][ks] = __builtin_amdgcn_ds_read_tr16_b64_v4i16((LAS v4i16_t*)(vp_ + 512)); } } while (0)
#define P_PV(dg, ksa) do { __builtin_amdgcn_s_setprio(1); _Pragma("unroll") for (int ks = (ksa); ks < (ksa) + 2; ++ks) _Pragma("unroll") for (int d2 = 0; d2 < 2; ++d2) { \
            const bf16x8 vf_ = __builtin_shufflevector(vlo[d2][ks], vhh[d2][ks], 0, 1, 2, 3, 4, 5, 6, 7); o[(dg) + d2] = MFMA32(pa[ks], vf_, o[(dg) + d2]); } __builtin_amdgcn_s_setprio(0); } while (0)
#define P_MASKMAX(t) do { \
        int lim; if ((t) == 0) lim = meta ? (qrow_l < 15 ? qrow_l : 15) : 15; else lim = qreal0 + qrow_l - 64 * ((t) - 1); \
        if (__any(lim < 63)) { \
            _Pragma("unroll") for (int r = 0; r < 16; ++r) { const int kidx = crow(r, hix); if (kidx > lim) c0[r] = -INFINITY; if (kidx + 32 > lim) c1[r] = -INFINITY; } } \
        float mx = fmaxf(c0[0], c1[0]); \
        _Pragma("unroll") for (int r = 1; r < 16; ++r) mx = fmaxf(fmaxf(mx, c0[r]), c1[r]); \
        mx = half_max(mx); \
        if ((t) == 0 || __any(mx > 90.0f)) { \
            const float dl = (t) == 0 ? mx : fmaxf(mx, 0.f); \
            m_ref += dl; \
            _Pragma("unroll") for (int r = 0; r < 16; ++r) { c0[r] -= dl; c1[r] -= dl; negm[r] = -m_ref; } \
            if ((t) != 0) { const float alpha = __builtin_amdgcn_exp2f(-dl); l *= alpha; if (hi == 0) asc[r32] = alpha; resc = true; } \
        } } while (0)
#define P_EXP0() do { _Pragma("unroll") for (int r = 0; r < 16; ++r) c0[r] = __builtin_amdgcn_exp2f(c0[r]); } while (0)
#define P_EXP1SUM() do { float rs0 = 0.f, rs1 = 0.f; \
        _Pragma("unroll") for (int r = 0; r < 16; ++r) { c1[r] = __builtin_amdgcn_exp2f(c1[r]); rs0 += c0[r]; rs1 += c1[r]; } l += rs0 + rs1; } while (0)
#define P_PACK() do { _Pragma("unroll") for (int s = 0; s < 2; ++s) { u32x4 w0, w1; \
        _Pragma("unroll") for (int j = 0; j < 4; ++j) { w0[j] = cvt_pk(c0[8 * s + 2 * j], c0[8 * s + 2 * j + 1]); w1[j] = cvt_pk(c1[8 * s + 2 * j], c1[8 * s + 2 * j + 1]); } \
        pa[s] = __builtin_bit_cast(bf16x8, w0); pa[2 + s] = __builtin_bit_cast(bf16x8, w1); } } while (0)
#define P_RESC() do { if (resc) { resc = false; \
        _Pragma("unroll") for (int g = 0; g < 4; ++g) { const f32x4 a4 = *(const LAS f32x4*)(asc + 8 * g + 4 * hi); \
            _Pragma("unroll") for (int db = 0; db < NDB; ++db) _Pragma("unroll") for (int i = 0; i < 4; ++i) o[db][4 * g + i] *= a4[i]; } } } while (0)
#define AT_OPAQUE() float sl2x = sl2; int hix = hi; asm volatile("" : "+v"(sl2x), "+v"(hix))
    int skip = 0;
    if (ALIBI && !meta && NT > 6) {
        const bf16_t* krow = K1 + (size_t)(brow0 + qreal0 + 32 * wid + r32) * k1pitch + 8 * hi;
        float dot = 0.f, qn2 = 0.f;
#pragma unroll
        for (int ds = 0; ds < NDS; ++ds) { const bf16x8 kk = *(const bf16x8*)(krow + 16 * ds);
#pragma unroll
            for (int j = 0; j < 8; ++j) { const float qv = bf2f((unsigned short)qf[ds][j]), kv = bf2f((unsigned short)kk[j]); dot += qv * kv; qn2 += qv * qv; } }
        dot = half_sum(dot); qn2 = half_sum(qn2);
        float T = dot + sl2 * (float)(32 * wid + r32) - sqrtf(qn2) * kmax - 0.5f;
        T = swap16_min(row16_min(T));
        LAS float* tm = (LAS float*)(lds + AT_ASC);
        if (lane == 0) tm[32 * wid] = T;
        AT_BAR();
        float Tmin = tm[0];
#pragma unroll
        for (int w = 1; w < 8; ++w) Tmin = fminf(Tmin, tm[32 * w]);
        const float X = ((Tmin - 48.0f) / sl2 + (float)(qreal0 + 1)) * (1.0f / 64.0f);
        int J = X > 2.0f ? (int)X - 1 : 0;
        J = J < NT - 5 ? J : NT - 5;
        skip = __builtin_amdgcn_readfirstlane(J > 0 ? J : 0);
        NT -= skip;
    }
#define TJ(t) ((t) == 0 ? 0 : (t) + skip)
    int vs_prev = 0, vs_cur = AT_VBUF, vs_next = 2 * AT_VBUF;
    AT_ISSUE(0, kregA, vregA); AT_COMMIT(0, 0, kregA, vregA);
    AT_BAR();
    {
        f32x16 c0, c1; bf16x8 kf0[NDS], kf1[NDS]; AT_OPAQUE();
        if (NT > 1) AT_ISSUE(TJ(1), kregA, vregA);
        P_CINIT(0); P_KREAD(0); SB(); P_QK(); SB(); P_MASKMAX(0); P_EXP0(); P_EXP1SUM(); P_PACK();
        if (NT > 1) AT_COMMIT(1, vs_cur, kregA, vregA);
        AT_BAR();
    }
#define WAVE_HAS(j) ((j) == 0 || 64 * ((j) - 1) <= qreal0 + qw0 + 31)
    const int NT1 = (meta || NT < 5) ? NT : NT - 3;
    for (int t = 1; t < NT1; ++t) {
        f32x16 c0, c1; bf16x8 kf0[NDS], kf1[NDS]; v4i16_t vlo[2][4], vhh[2][4]; AT_OPAQUE();
        const int kb = t & 1;
        if (t + 1 < NT) AT_ISSUE(TJ(t + 1), kregA, vregA);
        P_RESC();
        P_CINIT(TJ(t)); P_KREAD(kb); SB();
        P_QK(); SB(); P_VREAD(vs_prev, 0); SB(); P_PV(0, 0); SB();
        P_MASKMAX(TJ(t)); SB();
        P_PV(0, 2); SB(); if (NDB == 4) P_VREAD(vs_prev, 2); SB();
        P_EXP0(); SB();
        if (NDB == 4) P_PV(2, 0); SB();
        P_EXP1SUM(); SB();
        if (NDB == 4) P_PV(2, 2); SB();
        P_PACK();
        if (t + 1 < NT) AT_COMMIT(kb ^ 1, vs_next, kregA, vregA);
        AT_BAR();
        const int tmp_ = vs_prev; vs_prev = vs_cur; vs_cur = vs_next; vs_next = tmp_;
    }
    for (int t = NT1; t < NT; ++t) {
        const int kb = t & 1;
        if (t + 1 < NT) AT_ISSUE(TJ(t + 1), kregA, vregA);
        if (WAVE_HAS(TJ(t - 1))) {
            v4i16_t vlo[2][4], vhh[2][4];
            P_RESC();
            P_VREAD(vs_prev, 0); SB(); P_PV(0, 0); P_PV(0, 2); SB();
            if (NDB == 4) { P_VREAD(vs_prev, 2); SB(); P_PV(2, 0); P_PV(2, 2); SB(); }
        }
        if (WAVE_HAS(TJ(t))) {
            f32x16 c0, c1; bf16x8 kf0[NDS], kf1[NDS]; AT_OPAQUE();
            P_CINIT(TJ(t)); P_KREAD(kb); SB(); P_QK(); SB(); P_MASKMAX(TJ(t)); P_EXP0(); P_EXP1SUM(); P_PACK();
        }
        if (t + 1 < NT) AT_COMMIT(kb ^ 1, vs_next, kregA, vregA);
        AT_BAR();
        const int tmp_ = vs_prev; vs_prev = vs_cur; vs_cur = vs_next; vs_next = tmp_;
    }
    {
        if (WAVE_HAS(TJ(NT - 1))) {
            v4i16_t vlo[2][4], vhh[2][4];
            P_RESC();
            P_VREAD(vs_prev, 0); SB(); P_PV(0, 0); P_PV(0, 2); SB();
            if (NDB == 4) { P_VREAD(vs_prev, 2); SB(); P_PV(2, 0); P_PV(2, 2); SB(); }
        }
        AT_BAR();
    }
#undef WAVE_HAS
    l = half_sum(l);
    const float inv = 1.0f / l;
    if (hi == 0) asc[r32] = inv;
#pragma unroll
    for (int g = 0; g < 4; ++g) { const f32x4 a4 = *(const LAS f32x4*)(asc + 8 * g + 4 * hi);
#pragma unroll
        for (int db = 0; db < NDB; ++db)
#pragma unroll
            for (int i = 0; i < 4; ++i) o[db][4 * g + i] *= a4[i]; }
#undef AT_ISSUE
#undef AT_COMMIT
#undef AT_BAR
#undef SB
#undef P_CINIT
#undef P_KREAD
#undef P_QK
#undef P_VREAD
#undef P_PV
#undef P_MASKMAX
#undef P_EXP0
#undef P_EXP1SUM
#undef P_PACK
#undef P_RESC
#undef AT_OPAQUE
#undef TJ
}
template <int NDB> __device__ __forceinline__ void store_rows16(LAS unsigned char* lds, const f32x16 (&o)[NDB], const float (&scl)[16], bf16_t* dst  , int ld, int meta, int wid, int lane) {
    constexpr int PITCH = NDB * 64 + 16, CH = NDB * 4;
    static_assert(8 * 32 * PITCH <= AT_ASC, "output staging overlaps the softmax scratch");
    const int r32 = lane & 31, hi = lane >> 5;
    LAS unsigned char* st = lds + wid * (32 * PITCH);
#pragma unroll
    for (int r = 0; r < 16; ++r)
#pragma unroll
        for (int db = 0; db < NDB; ++db) *(LAS bf16_t*)(st + crow(r, hi) * PITCH + (db * 32 + r32) * 2) = (bf16_t)f2bf(o[db][r] * scl[r]);
#pragma unroll
    for (int k = 0; k < NDB * 2; ++k) { const int id = lane + 64 * k, row = id / CH, ch = id % CH;
        const u32x4 vv = *(const LAS u32x4*)(st + row * PITCH + ch * 16);
        if (!meta || 32 * wid + row < 16) *(u32x4*)(dst + (size_t)(32 * wid + row) * ld + ch * 8) = vv; }
}
__device__ __forceinline__ void attn_unit_mla(const Params& P, LAS unsigned char* lds, int b, int h, int qb, int meta, int g_wid) {
    const bf16_t* Q = (const bf16_t*)(KPAR->ws + WS_POOL + PO_Q); const bf16_t* KV = (const bf16_t*)(KPAR->ws + WS_POOL + PO_KV); const bf16_t* KR = (const bf16_t*)(KPAR->ws + WS_KR);
    bf16_t* AO = (bf16_t*)(KPAR->ws + WS_POOL + PO_AO);
    int tid_o = (g_wid << 6) | lane_id(); const int tid = tid_o, lane = tid & 63, wid = tid >> 6, r32 = lane & 31, hi = lane >> 5;
    const int row0 = meta ? MREAL : b * SEQ + 256 * qb, NT = meta ? 1 : 1 + 4 * (qb + 1);
    f32x16 o[2];
    attn_pass<96, 64, false>(lds, Q + (size_t)row0 * 768 + h * 96, 768, KV + h * 128, 1024, KR, 32, KV + h * 128 + 64, 1024, b * SEQ, NT, 256 * qb, meta, 0.f, 0.f, o, g_wid);
    float one[16];
#pragma unroll
    for (int r = 0; r < 16; ++r) one[r] = 1.0f;
    (void)r32; (void)hi;
    store_rows16<2>(lds, o, one, AO + (size_t)row0 * 512 + h * 64, 512, meta, wid, lane);
}
__device__ __forceinline__ void attn_unit_diff(const Params& P, LAS unsigned char* lds, int b, int h, int qb, int meta, int map, int l, float lam, float kmax, int g_wid) {
    const bf16_t* DQ = (const bf16_t*)(KPAR->ws + WS_POOL + PO_DQ); const bf16_t* DK = (const bf16_t*)(KPAR->ws + WS_POOL + PO_DK); const bf16_t* DVv = (const bf16_t*)(KPAR->ws + WS_POOL + PO_DV);
    const int row0 = meta ? MREAL : b * SEQ + 256 * qb, NT = meta ? 1 : 1 + 4 * (qb + 1);
    const float sl2 = LOG2E * (h == 0 ? 0.25f : (h == 1 ? 0.0625f : (h == 2 ? 0.015625f : 0.00390625f)));
    f32x16 o[4];
    attn_pass<64, 128, true>(lds, DQ + (size_t)row0 * 512 + h * 128 + 64 * map, 512, DK + h * 128 + 64 * map, 512, nullptr, 0, DVv + h * 128, 512, b * SEQ, NT, 256 * qb, meta, sl2, kmax, o, g_wid);
    const int unit = meta ? 256 + h : ((b * 4 + h) * 32 + qb);
    unsigned* cw = (unsigned*)(KPAR->ws + WS_CTL) + 8192 + l * 1024 + unit * 2;
    const int tid = (g_wid << 6) | lane_id(), lane = tid & 63, wid = tid >> 6, r32 = lane & 31, hi = lane >> 5;
    float* st4 = (float*)(KPAR->ws + WS_POOL + PO_S) + (meta ? (size_t)256 * 32768 + (size_t)h * 4096 : (size_t)unit * 32768) + (size_t)tid * 64;
    const bool parks = !meta || wid == 0;
    static_assert((size_t)256 * 131072 + 4 * 16384 <= R1K, "parking slots exceed the S region");
    if (tid == 0) *(LAS unsigned*)(lds + AT_QW + 64) = __hip_atomic_fetch_add(cw, 1u, __ATOMIC_RELAXED, __HIP_MEMORY_SCOPE_AGENT);
    __syncthreads();
    const unsigned first = *(LAS unsigned*)(lds + AT_QW + 64) == 0u;
    if (first) {
#pragma unroll
        for (int db = 0; db < 4; ++db)
#pragma unroll
            for (int g = 0; g < 4; ++g) if (parks) ((f32x4*)st4)[db * 4 + g] = (f32x4){o[db][4 * g], o[db][4 * g + 1], o[db][4 * g + 2], o[db][4 * g + 3]};
        asm volatile("s_waitcnt vmcnt(0)" ::: "memory");
        __syncthreads();
        if (tid == 0) { __builtin_amdgcn_fence(__ATOMIC_RELEASE, "agent"); asm volatile("s_waitcnt vmcnt(0)" ::: "memory");
                        __hip_atomic_store(cw + 1, 1u, __ATOMIC_RELAXED, __HIP_MEMORY_SCOPE_AGENT); }
        return;
    }
    if (tid == 0) { while (__hip_atomic_load(cw + 1, __ATOMIC_RELAXED, __HIP_MEMORY_SCOPE_AGENT) == 0u) __builtin_amdgcn_s_sleep(2);
                    __builtin_amdgcn_fence(__ATOMIC_ACQUIRE, "agent"); asm volatile("s_waitcnt vmcnt(0)" ::: "memory"); }
    __syncthreads();
    bf16_t* DN = (bf16_t*)(KPAR->ws + WS_POOL + PO_DN);
    const float ca = map == 0 ? 1.0f : -lam, cb = map == 0 ? -lam : 1.0f;
#pragma unroll
    for (int db = 0; db < 4; ++db)
#pragma unroll
        for (int g = 0; g < 4; ++g) { f32x4 s4 = (f32x4){0.f, 0.f, 0.f, 0.f}; if (parks) s4 = __builtin_nontemporal_load((const f32x4*)st4 + db * 4 + g);
#pragma unroll
            for (int i = 0; i < 4; ++i) o[db][4 * g + i] = map == 0 ? (o[db][4 * g + i] - lam * s4[i]) : (s4[i] - lam * o[db][4 * g + i]); }
    (void)ca; (void)cb;
    float rs[16];
#pragma unroll
    for (int r = 0; r < 16; ++r) {
        float ss = (o[0][r] * o[0][r] + o[1][r] * o[1][r]) + (o[2][r] * o[2][r] + o[3][r] * o[3][r]);
        ss = half32_sum(ss);
        rs[r] = rsqrtf(ss * (1.0f / 128.0f) + EPS);
    }
    (void)r32; (void)hi;
    store_rows16<4>(lds, o, rs, DN + (size_t)row0 * 512 + h * 128, 512, meta, wid, lane);
}
__device__ __forceinline__ void attn_phase(const Params& P, LAS unsigned char* lds, int lc, int g_wid) {
    const int l = lc & 1;
    int tid_o = (g_wid << 6) | lane_id(); const int tid = tid_o, lane = tid & 63;
    const float s1 = wave_sum(KPAR->in[9][l * 64 + lane] * KPAR->in[10][l * 64 + lane]), s2 = wave_sum(KPAR->in[11][l * 64 + lane] * KPAR->in[12][l * 64 + lane]);
    const float lam = expf(s1) - expf(s2) + (l == 0 ? 0.2f : 0.35550907f);
    const float kmax = sqrtf(2.0f * __uint_as_float(__hip_atomic_load((unsigned*)(KPAR->ws + WS_CTL) + 3000 + 64 * l, __ATOMIC_RELAXED, __HIP_MEMORY_SCOPE_AGENT))) * 1.01f;
    const int xcc = (int)((unsigned)__builtin_amdgcn_s_getreg((3 << 11) | 20) & 7u);
    for (int qi = 0; qi < 8; ++qi) {
        const int q = (xcc + qi) & 7;
        unsigned* ctr = (unsigned*)(KPAR->ws + WS_CTL) + 64 * (lc * 8 + q);
        for (;;) {
            if (tid == 0) *(LAS unsigned*)(lds + AT_QW) = atomicAdd(ctr, 1u);
            __syncthreads();
            const int u = (int)*(LAS unsigned*)(lds + AT_QW);
            __syncthreads();
            if (u >= (l == 0 ? 130 : 128)) break;
            if (u < 128) { const int qb = 31 - (u >> 2), j = u & 3;
                if (j < 2) attn_unit_diff(P, lds, q >> 2, (qb & 1) ? 3 - (q & 3) : (q & 3), qb, 0, j, l, lam, kmax, g_wid);     else { const int s = q + 8 * (j - 2); attn_unit_mla(P, lds, s >> 3, s & 7, qb, 0, g_wid); }
            } else { const int m = q + 8 * (u - 128);
                if (m < 8) attn_unit_diff(P, lds, 0, m >> 1, 0, 1, m & 1, l, lam, kmax, g_wid); else attn_unit_mla(P, lds, 0, m - 8, 0, 1, g_wid); }
        }
    }
}
#define XB_TMO      128
#define XB_XCNT(j)  (256  + 64 * (j))
#define XB_XSUB(j)  (1280 + 64 * (j))
#define XB_XGEN(j)  (2304 + 64 * (j))
#define XB_TOP      3328
#define XB_TOPGEN   3392
#define XCD_BAR_WORDS 3456
#define XB_SPIN_CAP (1u << 18)

__device__ __forceinline__ unsigned xb_ld(unsigned* p)              { return __hip_atomic_load(p, __ATOMIC_RELAXED, __HIP_MEMORY_SCOPE_AGENT); }
__device__ __forceinline__ unsigned xb_add(unsigned* p, unsigned v) { return __hip_atomic_fetch_add(p, v, __ATOMIC_RELAXED, __HIP_MEMORY_SCOPE_AGENT); }
__device__ __forceinline__ unsigned xb_xcc_id() { return (unsigned)__builtin_amdgcn_s_getreg((3 << 11) | 20) & 0xFu; }
#define XB_SPIN(cond, bar) do { unsigned _sp = 0; while (cond) { __builtin_amdgcn_s_sleep(1); \
    if ((++_sp & 255u) == 0u) { if (xb_ld(&(bar)[XB_TMO])) break; if (_sp > XB_SPIN_CAP) { atomicAdd(&(bar)[XB_TMO], 1u); break; } } } } while (0)

struct XcdBarrier {
    unsigned* bar; unsigned x;
    volatile LAS unsigned* st;
};

__device__ __forceinline__ XcdBarrier xcd_barrier_post(unsigned* bar, volatile LAS unsigned* st, bool leader) {
    XcdBarrier b; b.bar = bar; b.x = xb_xcc_id(); b.st = st;
    if (leader) (void)xb_add(&bar[XB_XCNT(b.x)], 1u);
    return b;
}
__device__ __forceinline__ void xcd_barrier_complete(unsigned* bar, unsigned x, unsigned& nloc, unsigned& nx) {
    const unsigned G = gridDim.x * gridDim.y * gridDim.z;
    unsigned sum, cnt, mine, sp = 0u;
    for (;;) {
        sum = 0u; cnt = 0u; mine = 0u;
#pragma unroll
        for (unsigned j = 0; j < 16; ++j) { const unsigned c = xb_ld(&bar[XB_XCNT(j)]); sum += c; cnt += (c > 0u) ? 1u : 0u; mine = (j == x) ? c : mine; }
        if (sum == G) break;
        __builtin_amdgcn_s_sleep(1);
        if ((++sp & 255u) == 0u) { if (xb_ld(&bar[XB_TMO])) break; if (sp > XB_SPIN_CAP) { atomicAdd(&bar[XB_TMO], 1u); break; } }
    }
    nloc = mine > 0u ? mine : 1u; nx = cnt > 0u ? cnt : 1u;
}

__device__ __forceinline__ void xcd_barrier(const XcdBarrier& b, int g_wid) {
    asm volatile("s_waitcnt vmcnt(0)" ::: "memory");
    __syncthreads();
    if (g_wid == 0 && lane_id() == 0) {
        unsigned* bar = b.bar;
        __builtin_amdgcn_s_waitcnt(0);
        unsigned nloc = b.st[0], nx = b.st[1];
        if (nloc == 0u) { xcd_barrier_complete(bar, b.x, nloc, nx); b.st[0] = nloc; b.st[1] = nx; }
        const unsigned old = xb_add(&bar[XB_XSUB(b.x)], 1u);
        const unsigned gen = old / nloc;
        if (old + 1u == (gen + 1u) * nloc) {
            __builtin_amdgcn_fence(__ATOMIC_RELEASE, "agent");
            asm volatile("s_waitcnt vmcnt(0)" ::: "memory");
            const unsigned og = xb_add(&bar[XB_TOP], 1u);
            const unsigned tg = og / nx;
            if (og + 1u == (tg + 1u) * nx) xb_add(&bar[XB_TOPGEN], 1u);
            else XB_SPIN(xb_ld(&bar[XB_TOPGEN]) == tg, bar);
            __builtin_amdgcn_fence(__ATOMIC_ACQUIRE, "agent");
            xb_add(&bar[XB_XGEN(b.x)], 1u);
            asm volatile("s_waitcnt vmcnt(0)" ::: "memory");
        } else {
            XB_SPIN(xb_ld(&bar[XB_XGEN(b.x)]) == gen, bar);
            __builtin_amdgcn_fence(__ATOMIC_ACQUIRE, "agent");
            asm volatile("s_waitcnt vmcnt(0)" ::: "memory");
        }
    }
    __syncthreads();
}

constexpr int LDS_BYTES = 131072 + 1024;
__global__ void __launch_bounds__(512, 2) fwd_megakernel(Params P) {
    extern __shared__ __attribute__((aligned(16))) unsigned char lds_raw[];
    LAS unsigned char* lds = (LAS unsigned char*)lds_raw;
    const int g_wid = __builtin_amdgcn_readfirstlane(threadIdx.x >> 6);
    volatile LAS unsigned* xb_st = (volatile LAS unsigned*)(lds + 131072 + 64);
    if (g_wid == 0 && lane_id() < 2) xb_st[lane_id()] = 0u;
    __syncthreads();
    const XcdBarrier xbar = xcd_barrier_post((unsigned*)(KPAR->ws + WS_CTL) + 4096, xb_st, g_wid == 0 && lane_id() == 0);
#define GRID_SYNC() xcd_barrier(xbar, g_wid)
#define WSP unsigned char* ws = KPAR->ws; asm volatile("" : "+s"(ws)); unsigned char* pool = ws + WS_POOL; (void)pool
#define PW ((bf16_t*)(ws + WS_W))
#define PXB ((bf16_t*)(ws + WS_XB))
#define PSSQ ((float*)(ws + WS_SSQ))
#define PSSQQ ((float*)(ws + WS_SSQQ))
#define PSSQKV ((float*)(ws + WS_SSQKV))
#define PXMETA ((float*)(ws + WS_XMETA))
#define PROPE ((const f32x2*)(ws + WS_ROPE))
#define PKR ((bf16_t*)(ws + WS_KR))
#define PP(off) ((bf16_t*)(pool + (off)))
#ifndef PHM
#define PHM 0xffff
#endif
#if PHM & 1
    prologue_x(P, g_wid); convert_weights(P, 0, lds, g_wid);
#if defined(PROBE_DUP) && (PROBE_DUP & 1)
    convert_weights(P, 0, lds, g_wid);
#endif
#endif
    if (KPAR->ws == nullptr) cg::this_grid().sync();
    GRID_SYNC();
    for (int l = 0; l < 2; ++l) {
#if PHM & 1
        if (l == 1) { convert_weights(P, 1, lds, g_wid); GRID_SYNC(); }
#endif
        const bool m_all = (l == 0);
#if PHM & 2
        {
            WSP; gemm_all<REWin>(lds, PXB, PW + WO_IN, 2048, 1024, REWin{PSSQ, (unsigned*)(ws + WS_CTL) + 3000 + 64 * l, PP(PO_QA), PP(PO_KVA), PKR, PP(PO_DQ), PP(PO_DK), PP(PO_DV), PSSQQ, PSSQKV, PROPE}, true, g_wid);
        }
        GRID_SYNC();
#if defined(PROBE_DUP) && (PROBE_DUP & 2)
        {
            WSP; gemm_all<REWin>(lds, PXB, PW + WO_IN, 2048, 1024, REWin{PSSQ, (unsigned*)(ws + WS_CTL) + 3000 + 64 * l, PP(PO_QA), PP(PO_KVA), PKR, PP(PO_DQ), PP(PO_DK), PP(PO_DV), PSSQQ, PSSQKV, PROPE}, true, g_wid);
        }
        GRID_SYNC();
#endif
#endif
#if PHM & 4
        {
            WSP; gemm_all<REQup>(lds, PP(PO_QA), PW + WO_Q, 768, 256, REQup{PSSQQ, PP(PO_Q), PROPE}, m_all, g_wid);
        }
        {   WSP; gemm_all<REKVup>(lds, PP(PO_KVA), PW + WO_KV, 1024, 128, REKVup{PSSQKV, PP(PO_KV)}, true, g_wid); }
        GRID_SYNC();
#if defined(PROBE_DUP) && (PROBE_DUP & 4)
        {
            WSP; gemm_all<REQup>(lds, PP(PO_QA), PW + WO_Q, 768, 256, REQup{PSSQQ, PP(PO_Q), PROPE}, m_all, g_wid);
        }
        {   WSP; gemm_all<REKVup>(lds, PP(PO_KVA), PW + WO_KV, 1024, 128, REKVup{PSSQKV, PP(PO_KV)}, true, g_wid); }
        GRID_SYNC();
#endif
#endif
#if PHM & 8
        attn_phase(P, lds, l, g_wid);
#ifdef PROBE_ATTN2
        GRID_SYNC(); attn_phase(P, lds, l + 2, g_wid);
#endif
        GRID_SYNC();
#endif
#if PHM & 16
        {   WSP; gemm_all<REStore>(lds, PP(PO_AO), PW + WO_A, 1024, 512, REStore{PP(PO_S)}, m_all, g_wid); }
        {   WSP; gemm_all<REGate>(lds, PXB, PW + WO_GA, 1024, 1024, REGate{PSSQ, KPAR->in[4] + (size_t)l * 2048, PP(PO_S), nullptr, 0}, m_all, g_wid); }
        {   WSP; gemm_all<REStore>(lds, PP(PO_DN), PW + WO_B, 1024, 512, REStore{PP(PO_YQ)}, m_all, g_wid); }
        {   WSP; gemm_all<REGate>(lds, PXB, PW + WO_GB, 1024, 1024, REGate{PSSQ, KPAR->in[4] + (size_t)l * 2048 + 1024, PP(PO_S), PP(PO_YQ), 1}, m_all, g_wid); }
        GRID_SYNC();
#if defined(PROBE_DUP) && (PROBE_DUP & 16)
        {   WSP; gemm_all<REStore>(lds, PP(PO_AO), PW + WO_A, 1024, 512, REStore{PP(PO_S)}, m_all, g_wid); }
        {   WSP; gemm_all<REGate>(lds, PXB, PW + WO_GA, 1024, 1024, REGate{PSSQ, KPAR->in[4] + (size_t)l * 2048, PP(PO_S), nullptr, 0}, m_all, g_wid); }
        {   WSP; gemm_all<REStore>(lds, PP(PO_DN), PW + WO_B, 1024, 512, REStore{PP(PO_YQ)}, m_all, g_wid); }
        {   WSP; gemm_all<REGate>(lds, PXB, PW + WO_GB, 1024, 1024, REGate{PSSQ, KPAR->in[4] + (size_t)l * 2048 + 1024, PP(PO_S), PP(PO_YQ), 1}, m_all, g_wid); }
        GRID_SYNC();
#endif
#endif
#if PHM & 32
        {
            WSP; float* out = KPAR->out; gemm_all<REResid>(lds, PP(PO_S), PW + WO_O, 1024, 1024, REResid{l == 0 ? KPAR->in[0] : out, l == 0 ? KPAR->in[1] : PXMETA, out, PXMETA, PXB, PSSQ}, m_all, g_wid);
        }
        GRID_SYNC();
#endif
#if PHM & 64
        {
            WSP; gemm_all<REUp>(lds, PXB, PW + WO_UP, 4096, 1024, REUp{PSSQ, PP(PO_H)}, m_all, g_wid);
        }
        GRID_SYNC();
#if defined(PROBE_DUP) && (PROBE_DUP & 64)
        {
            WSP; gemm_all<REUp>(lds, PXB, PW + WO_UP, 4096, 1024, REUp{PSSQ, PP(PO_H)}, m_all, g_wid);
        }
        GRID_SYNC();
#endif
#endif
#if PHM & 128
        {
            WSP; float* out = KPAR->out; gemm_all<REResid>(lds, PP(PO_H), PW + WO_DN, 1024, 4096, REResid{out, PXMETA, out, PXMETA, l == 1 ? (bf16_t*)nullptr : PXB, PSSQ}, m_all, g_wid);
        }
        GRID_SYNC();
#endif
    }
    { int tid_o = (g_wid << 6) | lane_id(); const int tid = tid_o, wid = tid >> 6, lane = tid & 63; const float* g = KPAR->in[20]; WSP; float* ssq = PSSQ; float* out = KPAR->out;
      for (int row = blockIdx.x * 8 + wid; row < MREAL; row += gridDim.x * 8) {
          const float rstd = rsqrtf(sum16p(ssq + (size_t)row * 16) * (1.0f / 1024.0f) + EPS);
          f32x4* o4 = (f32x4*)(out + (size_t)row * 1024);
#pragma unroll
          for (int j = 0; j < 4; ++j) o4[64 * j + lane] = o4[64 * j + lane] * rstd * ((const f32x4*)g)[64 * j + lane];
      } }
}

extern "C" void kernel_launch(void* const* d_in, const int* in_sizes, int n_in, void* d_out, int out_size, void* d_ws, size_t ws_size, hipStream_t stream) {
    static int grid = 0;
    if (grid == 0) {
        if (n_in != 21 || ws_size < WS_END) { fprintf(stderr, "kernel_launch: unexpected inputs (n_in %d, ws %zu < %zu)\n", n_in, ws_size, (size_t)WS_END); grid = -1; return; }
        int dev = 0, cus = 0, per_cu = 0;
        (void)hipGetDevice(&dev); (void)hipDeviceGetAttribute(&cus, hipDeviceAttributeMultiprocessorCount, dev);
        (void)hipFuncSetAttribute((const void*)fwd_megakernel, hipFuncAttributeMaxDynamicSharedMemorySize, LDS_BYTES);
        (void)hipOccupancyMaxActiveBlocksPerMultiprocessor(&per_cu, (const void*)fwd_megakernel, 512, LDS_BYTES);
        if (per_cu < 1) per_cu = 1;
        grid = cus * per_cu; if (grid > 256) grid = 256;
        (void)hipGetLastError();
    }
    if (grid < 0) return;
    (void)hipMemsetAsync((char*)d_ws + WS_CTL, 0, CTL_BYTES, stream);
    Params p{};
    for (int i = 0; i < 21; ++i) p.in[i] = (const float*)d_in[i];
    p.out = (float*)d_out; p.ws = (unsigned char*)d_ws;
    void* args[] = {&p};
    hipError_t e = hipLaunchCooperativeKernel((const void*)fwd_megakernel, dim3(grid), dim3(512), args, LDS_BYTES, stream);
    if (e != hipSuccess) fprintf(stderr, "cooperative launch failed: %s (grid %d)\n", hipGetErrorString(e), grid);
}
```
